# Optimizing an MI355X kernel written in HIP

```python
import jax, jax.numpy as jnp
from jax import lax

D_MODEL = 1024
BATCH = 4
SEQ = 4096
DEPTH = 2

D_RNN = 1024
RNN_BLOCKS = 16
RNN_BLOCK = D_RNN // RNN_BLOCKS
CONV_A = 4
LRU_C = 8.0
HEAD_DIM = 64
ATTN_GROUPS = ((128, 1), (512, 4), (2048, 16))
N_GROUPS = len(ATTN_GROUPS)
HEADS_PER_GROUP = 4
N_ATTN_HEADS = N_GROUPS * HEADS_PER_GROUP
D_ATTN = N_ATTN_HEADS * HEAD_DIM
D_ATTN_OUT = HEADS_PER_GROUP * HEAD_DIM
ROT_DIM = HEAD_DIM // 4
ROPE_THETA = 500000.0
Q_BLOCK = 128
RWKV_HEAD = 64
D_RWKV = 1024
N_RWKV_HEADS = D_RWKV // RWKV_HEAD
DECAY_LORA = 64
AAA_LORA = 64
GATE_LORA = 128
MV_LORA = 32
RWKV_GN_EPS = 64e-5
N_SHIFT = 3 * D_RWKV + DECAY_LORA + AAA_LORA + GATE_LORA
N_BRANCH = 3
IN_SPLITS = (D_RNN, D_RNN, D_ATTN, D_ATTN, D_ATTN, N_SHIFT, N_BRANCH * D_MODEL)
N_IN = sum(IN_SPLITS)
RWKV_SPLITS = (D_RWKV, D_RWKV, D_RWKV, DECAY_LORA, AAA_LORA, GATE_LORA)
D_FF = 2816
CONV_F = 3
ALPHA = (2 * DEPTH) ** 0.25
BETA = (8 * DEPTH) ** -0.25
LN_EPS = 1e-5

kernel_name = 'hybrid_rglru_dilattn_rwkv7_deepnorm'


def _split(z, sizes):
    idx, acc = [], 0
    for s in sizes[:-1]:
        acc += s
        idx.append(acc)
    return jnp.split(z, idx, axis=-1)


def _layer_norm(x, w, b):
    xf = x.astype(jnp.float32)
    mu = xf.mean(-1, keepdims=True)
    var = jnp.square(xf - mu).mean(-1, keepdims=True)
    return ((xf - mu) * lax.rsqrt(var + LN_EPS) * w + b).astype(x.dtype)


def _causal_dwconv(u, w, b):
    k_w = w.shape[0]
    s = u.shape[1]
    up = jnp.pad(u, ((0, 0), (k_w - 1, 0), (0, 0)))
    return b + sum(w[j] * up[:, k_w - 1 - j:k_w - 1 - j + s] for j in range(k_w))


def _token_shift(z, mu):
    z_prev = jnp.pad(z, ((0, 0), (1, 0), (0, 0)))[:, :-1]
    return z + (z_prev - z) * mu


def _partial_rope(t, positions):
    half = ROT_DIM // 2
    inv_freq = ROPE_THETA ** (-jnp.arange(half, dtype=jnp.float32) / half)
    ang = positions.astype(jnp.float32)[..., None] * inv_freq
    cos = jnp.cos(ang)[:, :, None, :]
    sin = jnp.sin(ang)[:, :, None, :]
    tf = t.astype(jnp.float32)
    x1, x2, rest = tf[..., :half], tf[..., half:ROT_DIM], tf[..., ROT_DIM:]
    out = jnp.concatenate([x1 * cos - x2 * sin, x2 * cos + x1 * sin, rest], axis=-1)
    return out.astype(t.dtype)


def _rg_lru(xa, wa, ba, wx, bx, lam):
    bsz, s, _ = xa.shape
    xf = xa.astype(jnp.float32)
    xb = xf.reshape(bsz, s, RNN_BLOCKS, RNN_BLOCK)
    r = jax.nn.sigmoid(jnp.einsum('bsgi,gij->bsgj', xb, wa).reshape(bsz, s, D_RNN) + ba)
    i = jax.nn.sigmoid(jnp.einsum('bsgi,gij->bsgj', xb, wx).reshape(bsz, s, D_RNN) + bx)
    log_a = -LRU_C * r * jax.nn.softplus(-lam)
    a = jnp.exp(log_a)
    b = jnp.sqrt(-jnp.expm1(2.0 * log_a)) * (i * xf)

    def combine(left, right):
        a1, b1 = left
        a2, b2 = right
        return a1 * a2, a2 * b1 + b2

    _, h = lax.associative_scan(combine, (a, b), axis=1)
    return h.astype(xa.dtype)


def _dilated_attention(q, k, v):
    bsz, s = q.shape[:2]
    n_blocks = s // Q_BLOCK
    scale = HEAD_DIM ** -0.5
    qg = q.reshape(bsz, s, N_GROUPS, HEADS_PER_GROUP, HEAD_DIM)
    kg = k.reshape(bsz, s, N_GROUPS, HEADS_PER_GROUP, HEAD_DIM)
    vg = v.reshape(bsz, s, N_GROUPS, HEADS_PER_GROUP, HEAD_DIM)
    k_groups = [kg[:, :, g] for g in range(N_GROUPS)]
    v_groups = [vg[:, :, g] for g in range(N_GROUPS)]

    def block(q0):
        t = q0 + jnp.arange(Q_BLOCK)
        qb = lax.dynamic_slice_in_dim(qg, q0, Q_BLOCK, axis=1).astype(jnp.float32) * scale
        outs, lses = [], []
        for g, (window, dil) in enumerate(ATTN_GROUPS):
            n_keys = window // dil + 1
            idx = t[:, None] - dil * jnp.arange(n_keys)[None, :]
            valid = idx >= 0
            idx = jnp.maximum(idx, 0)
            kb = jnp.take(k_groups[g], idx, axis=1).astype(jnp.float32)
            vb = jnp.take(v_groups[g], idx, axis=1).astype(jnp.float32)
            sc = jnp.einsum('bqhd,bqjhd->bhqj', qb[:, :, g], kb)
            sc = jnp.where(valid[None, None], sc, -jnp.inf)
            lse = jax.nn.logsumexp(sc, axis=-1)
            p = jnp.exp(sc - lse[..., None])
            outs.append(jnp.einsum('bhqj,bqjhd->bqhd', p, vb))
            lses.append(lse)
        wts = jax.nn.softmax(jnp.stack(lses, 0), axis=0)
        return jnp.einsum('gbhq,gbqhd->bqhd', wts, jnp.stack(outs, 0))

    out = lax.map(block, jnp.arange(n_blocks) * Q_BLOCK)
    out = out.transpose(1, 0, 2, 3, 4).reshape(bsz, s, D_ATTN_OUT)
    return out.astype(q.dtype)


def _wkv7(r, decay, k, v, kk, a):
    bsz, _, nh, n = r.shape

    def step(st, inp):
        r_t, w_t, k_t, v_t, kk_t, a_t = inp
        sa = jnp.einsum('bhij,bhj->bhi', st, -kk_t)
        st = (st * w_t[:, :, None, :] + sa[..., None] * (kk_t * a_t)[:, :, None, :]
              + v_t[..., None] * k_t[:, :, None, :])
        return st, jnp.einsum('bhij,bhj->bhi', st, r_t)

    xs = tuple(jnp.moveaxis(t, 1, 0) for t in (r, decay, k, v, kk, a))
    _, y = lax.scan(step, jnp.zeros((bsz, nh, n, n), jnp.float32), xs)
    return jnp.moveaxis(y, 0, 1)


def _rwkv7_branch(zc, v_res, w0, w2, a0, a2, g2, k_k, k_a, r_k, ln_w, ln_b):
    bsz, s, _ = zc.shape
    r, k, v, zw, za, zg = _split(zc.astype(jnp.float32), RWKV_SPLITS)
    w_log = -jax.nn.softplus(-(w0 + jnp.tanh(zw) @ w2)) - 0.5
    decay = jnp.exp(-jnp.exp(w_log))
    a = jax.nn.sigmoid(a0 + za @ a2)
    g = jax.nn.sigmoid(zg) @ g2
    if v_res is None:
        v_first = v
    else:
        v_first, zv1, v0, v2 = v_res
        v = v + (v_first - v) * jax.nn.sigmoid(v0 + zv1.astype(jnp.float32) @ v2)

    def heads(t):
        return t.reshape(bsz, s, N_RWKV_HEADS, RWKV_HEAD)

    kk = heads(k * k_k)
    kk = kk * lax.rsqrt(jnp.sum(kk * kk, -1, keepdims=True) + 1e-12)
    k = k * (1.0 + (a - 1.0) * k_a)
    rh, kh, vh = heads(r), heads(k), heads(v)
    y = _wkv7(rh, heads(decay), kh, vh, kk, heads(a))
    mu = y.mean(-1, keepdims=True)
    var = jnp.square(y - mu).mean(-1, keepdims=True)
    y = ((y - mu) * lax.rsqrt(var + RWKV_GN_EPS)).reshape(bsz, s, D_RWKV) * ln_w + ln_b
    bonus = (jnp.sum(rh * kh * r_k, -1, keepdims=True) * vh).reshape(bsz, s, D_RWKV)
    return ((y + bonus) * g).astype(zc.dtype), v_first


def setup_inputs(seed: int = 0) -> dict:
    key = jax.random.key(seed)
    keys = iter(jax.random.split(key, 64))

    def nrm(shape, scale):
        return jax.random.normal(next(keys), shape, jnp.float32) * scale

    def uni(shape, lo, hi):
        return jax.random.uniform(next(keys), shape, jnp.float32, lo, hi)

    L, LV = DEPTH, DEPTH - 1
    x = nrm((BATCH, SEQ, D_MODEL), 1.0)
    c = nrm((BATCH, D_MODEL), 1.0)
    offset = jax.random.randint(next(keys), (BATCH, 1), 0, 1024, jnp.int32)
    positions = offset + jnp.arange(SEQ, dtype=jnp.int32)[None, :]
    u = uni((L, D_RNN), 0.9, 0.999)
    s_lam = u ** (1.0 / LRU_C)
    lru_lambda = jnp.log(s_lam) - jnp.log1p(-s_lam)
    return {
        'x': x, 'c': c, 'positions': positions,
        'mod_w': nrm((L, D_MODEL, 6 * D_MODEL), 0.5 * D_MODEL ** -0.5),
        'mod_b': nrm((L, 6 * D_MODEL), 0.01),
        'w_in': nrm((L, D_MODEL, N_IN), D_MODEL ** -0.5),
        'w_in_vres': nrm((LV, D_MODEL, MV_LORA), D_MODEL ** -0.5),
        'conv_a_w': nrm((L, CONV_A, D_RNN), CONV_A ** -0.5),
        'conv_a_b': nrm((L, D_RNN), 0.01),
        'lru_wa': nrm((L, RNN_BLOCKS, RNN_BLOCK, RNN_BLOCK), RNN_BLOCK ** -0.5),
        'lru_ba': nrm((L, D_RNN), 0.01),
        'lru_wx': nrm((L, RNN_BLOCKS, RNN_BLOCK, RNN_BLOCK), RNN_BLOCK ** -0.5),
        'lru_bx': nrm((L, D_RNN), 0.01),
        'lru_lambda': lru_lambda,
        'rwkv_mu': uni((L, N_SHIFT), 0.0, 1.0),
        'mu_vres': uni((LV, MV_LORA), 0.0, 1.0),
        'w0': uni((L, D_RWKV), -4.0, 1.0),
        'w2': nrm((L, DECAY_LORA, D_RWKV), 0.1 * DECAY_LORA ** -0.5),
        'a0': nrm((L, D_RWKV), 0.1),
        'a2': nrm((L, AAA_LORA, D_RWKV), 0.1 * AAA_LORA ** -0.5),
        'g2': nrm((L, GATE_LORA, D_RWKV), GATE_LORA ** -0.5),
        'v0': nrm((LV, D_RWKV), 0.1),
        'v2': nrm((LV, MV_LORA, D_RWKV), 0.1 * MV_LORA ** -0.5),
        'k_k': uni((L, D_RWKV), 0.7, 1.0),
        'k_a': uni((L, D_RWKV), 0.8, 1.2),
        'r_k': nrm((L, N_RWKV_HEADS, RWKV_HEAD), 0.1),
        'ln_x_w': 1.0 + nrm((L, D_RWKV), 0.02),
        'ln_x_b': nrm((L, D_RWKV), 0.01),
        'proj_a': nrm((L, D_RNN, D_MODEL), BETA * D_RNN ** -0.5),
        'proj_b': nrm((L, D_ATTN_OUT, D_MODEL), BETA * D_ATTN_OUT ** -0.5),
        'proj_c': nrm((L, D_RWKV, D_MODEL), BETA * D_RWKV ** -0.5),
        'w_o': nrm((L, D_MODEL, D_MODEL), BETA * D_MODEL ** -0.5),
        'ln1_w': 1.0 + nrm((L, D_MODEL), 0.02),
        'ln1_b': nrm((L, D_MODEL), 0.01),
        'ffn_up': nrm((L, D_MODEL, 2 * D_FF), D_MODEL ** -0.5),
        'ffn_conv_w': nrm((L, CONV_F, 2 * D_FF), CONV_F ** -0.5),
        'ffn_conv_b': nrm((L, 2 * D_FF), 0.01),
        'ffn_down': nrm((L, D_FF, D_MODEL), BETA * D_FF ** -0.5),
        'ln2_w': 1.0 + nrm((L, D_MODEL), 0.02),
        'ln2_b': nrm((L, D_MODEL), 0.01),
    }


def reference(x, c, positions, mod_w, mod_b, w_in, w_in_vres, conv_a_w, conv_a_b,
              lru_wa, lru_ba, lru_wx, lru_bx, lru_lambda, rwkv_mu, mu_vres, w0, w2,
              a0, a2, g2, v0, v2, k_k, k_a, r_k, ln_x_w, ln_x_b, proj_a, proj_b,
              proj_c, w_o, ln1_w, ln1_b, ffn_up, ffn_conv_w, ffn_conv_b, ffn_down,
              ln2_w, ln2_b):
    bsz, s = x.shape[:2]
    v_first = None
    for l in range(DEPTH):
        mod = jax.nn.silu(c) @ mod_w[l] + mod_b[l]
        sh1, sc1, gt1, sh2, sc2, gt2 = jnp.split(mod[:, None, :], 6, axis=-1)

        h = x * (1.0 + sc1) + sh1
        if l == 0:
            z = h @ w_in[l]
            xa, ga, q, k, v, zc, zgate = _split(z, IN_SPLITS)
            v_res = None
        else:
            z = h @ jnp.concatenate([w_in[l], w_in_vres[l - 1]], axis=1)
            xa, ga, q, k, v, zc, zgate, zv1 = _split(z, IN_SPLITS + (MV_LORA,))
            v_res = (v_first, _token_shift(zv1, mu_vres[l - 1]), v0[l - 1], v2[l - 1])

        xa = _causal_dwconv(xa, conv_a_w[l], conv_a_b[l])
        y_a = _rg_lru(xa, lru_wa[l], lru_ba[l], lru_wx[l], lru_bx[l], lru_lambda[l]) * jax.nn.gelu(ga)

        q = _partial_rope(q.reshape(bsz, s, N_ATTN_HEADS, HEAD_DIM), positions)
        k = _partial_rope(k.reshape(bsz, s, N_ATTN_HEADS, HEAD_DIM), positions)
        y_b = _dilated_attention(q, k, v.reshape(bsz, s, N_ATTN_HEADS, HEAD_DIM))

        y_c, v_first = _rwkv7_branch(_token_shift(zc, rwkv_mu[l]), v_res, w0[l], w2[l], a0[l],
                                     a2[l], g2[l], k_k[l], k_a[l], r_k[l], ln_x_w[l], ln_x_b[l])

        g_a, g_b, g_c = jnp.split(jax.nn.sigmoid(zgate), N_BRANCH, axis=-1)
        merged = g_a * (y_a @ proj_a[l]) + g_b * (y_b @ proj_b[l]) + g_c * (y_c @ proj_c[l])
        x = _layer_norm(ALPHA * x + (1.0 + gt1) * (merged @ w_o[l]), ln1_w[l], ln1_b[l])

        h = x * (1.0 + sc2) + sh2
        u = _causal_dwconv(h @ ffn_up[l], ffn_conv_w[l], ffn_conv_b[l])
        u_g, u_v = jnp.split(u, 2, axis=-1)
        y = (jax.nn.silu(u_g) * u_v) @ ffn_down[l]
        x = _layer_norm(ALPHA * x + (1.0 + gt2) * y, ln2_w[l], ln2_b[l])
    return x
```

```cpp
#include <hip/hip_runtime.h>
#include <cstdio>
#include <cstdint>
namespace pg8 {
#define PG8_LAS __attribute__((address_space(3)))
typedef unsigned short bf16_t;
typedef short bf16x8 __attribute__((ext_vector_type(8)));
typedef float f32x4 __attribute__((ext_vector_type(4)));
typedef unsigned u32x4 __attribute__((ext_vector_type(4)));
typedef unsigned u32x2 __attribute__((ext_vector_type(2)));
constexpr int BM = 256, BK = 64, HALF = 128, HTB = HALF * BK * 2, STAGE_BYTES = 8 * HTB, NXCD = 8, WGM = 8;

__host__ __device__ __forceinline__ int lds_byte(int r, int c) { const int st = (r >> 4) * 2 + (c >> 5), rr = r & 15, cc = c & 31, ob = rr * 64 + cc * 2; return st * 1024 + (ob ^ (((ob >> 9) & 1) << 5)); }
__host__ __device__ __forceinline__ void stage_rc(int b, int& R, int& C) { const int st = b / 1024, sb = b % 1024, swz = sb ^ (((sb >> 9) & 1) << 5); R = (st >> 1) * 16 + swz / 64; C = (st & 1) * 32 + (swz % 64) / 2; }
__host__ __device__ __forceinline__ int perm32(int rho) { const int n = rho >> 4, i = rho & 15; return 8 * (i >> 2) + 4 * n + (i & 3); }

struct Unit { int pm, pn; };
struct Gemm { const bf16_t* A; const bf16_t* Bt; int M, N, K, lda; };

struct StaticOrder {
    int nM, nN, nwg, G, c;
    __host__ __device__ void init(int M, int N, int G_, int c_) { nM = M / BM; nN = N / BM; nwg = nM * nN; G = G_; c = c_; }
    __host__ __device__ bool next(int i, Unit& u) const {
        const long L = (long)i * G + c; if (L >= nwg) return false;
        int wgid = (int)L; { const int q = nwg / NXCD, r = nwg % NXCD, xcd = wgid % NXCD, off = wgid / NXCD; wgid = (xcd < r ? xcd * (q + 1) : r * (q + 1) + (xcd - r) * q) + off; }
        const int nig = WGM * nN, gid = wgid / nig, fm = gid * WGM, gsz = (nM - fm) < WGM ? (nM - fm) : WGM;
        u.pm = fm + ((wgid % nig) % gsz); u.pn = (wgid % nig) / gsz; return true;
    }
    __device__ __forceinline__ void a_ready(const Unit&) const {}
    __device__ __forceinline__ void done(const Unit&) const {}
};

__device__ __forceinline__ unsigned cvt_pk_bf16(float lo, float hi) { unsigned r; asm volatile("v_cvt_pk_bf16_f32 %0, %1, %2" : "=v"(r) : "v"(lo), "v"(hi)); return r; }

template <class Epi, class Sched, bool ALIGN_EPI = false, bool SP2 = false>
__device__ __forceinline__ void gemm_phase(PG8_LAS unsigned char* lds, const Gemm g, const Sched& S, const Epi& E) {
    const int tid = threadIdx.x, wid = __builtin_amdgcn_readfirstlane(tid >> 6), lane = tid & 63, wr = wid >> 2, wc = wid & 3, fr = lane & 15, fq = lane >> 4;
    const int K = g.K, nt = K / BK, lda = g.lda;
    unsigned voffA[2], voffB[2];
#pragma unroll
    for (int i = 0; i < 2; ++i) { int R, C; stage_rc(tid * 16 + i * 8192, R, C); const int Rb = Epi::PERM ? ((R & ~31) + perm32(R & 31)) : R;
        voffA[i] = (unsigned)(R * lda + C) * 2u; voffB[i] = (unsigned)(Rb * K + C) * 2u; }
    const size_t kstep = (size_t)(BK * 2);
    const size_t hstepA = (size_t)HALF * lda * 2, hstepB = (size_t)HALF * K * 2;
    const size_t tstepA = 2 * hstepA, tstepB = 2 * hstepB;
    const unsigned ldsw = (unsigned)wid * 1024u;
    const int aoff = lds_byte(wr * 64 + fr, fq * 8), boff = lds_byte(wc * 32 + fr, fq * 8);
#define PG8_SA(b, h) (((b) * 2 + (h)) * HTB)
#define PG8_SB(b, h) ((4 + (b) * 2 + (h)) * HTB)
#define PG8_STAGE(bufoff, gbase, voff) do { _Pragma("unroll") for (int _i = 0; _i < 2; ++_i) \
        __builtin_amdgcn_global_load_lds((const unsigned*)((const char*)(gbase) + (voff)[_i]), (PG8_LAS unsigned*)(lds + (bufoff) + ldsw + _i * 8192), 16, 0, 0); } while (0)
#define PG8_LDA(dst, b, h) do { _Pragma("unroll") for (int m = 0; m < 4; ++m) _Pragma("unroll") for (int k = 0; k < 2; ++k) dst[m][k] = *(const PG8_LAS bf16x8*)(lds + PG8_SA(b, h) + aoff + m * 2048 + k * 1024); } while (0)
#define PG8_LDB(dst, b, h) do { _Pragma("unroll") for (int n = 0; n < 2; ++n) _Pragma("unroll") for (int k = 0; k < 2; ++k) dst[n][k] = *(const PG8_LAS bf16x8*)(lds + PG8_SB(b, h) + boff + n * 2048 + k * 1024); } while (0)
#define PG8_MMA(ai, bj, At, Bt) do { __builtin_amdgcn_s_setprio(1); _Pragma("unroll") for (int m = 0; m < 4; ++m) _Pragma("unroll") for (int n = 0; n < 2; ++n) _Pragma("unroll") for (int k = 0; k < 2; ++k) \
        acc[ai][bj][m][n] = __builtin_amdgcn_mfma_f32_16x16x32_bf16(Bt[n][k], At[m][k], acc[ai][bj][m][n], 0, 0, 0); __builtin_amdgcn_s_setprio(0); } while (0)
#define PG8_WAIT_V(n) asm volatile("s_waitcnt vmcnt(" #n ")" ::: "memory")
#define PG8_WAIT_L(n) asm volatile("s_waitcnt lgkmcnt(" #n ")" ::: "memory")
#define PG8_BAR __builtin_amdgcn_s_barrier()
#define PG8_SCHED __builtin_amdgcn_sched_barrier(0)
    Unit cur, nxt; int ui = 0;
    if (!S.next(0, cur)) return;
    f32x4 acc[2][2][4][2];
#pragma unroll
    for (int a = 0; a < 2; ++a)
#pragma unroll
        for (int b = 0; b < 2; ++b)
#pragma unroll
            for (int m = 0; m < 4; ++m)
#pragma unroll
                for (int n = 0; n < 2; ++n) acc[a][b][m][n] = (f32x4){0.f, 0.f, 0.f, 0.f};
    bf16x8 At[4][2], B0[2][2], B1[2][2];
    const char* cA = (const char*)g.A + (size_t)cur.pm * tstepA; const char* cB = (const char*)g.Bt + (size_t)cur.pn * tstepB;
    S.a_ready(cur);
    if constexpr (SP2) {
        PG8_STAGE(PG8_SB(0, 0), cB, voffB); PG8_STAGE(PG8_SB(0, 1), cB + hstepB, voffB); PG8_STAGE(PG8_SA(0, 0), cA, voffA); PG8_STAGE(PG8_SA(0, 1), cA + hstepA, voffA);
        if (wr == 1) PG8_BAR;
        PG8_WAIT_V(2); PG8_BAR;
        PG8_STAGE(PG8_SB(1, 0), cB + kstep, voffB); PG8_STAGE(PG8_SA(1, 0), cA + kstep, voffA); PG8_STAGE(PG8_SB(1, 1), cB + hstepB + kstep, voffB);
        PG8_WAIT_V(6); PG8_BAR;
    } else {
        PG8_STAGE(PG8_SB(0, 0), cB, voffB); PG8_STAGE(PG8_SA(0, 0), cA, voffA); PG8_STAGE(PG8_SB(0, 1), cB + hstepB, voffB); PG8_STAGE(PG8_SA(0, 1), cA + hstepA, voffA);
        if (wr == 1) PG8_BAR;
        PG8_WAIT_V(4); PG8_BAR;
        PG8_STAGE(PG8_SB(1, 0), cB + kstep, voffB); PG8_STAGE(PG8_SA(1, 0), cA + kstep, voffA); PG8_STAGE(PG8_SB(1, 1), cB + hstepB + kstep, voffB);
        PG8_WAIT_V(6); PG8_BAR;
    }
    for (;;) {
        const bool has_next = S.next(ui + 1, nxt);
        const char* nA = has_next ? (const char*)g.A + (size_t)nxt.pm * tstepA : cA; const char* nB = has_next ? (const char*)g.Bt + (size_t)nxt.pn * tstepB : cB;
        for (int t = 0; t < nt; t += 2) {
            const bool last = (t == nt - 2);
            const char* a1 = cA + (size_t)(t + 1) * kstep;
            const char* a2 = last ? nA : cA + (size_t)(t + 2) * kstep; const char* b2 = last ? nB : cB + (size_t)(t + 2) * kstep;
            const char* a3 = a2 + kstep; const char* b3 = b2 + kstep;
            if (last && has_next) S.a_ready(nxt);
            if constexpr (SP2) {
            PG8_LDB(B0, 0, 0); PG8_LDB(B1, 0, 1); PG8_SCHED; PG8_LDA(At, 0, 0); PG8_STAGE(PG8_SA(1, 1), a1 + hstepA, voffA);
            PG8_WAIT_V(8); PG8_WAIT_L(0); PG8_BAR; PG8_MMA(0, 0, At, B0); PG8_MMA(0, 1, At, B1); PG8_BAR; PG8_SCHED;
            PG8_LDA(At, 0, 1); PG8_STAGE(PG8_SB(0, 0), b2, voffB); PG8_STAGE(PG8_SB(0, 1), b2 + hstepB, voffB); PG8_STAGE(PG8_SA(0, 0), a2, voffA);
            PG8_WAIT_V(8); PG8_WAIT_L(0); PG8_BAR; PG8_MMA(1, 0, At, B0); PG8_MMA(1, 1, At, B1); PG8_BAR; PG8_SCHED;
            PG8_LDB(B0, 1, 0); PG8_LDB(B1, 1, 1); PG8_SCHED; PG8_LDA(At, 1, 0); PG8_STAGE(PG8_SA(0, 1), a2 + hstepA, voffA);
            PG8_WAIT_V(8); PG8_WAIT_L(0); PG8_BAR; PG8_MMA(0, 0, At, B0); PG8_MMA(0, 1, At, B1); PG8_BAR; PG8_SCHED;
            PG8_LDA(At, 1, 1); PG8_STAGE(PG8_SB(1, 0), b3, voffB); PG8_STAGE(PG8_SB(1, 1), b3 + hstepB, voffB); PG8_STAGE(PG8_SA(1, 0), a3, voffA);
            PG8_WAIT_V(8); PG8_WAIT_L(0); PG8_BAR; PG8_MMA(1, 0, At, B0); PG8_MMA(1, 1, At, B1); PG8_BAR; PG8_SCHED;
            } else {
            PG8_LDB(B0, 0, 0); PG8_SCHED; PG8_LDA(At, 0, 0); PG8_STAGE(PG8_SA(1, 1), a1 + hstepA, voffA);
            PG8_WAIT_L(8); PG8_BAR; PG8_WAIT_L(0); PG8_MMA(0, 0, At, B0); PG8_BAR; PG8_SCHED;
            PG8_LDB(B1, 0, 1); PG8_STAGE(PG8_SB(0, 0), b2, voffB);
            PG8_BAR; PG8_WAIT_L(0); PG8_MMA(0, 1, At, B1); PG8_BAR;
            PG8_LDA(At, 0, 1); PG8_STAGE(PG8_SA(0, 0), a2, voffA);
            PG8_BAR; PG8_WAIT_L(0); PG8_MMA(1, 0, At, B0); PG8_BAR; PG8_SCHED;
            PG8_STAGE(PG8_SB(0, 1), b2 + hstepB, voffB);
            PG8_WAIT_V(6); PG8_BAR; PG8_MMA(1, 1, At, B1); PG8_BAR;
            PG8_LDB(B0, 1, 0); PG8_SCHED; PG8_LDA(At, 1, 0); PG8_STAGE(PG8_SA(0, 1), a2 + hstepA, voffA);
            PG8_WAIT_L(8); PG8_BAR; PG8_WAIT_L(0); PG8_MMA(0, 0, At, B0); PG8_BAR; PG8_SCHED;
            PG8_LDB(B1, 1, 1); PG8_STAGE(PG8_SB(1, 0), b3, voffB);
            PG8_BAR; PG8_WAIT_L(0); PG8_MMA(0, 1, At, B1); PG8_BAR;
            PG8_LDA(At, 1, 1); PG8_STAGE(PG8_SA(1, 0), a3, voffA);
            PG8_BAR; PG8_WAIT_L(0); PG8_MMA(1, 0, At, B0); PG8_BAR; PG8_SCHED;
            PG8_STAGE(PG8_SB(1, 1), b3 + hstepB, voffB);
            PG8_WAIT_V(6); PG8_BAR; PG8_MMA(1, 1, At, B1); PG8_BAR;
            }
        }
        if constexpr (ALIGN_EPI) { if (wr == 0) PG8_BAR; }
        if constexpr (!Epi::AFTER_DRAIN) { E(acc, cur, wr, wc, fr, fq); S.done(cur); }
        if (!has_next) break;
#pragma unroll
        for (int a = 0; a < 2; ++a)
#pragma unroll
            for (int b = 0; b < 2; ++b)
#pragma unroll
                for (int m = 0; m < 4; ++m)
#pragma unroll
                    for (int n = 0; n < 2; ++n) acc[a][b][m][n] = (f32x4){0.f, 0.f, 0.f, 0.f};
        cur = nxt; cA = nA; cB = nB; ++ui;
        if constexpr (ALIGN_EPI) { if (wr == 1) PG8_BAR; }
    }
    PG8_WAIT_V(0);
    if constexpr (!ALIGN_EPI) { if (wr == 0) PG8_BAR; }
    PG8_BAR;
    if constexpr (Epi::AFTER_DRAIN) { E.fused(acc, cur, wr, wc, fr, fq, lds, wid, lane); S.done(cur); }
#undef PG8_SA
#undef PG8_SB
#undef PG8_STAGE
#undef PG8_LDA
#undef PG8_LDB
#undef PG8_MMA
#undef PG8_WAIT_V
#undef PG8_WAIT_L
#undef PG8_BAR
#undef PG8_SCHED
}
}
namespace cf {
constexpr int D = 1024, NB = 4, SEQ = 4096, M = NB * SEQ;
constexpr int DFF = 2816, NSHIFT = 3328;
constexpr float ALPHA = 1.41421356237309515f;
constexpr float LN_EPS = 1e-5f, GN_EPS = 64e-5f;
constexpr size_t MiB = 1u << 20;
}
typedef unsigned short bf16_t;
typedef float f32x4 __attribute__((ext_vector_type(4)));
typedef unsigned u32x4 __attribute__((ext_vector_type(4)));
typedef unsigned u32x2 __attribute__((ext_vector_type(2)));

__device__ __forceinline__ unsigned f2bf(float f) { unsigned u = __builtin_bit_cast(unsigned, f); return (u + 0x7fffu + ((u >> 16) & 1u)) >> 16; }
__device__ __forceinline__ unsigned pk2(float lo, float hi) { return f2bf(lo) | (f2bf(hi) << 16); }
__device__ __forceinline__ float bf2f(unsigned short b) { return __builtin_bit_cast(float, ((unsigned)b) << 16); }
__device__ __forceinline__ float bflo(unsigned w) { return __builtin_bit_cast(float, w << 16); }
__device__ __forceinline__ float bfhi(unsigned w) { return __builtin_bit_cast(float, w & 0xffff0000u); }
__device__ __forceinline__ float sigmoidf_(float x) { return 1.0f / (1.0f + __expf(-x)); }
__device__ __forceinline__ float tanhf_(float x) { const float e = __expf(2.0f * x); return 1.0f - 2.0f / (e + 1.0f); }
__device__ __forceinline__ float gelu_tanh(float x) { const float u = 0.7978845608028654f * (x + 0.044715f * x * x * x); return 0.5f * x * (1.0f + tanhf_(u)); }
__device__ __forceinline__ float silu_(float x) { return x / (1.0f + __expf(-x)); }
__device__ __forceinline__ float wave_sum(float v) {
#pragma unroll
    for (int o = 1; o < 64; o <<= 1) v += __shfl_xor(v, o);
    return v;
}
__device__ __forceinline__ float wave_max(float v) {
#pragma unroll
    for (int o = 1; o < 64; o <<= 1) v = fmaxf(v, __shfl_xor(v, o));
    return v;
}

namespace pg8 {
struct EpiIn {
    static constexpr bool PERM = true, AFTER_DRAIN = false;
    bf16_t *XA, *GA, *Q, *K, *V, *ZC, *ZV1; const float* cs;
    __device__ __forceinline__ void operator()(const f32x4 (&acc)[2][2][4][2], const Unit& u, int wr, int wc, int fr, int fq) const {
        const int pn = u.pn; bf16_t* dst; int ldc, colt, mode;
        if (pn < 4) { dst = XA; ldc = 1024; colt = pn * 256; mode = 0; }
        else if (pn < 8) { dst = GA; ldc = 1024; colt = (pn - 4) * 256; mode = 1; }
        else if (pn < 11) { dst = Q; ldc = 768; colt = (pn - 8) * 256; mode = 2; }
        else if (pn < 14) { dst = K; ldc = 768; colt = (pn - 11) * 256; mode = 3; }
        else if (pn < 17) { dst = V; ldc = 768; colt = (pn - 14) * 256; mode = 0; }
        else if (pn < 30) { dst = ZC; ldc = 3328; colt = (pn - 17) * 256; mode = 0; }
        else { dst = ZV1; ldc = 32; colt = 0; mode = 4; }
        const int row0 = u.pm * BM + wr * 64 + fr;
        const bool rot = (mode == 2 || mode == 3) && ((wc & 1) == 0);
        const float sgn = (fq == 0) ? -1.0f : 1.0f; const bool rl = fq < 2;
#pragma unroll
        for (int ai = 0; ai < 2; ++ai)
#pragma unroll
            for (int m = 0; m < 4; ++m) {
                const int row = row0 + ai * HALF + m * 16;
                f32x4 c0 = {1.f, 1.f, 1.f, 1.f}, c1 = c0, s0 = {0.f, 0.f, 0.f, 0.f}, s1 = s0;
                if (rot) { const f32x4* p = (const f32x4*)(cs + (size_t)row * 16); c0 = p[0]; c1 = p[1]; s0 = p[2]; s1 = p[3]; }
#pragma unroll
                for (int bj = 0; bj < 2; ++bj) {
                    f32x4 v0 = acc[ai][bj][m][0], v1 = acc[ai][bj][m][1];
                    if (mode == 1) {
#pragma unroll
                        for (int j = 0; j < 4; ++j) { v0[j] = gelu_tanh(v0[j]); v1[j] = gelu_tanh(v1[j]); }
                    }
                    if (rot) {
                        f32x4 p0, p1;
#pragma unroll
                        for (int j = 0; j < 4; ++j) { p0[j] = __shfl_xor(v0[j], 16); p1[j] = __shfl_xor(v1[j], 16); }
                        if (rl) { v0 = v0 * c0 + (p0 * s0) * sgn; v1 = v1 * c1 + (p1 * s1) * sgn; }
                    }
                    if (mode == 2) { v0 = v0 * 0.125f; v1 = v1 * 0.125f; }
                    u32x4 w; w.x = cvt_pk_bf16(v0[0], v0[1]); w.y = cvt_pk_bf16(v0[2], v0[3]); w.z = cvt_pk_bf16(v1[0], v1[1]); w.w = cvt_pk_bf16(v1[2], v1[3]);
                    const int col = colt + bj * HALF + wc * 32 + 8 * fq;
                    if (mode != 4 || (bj == 0 && wc == 0)) *(u32x4*)(dst + (size_t)row * ldc + col) = w;
                }
            }
    }
};
template <int ACT  > struct EpiBf16 {
    static constexpr bool PERM = true, AFTER_DRAIN = false;
    bf16_t* O; int ldc; int pad_;
    __device__ __forceinline__ void operator()(const f32x4 (&acc)[2][2][4][2], const Unit& u, int wr, int wc, int fr, int fq) const {
        const int row0 = u.pm * BM + wr * 64 + fr, col0 = u.pn * BM + wc * 32 + 8 * fq;
#pragma unroll
        for (int ai = 0; ai < 2; ++ai)
#pragma unroll
            for (int m = 0; m < 4; ++m) { bf16_t* rowp = O + (size_t)(row0 + ai * HALF + m * 16) * ldc + col0;
#pragma unroll
                for (int bj = 0; bj < 2; ++bj) { f32x4 v0 = acc[ai][bj][m][0], v1 = acc[ai][bj][m][1];
                    if (ACT == 1) {
#pragma unroll
                        for (int j = 0; j < 4; ++j) { v0[j] = sigmoidf_(v0[j]); v1[j] = sigmoidf_(v1[j]); }
                    }
                    u32x4 w; w.x = cvt_pk_bf16(v0[0], v0[1]); w.y = cvt_pk_bf16(v0[2], v0[3]); w.z = cvt_pk_bf16(v1[0], v1[1]); w.w = cvt_pk_bf16(v1[2], v1[3]);
                    *(u32x4*)(rowp + bj * HALF) = w; } }
    }
};
struct EpiF32 {
    static constexpr bool PERM = false, AFTER_DRAIN = false;
    float* C; int ldc; int pad_;
    __device__ __forceinline__ void operator()(const f32x4 (&acc)[2][2][4][2], const Unit& u, int wr, int wc, int fr, int fq) const {
        const int row0 = u.pm * BM + wr * 64 + fr, col0 = u.pn * BM + wc * 32 + 4 * fq;
#pragma unroll
        for (int ai = 0; ai < 2; ++ai)
#pragma unroll
            for (int m = 0; m < 4; ++m) { float* rowp = C + (size_t)(row0 + ai * HALF + m * 16) * ldc + col0;
#pragma unroll
                for (int bj = 0; bj < 2; ++bj)
#pragma unroll
                    for (int n = 0; n < 2; ++n) *(f32x4*)(rowp + bj * HALF + n * 16) = acc[ai][bj][m][n]; }
    }
};
template <int ADD> struct EpiMerge {
    static constexpr bool PERM = true, AFTER_DRAIN = false;
    bf16_t* MG; const bf16_t* GT; int ldc; int pad_;
    __device__ __forceinline__ void operator()(const f32x4 (&acc)[2][2][4][2], const Unit& u, int wr, int wc, int fr, int fq) const {
        const int row0 = u.pm * BM + wr * 64 + fr, col0 = u.pn * BM + wc * 32 + 8 * fq;
#pragma unroll
        for (int ai = 0; ai < 2; ++ai)
#pragma unroll
            for (int m = 0; m < 4; ++m) { const size_t off = (size_t)(row0 + ai * HALF + m * 16) * ldc + col0;
#pragma unroll
                for (int bj = 0; bj < 2; ++bj) { f32x4 v0 = acc[ai][bj][m][0], v1 = acc[ai][bj][m][1];
                    const u32x4 gw = *(const u32x4*)(GT + off + bj * HALF);
                    v0[0] *= bflo(gw.x); v0[1] *= bfhi(gw.x); v0[2] *= bflo(gw.y); v0[3] *= bfhi(gw.y);
                    v1[0] *= bflo(gw.z); v1[1] *= bfhi(gw.z); v1[2] *= bflo(gw.w); v1[3] *= bfhi(gw.w);
                    if (ADD) { const u32x4 mw = *(const u32x4*)(MG + off + bj * HALF);
                        v0[0] += bflo(mw.x); v0[1] += bfhi(mw.x); v0[2] += bflo(mw.y); v0[3] += bfhi(mw.y);
                        v1[0] += bflo(mw.z); v1[1] += bfhi(mw.z); v1[2] += bflo(mw.w); v1[3] += bfhi(mw.w); }
                    u32x4 w; w.x = cvt_pk_bf16(v0[0], v0[1]); w.y = cvt_pk_bf16(v0[2], v0[3]); w.z = cvt_pk_bf16(v1[0], v1[1]); w.w = cvt_pk_bf16(v1[2], v1[3]);
                    *(u32x4*)(MG + off + bj * HALF) = w; } }
    }
};
}

constexpr int GEMM_LDS = 147456;
template <class Epi> __global__ __launch_bounds__(512, 2) void k_gemm(pg8::Gemm g, Epi E) {
    extern __shared__ __attribute__((aligned(16))) unsigned char shm[];
    pg8::StaticOrder S; S.init(g.M, g.N, (int)gridDim.x, (int)blockIdx.x);
    pg8::gemm_phase<Epi, pg8::StaticOrder, true, true>((PG8_LAS unsigned char*)shm, g, S, E);
}
__global__ __launch_bounds__(256) void k_mod(const float* __restrict__ c, const float* __restrict__ mod_w, const float* __restrict__ mod_b, float* __restrict__ mod) {
    __shared__ float sc[4 * 1024];
    const int l = blockIdx.y, n = blockIdx.x * 256 + threadIdx.x;
    for (int i = threadIdx.x; i < 4096; i += 256) sc[i] = silu_(c[i]);
    __syncthreads();
    const float* W = mod_w + (size_t)l * 1024 * 6144 + n;
    float a0 = 0.f, a1 = 0.f, a2 = 0.f, a3 = 0.f;
    for (int k = 0; k < 1024; ++k) { const float w = W[(size_t)k * 6144]; a0 += sc[k] * w; a1 += sc[1024 + k] * w; a2 += sc[2048 + k] * w; a3 += sc[3072 + k] * w; }
    const float bb = mod_b[l * 6144 + n];
    float* o = mod + (size_t)l * 4 * 6144 + n;
    o[0] = a0 + bb; o[6144] = a1 + bb; o[2 * 6144] = a2 + bb; o[3 * 6144] = a3 + bb;
}
__global__ __launch_bounds__(256) void k_rope(const int* __restrict__ pos, float* __restrict__ cs) {
    const int e = blockIdx.x * 256 + threadIdx.x;
    if (e >= cf::M * 8) return;
    const int m = e >> 3, i = e & 7;
    const float inv = powf(500000.0f, -(float)i / 8.0f);
    const float ang = (float)pos[m] * inv;
    cs[m * 16 + i] = cosf(ang); cs[m * 16 + 8 + i] = sinf(ang);
}
__global__ __launch_bounds__(256) void k_transpose(const float* __restrict__ W, int K, int Nsrc, int c0, int nc, bf16_t* __restrict__ WT, int r0) {
    __shared__ float scr_all[4 * 64 * 33];
    const int lane = threadIdx.x & 63, wave = threadIdx.x >> 6;
    float* scr = scr_all + wave * 64 * 33;
    const int nblk = nc / 32, nitems = (K / 64) * nblk;
    for (int item = blockIdx.x * 4 + wave; item < nitems; item += gridDim.x * 4) {
        const int kb = item / nblk, nb = item % nblk, k0 = 64 * kb, n0 = 32 * nb;
#pragma unroll 8
        for (int i = 0; i < 32; ++i) { const int kk = 2 * i + (lane >> 5); scr[kk * 33 + (lane & 31)] = W[(size_t)(k0 + kk) * Nsrc + c0 + n0 + (lane & 31)]; }
        __builtin_amdgcn_wave_barrier(); asm volatile("s_waitcnt lgkmcnt(0)" ::: "memory");
        const int c = lane & 7;
#pragma unroll
        for (int j = 0; j < 4; ++j) { const int n = (lane >> 3) + 8 * j; const float* s = scr + (8 * c) * 33 + n;
            u32x4 o; o.x = pk2(s[0 * 33], s[1 * 33]); o.y = pk2(s[2 * 33], s[3 * 33]); o.z = pk2(s[4 * 33], s[5 * 33]); o.w = pk2(s[6 * 33], s[7 * 33]);
            *(u32x4*)(WT + (size_t)(r0 + n0 + n) * K + k0 + 8 * c) = o; }
        __builtin_amdgcn_wave_barrier(); asm volatile("s_waitcnt lgkmcnt(0)" ::: "memory");
    }
}
__global__ __launch_bounds__(256) void k_zero16(u32x4* p, size_t n16) { for (size_t i = (size_t)blockIdx.x * 256 + threadIdx.x; i < n16; i += (size_t)gridDim.x * 256) p[i] = (u32x4){0u, 0u, 0u, 0u}; }
__global__ __launch_bounds__(256) void k_modulate(const float* __restrict__ x, const float* __restrict__ modl, int sh_off, int sc_off, bf16_t* __restrict__ h) {
    const size_t e4 = (size_t)blockIdx.x * 256 + threadIdx.x;
    if (e4 >= (size_t)cf::M * 256) return;
    const int m = (int)(e4 >> 8), c = (int)(e4 & 255) * 4, b = m / cf::SEQ;
    const f32x4 xv = *(const f32x4*)(x + (size_t)m * 1024 + c);
    const f32x4 sh = *(const f32x4*)(modl + b * 6144 + sh_off + c), sc = *(const f32x4*)(modl + b * 6144 + sc_off + c);
    const f32x4 o = xv * (sc + 1.0f) + sh;
    u32x2 w; w.x = pk2(o[0], o[1]); w.y = pk2(o[2], o[3]);
    *(u32x2*)(h + (size_t)m * 1024 + c) = w;
}
__global__ __launch_bounds__(256) void k_ln(const float* __restrict__ xin, const float* __restrict__ y, int m0, int nrows, const float* __restrict__ modl, int gt_off,
                                            const float* __restrict__ lw, const float* __restrict__ lb, float* __restrict__ xo,
                                            const float* __restrict__ modn, int shn_off, int scn_off, bf16_t* __restrict__ hn) {
    const int lane = threadIdx.x & 63, r = blockIdx.x * 4 + (threadIdx.x >> 6);
    if (r >= nrows) return;
    const int m = m0 + r, b = m / cf::SEQ;
    f32x4 v[4]; float s = 0.f;
#pragma unroll
    for (int j = 0; j < 4; ++j) { const int c = 4 * lane + 256 * j;
        const f32x4 xv = *(const f32x4*)(xin + (size_t)m * 1024 + c), yv = *(const f32x4*)(y + (size_t)r * 1024 + c), g = *(const f32x4*)(modl + b * 6144 + gt_off + c);
        v[j] = xv * cf::ALPHA + (g + 1.0f) * yv; s += (v[j][0] + v[j][1]) + (v[j][2] + v[j][3]); }
    const float mean = wave_sum(s) * (1.f / 1024.f); float s2 = 0.f;
#pragma unroll
    for (int j = 0; j < 4; ++j) { v[j] = v[j] - mean; s2 += (v[j][0] * v[j][0] + v[j][1] * v[j][1]) + (v[j][2] * v[j][2] + v[j][3] * v[j][3]); }
    const float rstd = 1.0f / sqrtf(wave_sum(s2) * (1.f / 1024.f) + cf::LN_EPS);
#pragma unroll
    for (int j = 0; j < 4; ++j) { const int c = 4 * lane + 256 * j;
        const f32x4 o = v[j] * rstd * *(const f32x4*)(lw + c) + *(const f32x4*)(lb + c);
        *(f32x4*)(xo + (size_t)m * 1024 + c) = o;
        if (hn) { const f32x4 sh = *(const f32x4*)(modn + b * 6144 + shn_off + c), sc = *(const f32x4*)(modn + b * 6144 + scn_off + c);
            const f32x4 hv = o * (sc + 1.0f) + sh; u32x2 w; w.x = pk2(hv[0], hv[1]); w.y = pk2(hv[2], hv[3]); *(u32x2*)(hn + (size_t)m * 1024 + c) = w; } }
}
__global__ __launch_bounds__(256) void k_convglu(const bf16_t* __restrict__ U, int nrows, const float* __restrict__ cw, const float* __restrict__ cb, bf16_t* __restrict__ S) {
    const size_t e = (size_t)blockIdx.x * 256 + threadIdx.x;
    if (e >= (size_t)nrows * 704) return;
    const int r = (int)(e / 704), c = (int)(e % 704) * 4, s = r % cf::SEQ;
    f32x4 g = *(const f32x4*)(cb + c), v = *(const f32x4*)(cb + 2816 + c);
#pragma unroll
    for (int j = 0; j < 3; ++j) if (s - j >= 0) {
        const u32x2 ug = *(const u32x2*)(U + (size_t)(r - j) * 5632 + c), uv = *(const u32x2*)(U + (size_t)(r - j) * 5632 + 2816 + c);
        const f32x4 wg = *(const f32x4*)(cw + j * 5632 + c), wv = *(const f32x4*)(cw + j * 5632 + 2816 + c);
        g[0] += wg[0] * bflo(ug.x); g[1] += wg[1] * bfhi(ug.x); g[2] += wg[2] * bflo(ug.y); g[3] += wg[3] * bfhi(ug.y);
        v[0] += wv[0] * bflo(uv.x); v[1] += wv[1] * bfhi(uv.x); v[2] += wv[2] * bflo(uv.y); v[3] += wv[3] * bfhi(uv.y); }
    u32x2 w; w.x = pk2(silu_(g[0]) * v[0], silu_(g[1]) * v[1]); w.y = pk2(silu_(g[2]) * v[2], silu_(g[3]) * v[3]);
    *(u32x2*)(S + (size_t)r * 2816 + c) = w;
}

struct LruArgs { const bf16_t* XA; bf16_t* GA  ; const float *cw, *cb, *wa, *ba, *wx, *bx, *lam; };
__global__ __launch_bounds__(512) void k_lru(LruArgs a) {
    __shared__ float xraw[67 * 64], xc[64 * 64], Bb[64 * 64]; float* Aa = xraw;
    const int b = blockIdx.x >> 4, g = blockIdx.x & 15, tid = threadIdx.x, j = tid & 63, tq = tid >> 6, gj = g * 64 + j;
    const float* wa = a.wa + (size_t)g * 4096 + j; const float* wx = a.wx + (size_t)g * 4096 + j;
    const float lamv = a.lam[gj]; const float c8 = 8.0f * (fmaxf(-lamv, 0.f) + log1pf(expf(-fabsf(lamv))));
    const float bav = a.ba[gj], bxv = a.bx[gj], cbv = a.cb[gj];
    float cwv[4];
#pragma unroll
    for (int q = 0; q < 4; ++q) cwv[q] = a.cw[q * 1024 + gj];
    float hstate = 0.f;
    for (int ch = 0; ch < cf::SEQ / 64; ++ch) {
        const int s0 = ch * 64; const size_t m0 = (size_t)b * cf::SEQ + s0;
        for (int e = tid; e < 67 * 64; e += 512) { const int r = e >> 6, cc = e & 63, s = s0 - 3 + r; xraw[e] = (s >= 0) ? bf2f(a.XA[((size_t)b * cf::SEQ + s) * 1024 + g * 64 + cc]) : 0.f; }
        __syncthreads();
        for (int e = tid; e < 64 * 64; e += 512) { const int tt = e >> 6;
            xc[e] = cbv + cwv[0] * xraw[(tt + 3) * 64 + j] + cwv[1] * xraw[(tt + 2) * 64 + j] + cwv[2] * xraw[(tt + 1) * 64 + j] + cwv[3] * xraw[tt * 64 + j]; }
        __syncthreads();
        float ar[8], ai[8];
#pragma unroll
        for (int q = 0; q < 8; ++q) { ar[q] = 0.f; ai[q] = 0.f; }
        for (int i = 0; i < 64; ++i) { const float wav = wa[i * 64], wxv = wx[i * 64];
#pragma unroll
            for (int q = 0; q < 8; ++q) { const float xv = xc[(tq * 8 + q) * 64 + i]; ar[q] += xv * wav; ai[q] += xv * wxv; } }
#pragma unroll
        for (int q = 0; q < 8; ++q) { const int tt = tq * 8 + q;
            const float r = sigmoidf_(ar[q] + bav), ig = sigmoidf_(ai[q] + bxv), la = -c8 * r;
            Aa[tt * 64 + j] = expf(la); Bb[tt * 64 + j] = sqrtf(-expm1f(2.0f * la)) * (ig * xc[tt * 64 + j]); }
        __syncthreads();
        if (tid < 64) { float h = hstate;
            for (int tt = 0; tt < 64; ++tt) { h = Aa[tt * 64 + j] * h + Bb[tt * 64 + j]; Bb[tt * 64 + j] = h; }
            hstate = h; }
        __syncthreads();
        for (int e = tid; e < 64 * 64; e += 512) { const int tt = e >> 6; bf16_t* p = a.GA + (m0 + tt) * 1024 + g * 64 + j; *p = (bf16_t)f2bf(Bb[e] * bf2f(*p)); }
        __syncthreads();
    }
}

__global__ __launch_bounds__(256) void k_attn(const bf16_t* __restrict__ Q, const bf16_t* __restrict__ K, const bf16_t* __restrict__ V, bf16_t* __restrict__ YB) {
    __shared__ float pbuf[4][3 * 132];
    const int m = blockIdx.x, hs = threadIdx.x >> 6, lane = threadIdx.x & 63, b = m / cf::SEQ, s = m % cf::SEQ;
    float* p = pbuf[hs];
    float sc[3][3]; float mx = -INFINITY;
#pragma unroll
    for (int g = 0; g < 3; ++g) {
        const int dil = (g == 0) ? 1 : (g == 1 ? 4 : 16), head = g * 4 + hs;
        float qf[64];
        { const u32x4* qp = (const u32x4*)(Q + (size_t)m * 768 + head * 64);
#pragma unroll
          for (int i = 0; i < 8; ++i) { const u32x4 w = qp[i]; qf[8 * i] = bflo(w.x); qf[8 * i + 1] = bfhi(w.x); qf[8 * i + 2] = bflo(w.y); qf[8 * i + 3] = bfhi(w.y); qf[8 * i + 4] = bflo(w.z); qf[8 * i + 5] = bfhi(w.z); qf[8 * i + 6] = bflo(w.w); qf[8 * i + 7] = bfhi(w.w); } }
#pragma unroll
        for (int r = 0; r < 3; ++r) {
            const int jj = lane + 64 * r; const int sk = s - dil * jj; float d = -INFINITY;
            if (jj <= 128 && sk >= 0) { const u32x4* kp = (const u32x4*)(K + ((size_t)b * cf::SEQ + sk) * 768 + head * 64); d = 0.f;
#pragma unroll
                for (int i = 0; i < 8; ++i) { const u32x4 w = kp[i]; d += qf[8 * i] * bflo(w.x) + qf[8 * i + 1] * bfhi(w.x) + qf[8 * i + 2] * bflo(w.y) + qf[8 * i + 3] * bfhi(w.y) + qf[8 * i + 4] * bflo(w.z) + qf[8 * i + 5] * bfhi(w.z) + qf[8 * i + 6] * bflo(w.w) + qf[8 * i + 7] * bfhi(w.w); } }
            sc[g][r] = d; mx = fmaxf(mx, d); }
    }
    mx = wave_max(mx);
    float sum = 0.f;
#pragma unroll
    for (int g = 0; g < 3; ++g)
#pragma unroll
        for (int r = 0; r < 3; ++r) { const int jj = lane + 64 * r; const float e = (sc[g][r] == -INFINITY) ? 0.f : __expf(sc[g][r] - mx); sum += e; if (jj <= 128) p[g * 132 + jj] = e; }
    sum = wave_sum(sum);
    __syncthreads();
    float o = 0.f;
#pragma unroll
    for (int g = 0; g < 3; ++g) {
        const int dil = (g == 0) ? 1 : (g == 1 ? 4 : 16), head = g * 4 + hs;
        const int nj = min(128, s / dil);
        const bf16_t* vp = V + ((size_t)b * cf::SEQ + s) * 768 + head * 64 + lane;
        for (int jj = 0; jj <= nj; ++jj) o += p[g * 132 + jj] * bf2f(vp[-(ptrdiff_t)jj * dil * 768]);
    }
    YB[(size_t)m * 256 + hs * 64 + lane] = (bf16_t)f2bf(o / sum);
}

struct WkvArgs {
    const bf16_t* ZC; const bf16_t* ZV1; bf16_t* VF; bf16_t* YC;
    const float *mu, *mu_v, *w0, *w2, *a0, *a2, *g2, *v0, *v2, *k_k, *k_a, *r_k, *lnw, *lnb;
    int layer; int pad_;
};
constexpr int WKV_TC = 32;
constexpr int WKV_LDS = (8 * WKV_TC * 64 + 2 * WKV_TC * 64 + WKV_TC * 128 + WKV_TC * 32 + WKV_TC) * 4;
__global__ __launch_bounds__(512) void k_wkv(WkvArgs a) {
    extern __shared__ __attribute__((aligned(16))) float sm[];
    constexpr int TC = WKV_TC;
    float* R = sm; float* Wd = R + TC * 64; float* Kp = Wd + TC * 64; float* Vv = Kp + TC * 64; float* KK = Vv + TC * 64; float* BB = KK + TC * 64; float* G = BB + TC * 64; float* Y = G + TC * 64;
    float* LW = Y + TC * 64; float* LA = LW + TC * 64; float* LG = LA + TC * 64; float* LV = LG + TC * 128; float* BD = LV + TC * 32;
    const int b = blockIdx.x >> 4, h = blockIdx.x & 15, tid = threadIdx.x, lane = tid & 63, wv = tid >> 6;
    const int hj = h * 64 + lane;
    const float w0v = a.w0[hj], a0v = a.a0[hj], kkv = a.k_k[hj], kav = a.k_a[hj], rkv = a.r_k[hj], lnwv = a.lnw[hj], lnbv = a.lnb[hj];
    const float v0v = a.layer ? a.v0[hj] : 0.f;
    const int rr = lane >> 3, cg = lane & 7, irow = wv * 8 + rr;
    float st[8];
#pragma unroll
    for (int c = 0; c < 8; ++c) st[c] = 0.f;
    const int ncol = a.layer ? 480 : 448;
    for (int ch = 0; ch < cf::SEQ / TC; ++ch) {
        const int s0 = ch * TC; const size_t m0 = (size_t)b * cf::SEQ + s0;
        for (int e = tid; e < TC * ncol; e += 512) {
            const int tt = e / ncol, col = e % ncol; const size_t m = m0 + tt; const bool hasp = (s0 + tt) > 0;
            if (col < 448) {
                int zcol; if (col < 192) zcol = (col >> 6) * 1024 + h * 64 + (col & 63); else zcol = 3072 + (col - 192);
                const float z = bf2f(a.ZC[m * 3328 + zcol]), zp = hasp ? bf2f(a.ZC[(m - 1) * 3328 + zcol]) : 0.f;
                const float zs = z + (zp - z) * a.mu[zcol];
                if (col < 64) R[tt * 64 + col] = zs; else if (col < 128) Kp[tt * 64 + col - 64] = zs; else if (col < 192) Vv[tt * 64 + col - 128] = zs;
                else if (col < 256) LW[tt * 64 + col - 192] = tanhf_(zs); else if (col < 320) LA[tt * 64 + col - 256] = zs; else LG[tt * 128 + col - 320] = sigmoidf_(zs);
            } else { const int i = col - 448;
                const float z = bf2f(a.ZV1[m * 32 + i]), zp = hasp ? bf2f(a.ZV1[(m - 1) * 32 + i]) : 0.f;
                LV[tt * 32 + i] = z + (zp - z) * a.mu_v[i]; }
        }
        __syncthreads();
        {
            float aw[4] = {0.f, 0.f, 0.f, 0.f}, aa[4] = {0.f, 0.f, 0.f, 0.f}, ag[4] = {0.f, 0.f, 0.f, 0.f}, av4[4] = {0.f, 0.f, 0.f, 0.f};
            for (int i = 0; i < 64; ++i) { const float w2v = a.w2[i * 1024 + hj], a2v = a.a2[i * 1024 + hj];
#pragma unroll
                for (int q = 0; q < 4; ++q) { const int tt = wv + 8 * q; aw[q] += LW[tt * 64 + i] * w2v; aa[q] += LA[tt * 64 + i] * a2v; } }
            for (int i = 0; i < 128; ++i) { const float g2v = a.g2[i * 1024 + hj];
#pragma unroll
                for (int q = 0; q < 4; ++q) ag[q] += LG[(wv + 8 * q) * 128 + i] * g2v; }
            if (a.layer) for (int i = 0; i < 32; ++i) { const float v2v = a.v2[i * 1024 + hj];
#pragma unroll
                for (int q = 0; q < 4; ++q) av4[q] += LV[(wv + 8 * q) * 32 + i] * v2v; }
#pragma unroll
            for (int q = 0; q < 4; ++q) { const int tt = wv + 8 * q; const size_t m = m0 + tt;
                const float wl = w0v + aw[q]; const float sp = fmaxf(-wl, 0.f) + log1pf(expf(-fabsf(wl)));
                const float decay = expf(-expf(-sp - 0.5f));
                const float av = sigmoidf_(a0v + aa[q]);
                const float rv = R[tt * 64 + lane], kr = Kp[tt * 64 + lane], vr = Vv[tt * 64 + lane];
                float v;
                if (a.layer == 0) { a.VF[m * 1024 + hj] = (bf16_t)f2bf(vr); v = vr; }
                else { const float vf = bf2f(a.VF[m * 1024 + hj]); v = vr + (vf - vr) * sigmoidf_(v0v + av4[q]); }
                const float kkr = kr * kkv; const float ss = wave_sum(kkr * kkr); const float kk = kkr * rsqrtf(ss + 1e-12f);
                const float kp = kr * (1.0f + (av - 1.0f) * kav);
                const float bd = wave_sum(rv * kp * rkv);
                Wd[tt * 64 + lane] = decay; Kp[tt * 64 + lane] = kp; Vv[tt * 64 + lane] = v; KK[tt * 64 + lane] = kk; BB[tt * 64 + lane] = kk * av; G[tt * 64 + lane] = ag[q];
                if (lane == 0) BD[tt] = bd; }
        }
        __syncthreads();
        for (int tt = 0; tt < TC; ++tt) {
            const f32x4* pk = (const f32x4*)(KK + tt * 64 + 8 * cg); const f32x4* pw = (const f32x4*)(Wd + tt * 64 + 8 * cg); const f32x4* pb = (const f32x4*)(BB + tt * 64 + 8 * cg);
            const f32x4* pkp = (const f32x4*)(Kp + tt * 64 + 8 * cg); const f32x4* pr = (const f32x4*)(R + tt * 64 + 8 * cg);
            const f32x4 k0 = pk[0], k1 = pk[1], w0_ = pw[0], w1_ = pw[1], b0 = pb[0], b1 = pb[1], q0 = pkp[0], q1 = pkp[1], r0 = pr[0], r1 = pr[1];
            const float vi = Vv[tt * 64 + irow];
            float p = (st[0] * k0[0] + st[1] * k0[1]) + (st[2] * k0[2] + st[3] * k0[3]) + (st[4] * k1[0] + st[5] * k1[1]) + (st[6] * k1[2] + st[7] * k1[3]);
            p += __shfl_xor(p, 1); p += __shfl_xor(p, 2); p += __shfl_xor(p, 4);
            const float sa = -p;
            st[0] = st[0] * w0_[0] + sa * b0[0] + vi * q0[0]; st[1] = st[1] * w0_[1] + sa * b0[1] + vi * q0[1]; st[2] = st[2] * w0_[2] + sa * b0[2] + vi * q0[2]; st[3] = st[3] * w0_[3] + sa * b0[3] + vi * q0[3];
            st[4] = st[4] * w1_[0] + sa * b1[0] + vi * q1[0]; st[5] = st[5] * w1_[1] + sa * b1[1] + vi * q1[1]; st[6] = st[6] * w1_[2] + sa * b1[2] + vi * q1[2]; st[7] = st[7] * w1_[3] + sa * b1[3] + vi * q1[3];
            float yq = (st[0] * r0[0] + st[1] * r0[1]) + (st[2] * r0[2] + st[3] * r0[3]) + (st[4] * r1[0] + st[5] * r1[1]) + (st[6] * r1[2] + st[7] * r1[3]);
            yq += __shfl_xor(yq, 1); yq += __shfl_xor(yq, 2); yq += __shfl_xor(yq, 4);
            if (cg == 0) Y[tt * 64 + irow] = yq;
        }
        __syncthreads();
#pragma unroll
        for (int q = 0; q < 4; ++q) { const int tt = wv + 8 * q; const size_t m = m0 + tt;
            const float y = Y[tt * 64 + lane]; const float mu = wave_sum(y) * (1.f / 64.f); const float d = y - mu; const float var = wave_sum(d * d) * (1.f / 64.f);
            const float o = (d * rsqrtf(var + cf::GN_EPS) * lnwv + lnbv + BD[tt] * Vv[tt * 64 + lane]) * G[tt * 64 + lane];
            a.YC[m * 1024 + hj] = (bf16_t)f2bf(o); }
        __syncthreads();
    }
}
namespace wsmap {
using cf::MiB;
constexpr size_t CTL = 0, MOD = 1 * MiB, CS = MiB + MiB / 2, H = 3 * MiB, VF = 35 * MiB, W = 67 * MiB, AR = 84 * MiB;
constexpr size_t XA = AR, GA = AR + 32 * MiB, Q = AR + 64 * MiB, K = AR + 88 * MiB, V = AR + 112 * MiB, ZC = AR + 136 * MiB, ZV1 = AR + 240 * MiB, YB = AR + 241 * MiB;
constexpr size_t GT = Q, MG = AR + 96 * MiB, YO = AR + 128 * MiB;
constexpr size_t U = AR, SS = AR + 88 * MiB, YF = AR + 132 * MiB;
constexpr size_t W_G = W, W_PA = W + 6 * MiB, W_PB = W + 8 * MiB, W_PC = W + 8 * MiB + MiB / 2, W_O = W + 10 * MiB + MiB / 2;
constexpr size_t W_UP = W, W_DN = W + 11 * MiB;
}
template <class Epi> static void launch_gemm(const bf16_t* A, int lda, const bf16_t* Bt, int M, int N, int K, Epi E, hipStream_t st) {
    static bool attr = false;
    if (!attr) { (void)hipFuncSetAttribute((const void*)k_gemm<Epi>, hipFuncAttributeMaxDynamicSharedMemorySize, GEMM_LDS); attr = true; }
    pg8::Gemm g{}; g.A = A; g.Bt = Bt; g.M = M; g.N = N; g.K = K; g.lda = lda;
    hipLaunchKernelGGL(k_gemm<Epi>, dim3(256), dim3(512), GEMM_LDS, st, g, E);
}
static void launch_transpose(const float* W, int K, int Nsrc, int c0, int nc, bf16_t* WT, int r0, hipStream_t st) {
    const int nitems = (K / 64) * (nc / 32); int nb = (nitems + 3) / 4; if (nb > 2048) nb = 2048;
    hipLaunchKernelGGL(k_transpose, dim3(nb), dim3(256), 0, st, W, K, Nsrc, c0, nc, WT, r0);
}
extern "C" void kernel_launch(void* const* d_in, const int* in_sizes, int n_in, void* d_out, int out_size, void* d_ws, size_t ws_size, hipStream_t stream) {
    using namespace wsmap;
    static bool attr = false;
    if (!attr) { (void)hipFuncSetAttribute((const void*)k_wkv, hipFuncAttributeMaxDynamicSharedMemorySize, WKV_LDS); attr = true; }
    unsigned char* ws = (unsigned char*)d_ws;
    auto F = [&](int i) { return (const float*)d_in[i]; };
    float* X = (float*)d_out; float* mod = (float*)(ws + MOD); float* cs = (float*)(ws + CS);
    bf16_t* Hb = (bf16_t*)(ws + H); bf16_t* VFb = (bf16_t*)(ws + VF);
    (void)hipMemsetAsync(ws + CTL, 0, MiB, stream);
    hipLaunchKernelGGL(k_mod, dim3(24, 2), dim3(256), 0, stream, F(1), F(3), F(4), mod);
    hipLaunchKernelGGL(k_rope, dim3(cf::M * 8 / 256), dim3(256), 0, stream, (const int*)d_in[2], cs);
    for (int l = 0; l < 2; ++l) {
        const float* modl = mod + (size_t)l * 4 * 6144;
        bf16_t* WinT = (bf16_t*)(ws + W);
        launch_transpose(F(5) + (size_t)l * 1024 * 10752, 1024, 10752, 0, 7680, WinT, 0, stream);
        if (l == 1) { launch_transpose(F(6), 1024, 32, 0, 32, WinT, 7680, stream);
            hipLaunchKernelGGL(k_zero16, dim3(64), dim3(256), 0, stream, (u32x4*)(WinT + (size_t)7712 * 1024), (size_t)224 * 1024 * 2 / 16); }
        if (l == 0) hipLaunchKernelGGL(k_modulate, dim3(cf::M), dim3(256), 0, stream, F(0), modl, 0, 1024, Hb);
        { pg8::EpiIn E{}; E.XA = (bf16_t*)(ws + XA); E.GA = (bf16_t*)(ws + GA); E.Q = (bf16_t*)(ws + Q); E.K = (bf16_t*)(ws + K); E.V = (bf16_t*)(ws + V); E.ZC = (bf16_t*)(ws + ZC); E.ZV1 = (bf16_t*)(ws + ZV1); E.cs = cs;
          launch_gemm(Hb, 1024, WinT, cf::M, (30 + l) * 256, 1024, E, stream); }
        { LruArgs a{}; a.XA = (const bf16_t*)(ws + XA); a.GA = (bf16_t*)(ws + GA); a.cw = F(7) + l * 4096; a.cb = F(8) + l * 1024; a.wa = F(9) + l * 65536; a.ba = F(10) + l * 1024; a.wx = F(11) + l * 65536; a.bx = F(12) + l * 1024; a.lam = F(13) + l * 1024;
          hipLaunchKernelGGL(k_lru, dim3(64), dim3(512), 0, stream, a); }
        hipLaunchKernelGGL(k_attn, dim3(cf::M), dim3(256), 0, stream, (const bf16_t*)(ws + Q), (const bf16_t*)(ws + K), (const bf16_t*)(ws + V), (bf16_t*)(ws + YB));
        { WkvArgs a{}; a.ZC = (const bf16_t*)(ws + ZC); a.ZV1 = (const bf16_t*)(ws + ZV1); a.VF = VFb; a.YC = (bf16_t*)(ws + XA);
          a.mu = F(14) + l * 3328; a.mu_v = F(15); a.w0 = F(16) + l * 1024; a.w2 = F(17) + l * 65536; a.a0 = F(18) + l * 1024; a.a2 = F(19) + l * 65536; a.g2 = F(20) + l * 131072; a.v0 = F(21); a.v2 = F(22);
          a.k_k = F(23) + l * 1024; a.k_a = F(24) + l * 1024; a.r_k = F(25) + l * 1024; a.lnw = F(26) + l * 1024; a.lnb = F(27) + l * 1024; a.layer = l;
          hipLaunchKernelGGL(k_wkv, dim3(64), dim3(512), WKV_LDS, stream, a); }
        launch_transpose(F(5) + (size_t)l * 1024 * 10752, 1024, 10752, 7680, 3072, (bf16_t*)(ws + W_G), 0, stream);
        launch_transpose(F(28) + (size_t)l * 1024 * 1024, 1024, 1024, 0, 1024, (bf16_t*)(ws + W_PA), 0, stream);
        launch_transpose(F(29) + (size_t)l * 256 * 1024, 256, 1024, 0, 1024, (bf16_t*)(ws + W_PB), 0, stream);
        launch_transpose(F(30) + (size_t)l * 1024 * 1024, 1024, 1024, 0, 1024, (bf16_t*)(ws + W_PC), 0, stream);
        launch_transpose(F(31) + (size_t)l * 1024 * 1024, 1024, 1024, 0, 1024, (bf16_t*)(ws + W_O), 0, stream);
        for (int br = 0; br < 3; ++br) {
            pg8::EpiBf16<1> Eg{}; Eg.O = (bf16_t*)(ws + GT); Eg.ldc = 1024;
            launch_gemm(Hb, 1024, (const bf16_t*)(ws + W_G) + (size_t)br * 1024 * 1024, cf::M, 1024, 1024, Eg, stream);
            const bf16_t* Y = (const bf16_t*)(ws + (br == 0 ? GA : (br == 1 ? YB : XA))); const bf16_t* P = (const bf16_t*)(ws + (br == 0 ? W_PA : (br == 1 ? W_PB : W_PC))); const int Kb = (br == 1) ? 256 : 1024;
            if (br == 0) { pg8::EpiMerge<0> Em{}; Em.MG = (bf16_t*)(ws + MG); Em.GT = (const bf16_t*)(ws + GT); Em.ldc = 1024; launch_gemm(Y, Kb, P, cf::M, 1024, Kb, Em, stream); }
            else { pg8::EpiMerge<1> Em{}; Em.MG = (bf16_t*)(ws + MG); Em.GT = (const bf16_t*)(ws + GT); Em.ldc = 1024; launch_gemm(Y, Kb, P, cf::M, 1024, Kb, Em, stream); }
        }
        { pg8::EpiF32 E{}; E.C = (float*)(ws + YO); E.ldc = 1024; launch_gemm((const bf16_t*)(ws + MG), 1024, (const bf16_t*)(ws + W_O), cf::M, 1024, 1024, E, stream); }
        hipLaunchKernelGGL(k_ln, dim3(cf::M / 4), dim3(256), 0, stream, l == 0 ? F(0) : (const float*)X, (const float*)(ws + YO), 0, cf::M, modl, 2048, F(32) + l * 1024, F(33) + l * 1024, X, modl, 3072, 4096, Hb);
        launch_transpose(F(34) + (size_t)l * 1024 * 5632, 1024, 5632, 0, 5632, (bf16_t*)(ws + W_UP), 0, stream);
        launch_transpose(F(37) + (size_t)l * 2816 * 1024, 2816, 1024, 0, 1024, (bf16_t*)(ws + W_DN), 0, stream);
        for (int hf = 0; hf < 2; ++hf) {
            const int m0 = hf * 8192;
            { pg8::EpiBf16<0> E{}; E.O = (bf16_t*)(ws + U); E.ldc = 5632; launch_gemm(Hb + (size_t)m0 * 1024, 1024, (const bf16_t*)(ws + W_UP), 8192, 5632, 1024, E, stream); }
            hipLaunchKernelGGL(k_convglu, dim3(8192 * 704 / 256), dim3(256), 0, stream, (const bf16_t*)(ws + U), 8192, F(35) + l * 3 * 5632, F(36) + l * 5632, (bf16_t*)(ws + SS));
            { pg8::EpiF32 E{}; E.C = (float*)(ws + YF); E.ldc = 1024; launch_gemm((const bf16_t*)(ws + SS), 2816, (const bf16_t*)(ws + W_DN), 8192, 1024, 2816, E, stream); }
            hipLaunchKernelGGL(k_ln, dim3(8192 / 4), dim3(256), 0, stream, (const float*)X, (const float*)(ws + YF), m0, 8192, modl, 5120, F(38) + l * 1024, F(39) + l * 1024, X,
                               (const float*)(l == 0 ? mod + 4 * 6144 : mod), 0, 1024, l == 0 ? Hb : (bf16_t*)nullptr);
        }
    }
}
```

```cpp
#include <hip/hip_runtime.h>
#include <cstdio>
#include <cstdint>
namespace pg8 {
#define PG8_LAS __attribute__((address_space(3)))
typedef unsigned short bf16_t;
typedef short bf16x8 __attribute__((ext_vector_type(8)));
typedef float f32x4 __attribute__((ext_vector_type(4)));
typedef unsigned u32x4 __attribute__((ext_vector_type(4)));
typedef unsigned u32x2 __attribute__((ext_vector_type(2)));
constexpr int BM = 256, BK = 64, HALF = 128, HTB = HALF * BK * 2, STAGE_BYTES = 8 * HTB, NXCD = 8, WGM = 8;

__host__ __device__ __forceinline__ int lds_byte(int r, int c) { const int st = (r >> 4) * 2 + (c >> 5), rr = r & 15, cc = c & 31, ob = rr * 64 + cc * 2; return st * 1024 + (ob ^ (((ob >> 9) & 1) << 5)); }
__host__ __device__ __forceinline__ void stage_rc(int b, int& R, int& C) { const int st = b / 1024, sb = b % 1024, swz = sb ^ (((sb >> 9) & 1) << 5); R = (st >> 1) * 16 + swz / 64; C = (st & 1) * 32 + (swz % 64) / 2; }
__host__ __device__ __forceinline__ int perm32(int rho) { const int n = rho >> 4, i = rho & 15; return 8 * (i >> 2) + 4 * n + (i & 3); }

struct Unit { int pm, pn; };
struct Gemm { const bf16_t* A; const bf16_t* Bt; int M, N, K, lda; };

struct StaticOrder {
    int nM, nN, nwg, G, c;
    __host__ __device__ void init(int M, int N, int G_, int c_) { nM = M / BM; nN = N / BM; nwg = nM * nN; G = G_; c = c_; }
    __host__ __device__ bool next(int i, Unit& u) const {
        const long L = (long)i * G + c; if (L >= nwg) return false;
        int wgid = (int)L; { const int q = nwg / NXCD, r = nwg % NXCD, xcd = wgid % NXCD, off = wgid / NXCD; wgid = (xcd < r ? xcd * (q + 1) : r * (q + 1) + (xcd - r) * q) + off; }
        const int nig = WGM * nN, gid = wgid / nig, fm = gid * WGM, gsz = (nM - fm) < WGM ? (nM - fm) : WGM;
        u.pm = fm + ((wgid % nig) % gsz); u.pn = (wgid % nig) / gsz; return true;
    }
    __device__ __forceinline__ void a_ready(const Unit&) const {}
    __device__ __forceinline__ void done(const Unit&) const {}
};

__device__ __forceinline__ unsigned cvt_pk_bf16(float lo, float hi) { unsigned r; asm volatile("v_cvt_pk_bf16_f32 %0, %1, %2" : "=v"(r) : "v"(lo), "v"(hi)); return r; }

template <class Epi, class Sched, bool ALIGN_EPI = false, bool SP2 = false>
__device__ __forceinline__ void gemm_phase(PG8_LAS unsigned char* lds, const Gemm g, const Sched& S, const Epi& E) {
    int tid = threadIdx.x; asm volatile("" : "+v"(tid));
    const int wid = __builtin_amdgcn_readfirstlane(tid >> 6), lane = tid & 63, wr = wid >> 2, wc = wid & 3, fr = lane & 15, fq = lane >> 4;
    const int K = g.K, nt = K / BK, lda = g.lda;
    unsigned voffA[2], voffB[2];
#pragma unroll
    for (int i = 0; i < 2; ++i) { int R, C; stage_rc(tid * 16 + i * 8192, R, C); const int Rb = Epi::PERM ? ((R & ~31) + perm32(R & 31)) : R;
        voffA[i] = (unsigned)(R * lda + C) * 2u; voffB[i] = (unsigned)(Rb * K + C) * 2u; }
    const size_t kstep = (size_t)(BK * 2);
    const size_t hstepA = (size_t)HALF * lda * 2, hstepB = (size_t)HALF * K * 2;
    const size_t tstepA = 2 * hstepA, tstepB = 2 * hstepB;
    const unsigned ldsw = (unsigned)wid * 1024u;
    const int aoff = lds_byte(wr * 64 + fr, fq * 8), boff = lds_byte(wc * 32 + fr, fq * 8);
#define PG8_SA(b, h) (((b) * 2 + (h)) * HTB)
#define PG8_SB(b, h) ((4 + (b) * 2 + (h)) * HTB)
#define PG8_STAGE(bufoff, gbase, voff) do { _Pragma("unroll") for (int _i = 0; _i < 2; ++_i) \
        __builtin_amdgcn_global_load_lds((const unsigned*)((const char*)(gbase) + (voff)[_i]), (PG8_LAS unsigned*)(lds + (bufoff) + ldsw + _i * 8192), 16, 0, 0); } while (0)
#define PG8_LDA(dst, b, h) do { _Pragma("unroll") for (int m = 0; m < 4; ++m) _Pragma("unroll") for (int k = 0; k < 2; ++k) dst[m][k] = *(const PG8_LAS bf16x8*)(lds + PG8_SA(b, h) + aoff + m * 2048 + k * 1024); } while (0)
#define PG8_LDB(dst, b, h) do { _Pragma("unroll") for (int n = 0; n < 2; ++n) _Pragma("unroll") for (int k = 0; k < 2; ++k) dst[n][k] = *(const PG8_LAS bf16x8*)(lds + PG8_SB(b, h) + boff + n * 2048 + k * 1024); } while (0)
#define PG8_MMA(ai, bj, At, Bt) do { __builtin_amdgcn_s_setprio(1); _Pragma("unroll") for (int m = 0; m < 4; ++m) _Pragma("unroll") for (int n = 0; n < 2; ++n) _Pragma("unroll") for (int k = 0; k < 2; ++k) \
        acc[ai][bj][m][n] = __builtin_amdgcn_mfma_f32_16x16x32_bf16(Bt[n][k], At[m][k], acc[ai][bj][m][n], 0, 0, 0); __builtin_amdgcn_s_setprio(0); } while (0)
#define PG8_WAIT_V(n) asm volatile("s_waitcnt vmcnt(" #n ")" ::: "memory")
#define PG8_WAIT_L(n) asm volatile("s_waitcnt lgkmcnt(" #n ")" ::: "memory")
#define PG8_BAR __builtin_amdgcn_s_barrier()
#define PG8_SCHED __builtin_amdgcn_sched_barrier(0)
    Unit cur, nxt; int ui = 0;
    if (!S.next(0, cur)) return;
    f32x4 acc[2][2][4][2];
#pragma unroll
    for (int a = 0; a < 2; ++a)
#pragma unroll
        for (int b = 0; b < 2; ++b)
#pragma unroll
            for (int m = 0; m < 4; ++m)
#pragma unroll
                for (int n = 0; n < 2; ++n) acc[a][b][m][n] = (f32x4){0.f, 0.f, 0.f, 0.f};
    bf16x8 At[4][2], B0[2][2], B1[2][2];
    const char* cA = (const char*)g.A + (size_t)cur.pm * tstepA; const char* cB = (const char*)g.Bt + (size_t)cur.pn * tstepB;
    S.a_ready(cur);
    if constexpr (SP2) {
        PG8_STAGE(PG8_SB(0, 0), cB, voffB); PG8_STAGE(PG8_SB(0, 1), cB + hstepB, voffB); PG8_STAGE(PG8_SA(0, 0), cA, voffA); PG8_STAGE(PG8_SA(0, 1), cA + hstepA, voffA);
        if (wr == 1) PG8_BAR;
        PG8_WAIT_V(2); PG8_BAR;
        PG8_STAGE(PG8_SB(1, 0), cB + kstep, voffB); PG8_STAGE(PG8_SA(1, 0), cA + kstep, voffA); PG8_STAGE(PG8_SB(1, 1), cB + hstepB + kstep, voffB);
        PG8_WAIT_V(6); PG8_BAR;
    } else {
        PG8_STAGE(PG8_SB(0, 0), cB, voffB); PG8_STAGE(PG8_SA(0, 0), cA, voffA); PG8_STAGE(PG8_SB(0, 1), cB + hstepB, voffB); PG8_STAGE(PG8_SA(0, 1), cA + hstepA, voffA);
        if (wr == 1) PG8_BAR;
        PG8_WAIT_V(4); PG8_BAR;
        PG8_STAGE(PG8_SB(1, 0), cB + kstep, voffB); PG8_STAGE(PG8_SA(1, 0), cA + kstep, voffA); PG8_STAGE(PG8_SB(1, 1), cB + hstepB + kstep, voffB);
        PG8_WAIT_V(6); PG8_BAR;
    }
    for (;;) {
        const bool has_next = S.next(ui + 1, nxt);
        const char* nA = has_next ? (const char*)g.A + (size_t)nxt.pm * tstepA : cA; const char* nB = has_next ? (const char*)g.Bt + (size_t)nxt.pn * tstepB : cB;
        for (int t = 0; t < nt; t += 2) {
            const bool last = (t == nt - 2);
            const char* a1 = cA + (size_t)(t + 1) * kstep;
            const char* a2 = last ? nA : cA + (size_t)(t + 2) * kstep; const char* b2 = last ? nB : cB + (size_t)(t + 2) * kstep;
            const char* a3 = a2 + kstep; const char* b3 = b2 + kstep;
            if (last && has_next) S.a_ready(nxt);
            if constexpr (SP2) {
            PG8_LDB(B0, 0, 0); PG8_LDB(B1, 0, 1); PG8_SCHED; PG8_LDA(At, 0, 0); PG8_STAGE(PG8_SA(1, 1), a1 + hstepA, voffA);
            PG8_WAIT_V(8); PG8_WAIT_L(0); PG8_BAR; PG8_MMA(0, 0, At, B0); PG8_MMA(0, 1, At, B1); PG8_BAR; PG8_SCHED;
            PG8_LDA(At, 0, 1); PG8_STAGE(PG8_SB(0, 0), b2, voffB); PG8_STAGE(PG8_SB(0, 1), b2 + hstepB, voffB); PG8_STAGE(PG8_SA(0, 0), a2, voffA);
            PG8_WAIT_V(8); PG8_WAIT_L(0); PG8_BAR; PG8_MMA(1, 0, At, B0); PG8_MMA(1, 1, At, B1); PG8_BAR; PG8_SCHED;
            PG8_LDB(B0, 1, 0); PG8_LDB(B1, 1, 1); PG8_SCHED; PG8_LDA(At, 1, 0); PG8_STAGE(PG8_SA(0, 1), a2 + hstepA, voffA);
            PG8_WAIT_V(8); PG8_WAIT_L(0); PG8_BAR; PG8_MMA(0, 0, At, B0); PG8_MMA(0, 1, At, B1); PG8_BAR; PG8_SCHED;
            PG8_LDA(At, 1, 1); PG8_STAGE(PG8_SB(1, 0), b3, voffB); PG8_STAGE(PG8_SB(1, 1), b3 + hstepB, voffB); PG8_STAGE(PG8_SA(1, 0), a3, voffA);
            PG8_WAIT_V(8); PG8_WAIT_L(0); PG8_BAR; PG8_MMA(1, 0, At, B0); PG8_MMA(1, 1, At, B1); PG8_BAR; PG8_SCHED;
            } else {
            PG8_LDB(B0, 0, 0); PG8_SCHED; PG8_LDA(At, 0, 0); PG8_STAGE(PG8_SA(1, 1), a1 + hstepA, voffA);
            PG8_WAIT_L(8); PG8_BAR; PG8_WAIT_L(0); PG8_MMA(0, 0, At, B0); PG8_BAR; PG8_SCHED;
            PG8_LDB(B1, 0, 1); PG8_STAGE(PG8_SB(0, 0), b2, voffB);
            PG8_BAR; PG8_WAIT_L(0); PG8_MMA(0, 1, At, B1); PG8_BAR;
            PG8_LDA(At, 0, 1); PG8_STAGE(PG8_SA(0, 0), a2, voffA);
            PG8_BAR; PG8_WAIT_L(0); PG8_MMA(1, 0, At, B0); PG8_BAR; PG8_SCHED;
            PG8_STAGE(PG8_SB(0, 1), b2 + hstepB, voffB);
            PG8_WAIT_V(6); PG8_BAR; PG8_MMA(1, 1, At, B1); PG8_BAR;
            PG8_LDB(B0, 1, 0); PG8_SCHED; PG8_LDA(At, 1, 0); PG8_STAGE(PG8_SA(0, 1), a2 + hstepA, voffA);
            PG8_WAIT_L(8); PG8_BAR; PG8_WAIT_L(0); PG8_MMA(0, 0, At, B0); PG8_BAR; PG8_SCHED;
            PG8_LDB(B1, 1, 1); PG8_STAGE(PG8_SB(1, 0), b3, voffB);
            PG8_BAR; PG8_WAIT_L(0); PG8_MMA(0, 1, At, B1); PG8_BAR;
            PG8_LDA(At, 1, 1); PG8_STAGE(PG8_SA(1, 0), a3, voffA);
            PG8_BAR; PG8_WAIT_L(0); PG8_MMA(1, 0, At, B0); PG8_BAR; PG8_SCHED;
            PG8_STAGE(PG8_SB(1, 1), b3 + hstepB, voffB);
            PG8_WAIT_V(6); PG8_BAR; PG8_MMA(1, 1, At, B1); PG8_BAR;
            }
        }
        if constexpr (ALIGN_EPI) { if (wr == 0) PG8_BAR; }
        if constexpr (!Epi::AFTER_DRAIN) { E(acc, cur, wr, wc, fr, fq); S.done(cur); }
        if (!has_next) break;
#pragma unroll
        for (int a = 0; a < 2; ++a)
#pragma unroll
            for (int b = 0; b < 2; ++b)
#pragma unroll
                for (int m = 0; m < 4; ++m)
#pragma unroll
                    for (int n = 0; n < 2; ++n) acc[a][b][m][n] = (f32x4){0.f, 0.f, 0.f, 0.f};
        cur = nxt; cA = nA; cB = nB; ++ui;
        if constexpr (ALIGN_EPI) { if (wr == 1) PG8_BAR; }
    }
    PG8_WAIT_V(0);
    if constexpr (!ALIGN_EPI) { if (wr == 0) PG8_BAR; }
    PG8_BAR;
    if constexpr (Epi::AFTER_DRAIN) { E.fused(acc, cur, wr, wc, fr, fq, lds, wid, lane); S.done(cur); }
#undef PG8_SA
#undef PG8_SB
#undef PG8_STAGE
#undef PG8_LDA
#undef PG8_LDB
#undef PG8_MMA
#undef PG8_WAIT_V
#undef PG8_WAIT_L
#undef PG8_BAR
#undef PG8_SCHED
}
}
namespace cf {
constexpr int D = 1024, NB = 4, SEQ = 4096, M = NB * SEQ;
constexpr int DFF = 2816, NSHIFT = 3328;
constexpr float ALPHA = 1.41421356237309515f;
constexpr float LN_EPS = 1e-5f, GN_EPS = 64e-5f;
constexpr size_t MiB = 1u << 20;
}
typedef unsigned short bf16_t;
typedef float f32x4 __attribute__((ext_vector_type(4)));
typedef unsigned u32x4 __attribute__((ext_vector_type(4)));
typedef unsigned u32x2 __attribute__((ext_vector_type(2)));

__device__ __forceinline__ unsigned f2bf(float f) { unsigned u = __builtin_bit_cast(unsigned, f); return (u + 0x7fffu + ((u >> 16) & 1u)) >> 16; }
__device__ __forceinline__ unsigned pk2(float lo, float hi) { return f2bf(lo) | (f2bf(hi) << 16); }
__device__ __forceinline__ float bf2f(unsigned short b) { return __builtin_bit_cast(float, ((unsigned)b) << 16); }
__device__ __forceinline__ float bflo(unsigned w) { return __builtin_bit_cast(float, w << 16); }
__device__ __forceinline__ float bfhi(unsigned w) { return __builtin_bit_cast(float, w & 0xffff0000u); }
__device__ __forceinline__ float sigmoidf_(float x) { return 1.0f / (1.0f + __expf(-x)); }
__device__ __forceinline__ float tanhf_(float x) { const float e = __expf(2.0f * x); return 1.0f - 2.0f / (e + 1.0f); }
__device__ __forceinline__ float gelu_tanh(float x) { const float u = 0.7978845608028654f * (x + 0.044715f * x * x * x); return 0.5f * x * (1.0f + tanhf_(u)); }
__device__ __forceinline__ float silu_(float x) { return x / (1.0f + __expf(-x)); }
__device__ __forceinline__ float wave_sum(float v) {
#pragma unroll
    for (int o = 1; o < 64; o <<= 1) v += __shfl_xor(v, o);
    return v;
}
__device__ __forceinline__ float wave_max(float v) {
#pragma unroll
    for (int o = 1; o < 64; o <<= 1) v = fmaxf(v, __shfl_xor(v, o));
    return v;
}

namespace pg8 {
struct EpiIn {
    static constexpr bool PERM = true, AFTER_DRAIN = false;
    bf16_t *XA, *GA, *Q, *K, *V, *ZC, *ZV1; const float* cs;
    __device__ __forceinline__ void operator()(const f32x4 (&acc)[2][2][4][2], const Unit& u, int wr, int wc, int fr, int fq) const {
        const int pn = u.pn; bf16_t* dst; int ldc, colt, mode;
        if (pn < 4) { dst = XA; ldc = 1024; colt = pn * 256; mode = 0; }
        else if (pn < 8) { dst = GA; ldc = 1024; colt = (pn - 4) * 256; mode = 1; }
        else if (pn < 11) { dst = Q; ldc = 768; colt = (pn - 8) * 256; mode = 2; }
        else if (pn < 14) { dst = K; ldc = 768; colt = (pn - 11) * 256; mode = 3; }
        else if (pn < 17) { dst = V; ldc = 768; colt = (pn - 14) * 256; mode = 0; }
        else if (pn < 30) { dst = ZC; ldc = 3328; colt = (pn - 17) * 256; mode = 0; }
        else { dst = ZV1; ldc = 32; colt = 0; mode = 4; }
        const int row0 = u.pm * BM + wr * 64 + fr;
        const bool rot = (mode == 2 || mode == 3) && ((wc & 1) == 0);
        const float sgn = (fq == 0) ? -1.0f : 1.0f; const bool rl = fq < 2;
#pragma unroll
        for (int ai = 0; ai < 2; ++ai)
#pragma unroll
            for (int m = 0; m < 4; ++m) {
                const int row = row0 + ai * HALF + m * 16;
                f32x4 c0 = {1.f, 1.f, 1.f, 1.f}, c1 = c0, s0 = {0.f, 0.f, 0.f, 0.f}, s1 = s0;
                if (rot) { const f32x4* p = (const f32x4*)(cs + (size_t)row * 16); c0 = p[0]; c1 = p[1]; s0 = p[2]; s1 = p[3]; }
#pragma unroll
                for (int bj = 0; bj < 2; ++bj) {
                    f32x4 v0 = acc[ai][bj][m][0], v1 = acc[ai][bj][m][1];
                    if (mode == 1) {
#pragma unroll
                        for (int j = 0; j < 4; ++j) { v0[j] = gelu_tanh(v0[j]); v1[j] = gelu_tanh(v1[j]); }
                    }
                    if (rot) {
                        f32x4 p0, p1;
#pragma unroll
                        for (int j = 0; j < 4; ++j) { p0[j] = __shfl_xor(v0[j], 16); p1[j] = __shfl_xor(v1[j], 16); }
                        if (rl) { v0 = v0 * c0 + (p0 * s0) * sgn; v1 = v1 * c1 + (p1 * s1) * sgn; }
                    }
                    if (mode == 2) { v0 = v0 * 0.125f; v1 = v1 * 0.125f; }
                    u32x4 w; w.x = cvt_pk_bf16(v0[0], v0[1]); w.y = cvt_pk_bf16(v0[2], v0[3]); w.z = cvt_pk_bf16(v1[0], v1[1]); w.w = cvt_pk_bf16(v1[2], v1[3]);
                    const int col = colt + bj * HALF + wc * 32 + 8 * fq;
                    if (mode != 4 || (bj == 0 && wc == 0)) *(u32x4*)(dst + (size_t)row * ldc + col) = w;
                }
            }
    }
};
template <int ACT  > struct EpiBf16 {
    static constexpr bool PERM = true, AFTER_DRAIN = false;
    bf16_t* O; int ldc; int pad_;
    __device__ __forceinline__ void operator()(const f32x4 (&acc)[2][2][4][2], const Unit& u, int wr, int wc, int fr, int fq) const {
        const int row0 = u.pm * BM + wr * 64 + fr, col0 = u.pn * BM + wc * 32 + 8 * fq;
#pragma unroll
        for (int ai = 0; ai < 2; ++ai)
#pragma unroll
            for (int m = 0; m < 4; ++m) { bf16_t* rowp = O + (size_t)(row0 + ai * HALF + m * 16) * ldc + col0;
#pragma unroll
                for (int bj = 0; bj < 2; ++bj) { f32x4 v0 = acc[ai][bj][m][0], v1 = acc[ai][bj][m][1];
                    if (ACT == 1) {
#pragma unroll
                        for (int j = 0; j < 4; ++j) { v0[j] = sigmoidf_(v0[j]); v1[j] = sigmoidf_(v1[j]); }
                    }
                    u32x4 w; w.x = cvt_pk_bf16(v0[0], v0[1]); w.y = cvt_pk_bf16(v0[2], v0[3]); w.z = cvt_pk_bf16(v1[0], v1[1]); w.w = cvt_pk_bf16(v1[2], v1[3]);
                    *(u32x4*)(rowp + bj * HALF) = w; } }
    }
};
struct EpiF32 {
    static constexpr bool PERM = false, AFTER_DRAIN = false;
    float* C; int ldc; int pad_;
    __device__ __forceinline__ void operator()(const f32x4 (&acc)[2][2][4][2], const Unit& u, int wr, int wc, int fr, int fq) const {
        const int row0 = u.pm * BM + wr * 64 + fr, col0 = u.pn * BM + wc * 32 + 4 * fq;
#pragma unroll
        for (int ai = 0; ai < 2; ++ai)
#pragma unroll
            for (int m = 0; m < 4; ++m) { float* rowp = C + (size_t)(row0 + ai * HALF + m * 16) * ldc + col0;
#pragma unroll
                for (int bj = 0; bj < 2; ++bj)
#pragma unroll
                    for (int n = 0; n < 2; ++n) *(f32x4*)(rowp + bj * HALF + n * 16) = acc[ai][bj][m][n]; }
    }
};
template <int ADD> struct EpiMerge {
    static constexpr bool PERM = true, AFTER_DRAIN = false;
    bf16_t* MG; const bf16_t* GT; int ldc; int pad_;
    __device__ __forceinline__ void operator()(const f32x4 (&acc)[2][2][4][2], const Unit& u, int wr, int wc, int fr, int fq) const {
        const int row0 = u.pm * BM + wr * 64 + fr, col0 = u.pn * BM + wc * 32 + 8 * fq;
#pragma unroll
        for (int ai = 0; ai < 2; ++ai)
#pragma unroll
            for (int m = 0; m < 4; ++m) { const size_t off = (size_t)(row0 + ai * HALF + m * 16) * ldc + col0;
#pragma unroll
                for (int bj = 0; bj < 2; ++bj) { f32x4 v0 = acc[ai][bj][m][0], v1 = acc[ai][bj][m][1];
                    const u32x4 gw = *(const u32x4*)(GT + off + bj * HALF);
                    v0[0] *= bflo(gw.x); v0[1] *= bfhi(gw.x); v0[2] *= bflo(gw.y); v0[3] *= bfhi(gw.y);
                    v1[0] *= bflo(gw.z); v1[1] *= bfhi(gw.z); v1[2] *= bflo(gw.w); v1[3] *= bfhi(gw.w);
                    if (ADD) { const u32x4 mw = *(const u32x4*)(MG + off + bj * HALF);
                        v0[0] += bflo(mw.x); v0[1] += bfhi(mw.x); v0[2] += bflo(mw.y); v0[3] += bfhi(mw.y);
                        v1[0] += bflo(mw.z); v1[1] += bfhi(mw.z); v1[2] += bflo(mw.w); v1[3] += bfhi(mw.w); }
                    u32x4 w; w.x = cvt_pk_bf16(v0[0], v0[1]); w.y = cvt_pk_bf16(v0[2], v0[3]); w.z = cvt_pk_bf16(v1[0], v1[1]); w.w = cvt_pk_bf16(v1[2], v1[3]);
                    *(u32x4*)(MG + off + bj * HALF) = w; } }
    }
};
}

constexpr int GEMM_LDS = 147456;
template <class Epi> __global__ __launch_bounds__(512, 2) void k_gemm(pg8::Gemm g, Epi E) {
    extern __shared__ __attribute__((aligned(16))) unsigned char shm[];
    pg8::StaticOrder S; S.init(g.M, g.N, (int)gridDim.x, (int)blockIdx.x);
    pg8::gemm_phase<Epi, pg8::StaticOrder, true, true>((PG8_LAS unsigned char*)shm, g, S, E);
}
#define LDSF(off) ((float*)(lds + (off)))
__device__ __forceinline__ int opaque_tid() { int t = threadIdx.x; asm volatile("" : "+v"(t)); return t; }
__device__ __forceinline__ void ph_mod(unsigned char* lds, const float* __restrict__ c, const float* __restrict__ mod_w, const float* __restrict__ mod_b, float* __restrict__ mod) {
    float* sc = LDSF(0); float* red = LDSF(16384);
    const int tid = opaque_tid(), col = tid & 63, ks = tid >> 6;
    for (int i = tid; i < 4096; i += 512) sc[i] = silu_(c[i]);
    __syncthreads();
    for (int it = blockIdx.x; it < 192; it += gridDim.x) {
        const int l = it / 96, n = (it % 96) * 64 + col;
        const float* W = mod_w + (size_t)l * 1024 * 6144 + n;
        float a0 = 0.f, a1 = 0.f, a2 = 0.f, a3 = 0.f;
        for (int k = ks * 128; k < ks * 128 + 128; ++k) { const float w = W[(size_t)k * 6144]; a0 += sc[k] * w; a1 += sc[1024 + k] * w; a2 += sc[2048 + k] * w; a3 += sc[3072 + k] * w; }
        red[(ks * 4 + 0) * 64 + col] = a0; red[(ks * 4 + 1) * 64 + col] = a1; red[(ks * 4 + 2) * 64 + col] = a2; red[(ks * 4 + 3) * 64 + col] = a3;
        __syncthreads();
        if (tid < 256) { const int b = tid >> 6; float s = mod_b[l * 6144 + n];
#pragma unroll
            for (int q = 0; q < 8; ++q) s += red[(q * 4 + b) * 64 + col];
            mod[((size_t)l * 4 + b) * 6144 + n] = s; }
        __syncthreads();
    }
}
__device__ __forceinline__ void ph_rope(const int* __restrict__ pos, float* __restrict__ cs) {
    for (int e = blockIdx.x * 512 + threadIdx.x; e < cf::M * 8; e += gridDim.x * 512) {
        const int m = e >> 3, i = e & 7;
        const float inv = powf(500000.0f, -(float)i / 8.0f);
        const float ang = (float)pos[m] * inv;
        cs[m * 16 + i] = cosf(ang); cs[m * 16 + 8 + i] = sinf(ang); }
}
__device__ __forceinline__ void ph_transpose(unsigned char* lds, const float* __restrict__ W, int K, int Nsrc, int c0, int nc, bf16_t* __restrict__ WT, int r0) {
    const int tid_ = opaque_tid(); const int lane = tid_ & 63, wave = tid_ >> 6;
    float* scr = LDSF(wave * 64 * 33 * 4);
    const int nblk = nc / 32, nitems = (K / 64) * nblk;
    for (int item = blockIdx.x * 8 + wave; item < nitems; item += gridDim.x * 8) {
        const int kb = item / nblk, nb = item % nblk, k0 = 64 * kb, n0 = 32 * nb;
#pragma unroll 8
        for (int i = 0; i < 32; ++i) { const int kk = 2 * i + (lane >> 5); scr[kk * 33 + (lane & 31)] = W[(size_t)(k0 + kk) * Nsrc + c0 + n0 + (lane & 31)]; }
        __builtin_amdgcn_wave_barrier(); asm volatile("s_waitcnt lgkmcnt(0)" ::: "memory");
        const int c = lane & 7;
#pragma unroll
        for (int j = 0; j < 4; ++j) { const int n = (lane >> 3) + 8 * j; const float* s = scr + (8 * c) * 33 + n;
            u32x4 o; o.x = pk2(s[0 * 33], s[1 * 33]); o.y = pk2(s[2 * 33], s[3 * 33]); o.z = pk2(s[4 * 33], s[5 * 33]); o.w = pk2(s[6 * 33], s[7 * 33]);
            *(u32x4*)(WT + (size_t)(r0 + n0 + n) * K + k0 + 8 * c) = o; }
        __builtin_amdgcn_wave_barrier(); asm volatile("s_waitcnt lgkmcnt(0)" ::: "memory");
    }
}
__device__ __forceinline__ void ph_zero16(u32x4* p, size_t n16) { for (size_t i = (size_t)blockIdx.x * 512 + threadIdx.x; i < n16; i += (size_t)gridDim.x * 512) p[i] = (u32x4){0u, 0u, 0u, 0u}; }
__device__ __forceinline__ void ph_modulate(const float* __restrict__ x, const float* __restrict__ modl, int sh_off, int sc_off, bf16_t* __restrict__ h) {
    for (size_t e4 = (size_t)blockIdx.x * 512 + threadIdx.x; e4 < (size_t)cf::M * 256; e4 += (size_t)gridDim.x * 512) {
        const int m = (int)(e4 >> 8), c = (int)(e4 & 255) * 4, b = m / cf::SEQ;
        const f32x4 xv = *(const f32x4*)(x + (size_t)m * 1024 + c);
        const f32x4 sh = *(const f32x4*)(modl + b * 6144 + sh_off + c), sc = *(const f32x4*)(modl + b * 6144 + sc_off + c);
        const f32x4 o = xv * (sc + 1.0f) + sh;
        u32x2 w; w.x = pk2(o[0], o[1]); w.y = pk2(o[2], o[3]);
        *(u32x2*)(h + (size_t)m * 1024 + c) = w; }
}
__device__ __forceinline__ void ph_ln(const float* __restrict__ xin, const float* __restrict__ y, int m0, int nrows, const float* __restrict__ modl, int gt_off,
                                      const float* __restrict__ lw, const float* __restrict__ lb, float* __restrict__ xo,
                                      const float* __restrict__ modn, int shn_off, int scn_off, bf16_t* __restrict__ hn) {
    const int tid_ = opaque_tid(); const int lane = tid_ & 63;
    for (int r = blockIdx.x * 8 + (tid_ >> 6); r < nrows; r += gridDim.x * 8) {
        const int m = m0 + r, b = m / cf::SEQ;
        f32x4 v[4]; float s = 0.f;
#pragma unroll
        for (int j = 0; j < 4; ++j) { const int c = 4 * lane + 256 * j;
            const f32x4 xv = *(const f32x4*)(xin + (size_t)m * 1024 + c), yv = *(const f32x4*)(y + (size_t)r * 1024 + c), g = *(const f32x4*)(modl + b * 6144 + gt_off + c);
            v[j] = xv * cf::ALPHA + (g + 1.0f) * yv; s += (v[j][0] + v[j][1]) + (v[j][2] + v[j][3]); }
        const float mean = wave_sum(s) * (1.f / 1024.f); float s2 = 0.f;
#pragma unroll
        for (int j = 0; j < 4; ++j) { v[j] = v[j] - mean; s2 += (v[j][0] * v[j][0] + v[j][1] * v[j][1]) + (v[j][2] * v[j][2] + v[j][3] * v[j][3]); }
        const float rstd = 1.0f / sqrtf(wave_sum(s2) * (1.f / 1024.f) + cf::LN_EPS);
#pragma unroll
        for (int j = 0; j < 4; ++j) { const int c = 4 * lane + 256 * j;
            const f32x4 o = v[j] * rstd * *(const f32x4*)(lw + c) + *(const f32x4*)(lb + c);
            *(f32x4*)(xo + (size_t)m * 1024 + c) = o;
            if (hn) { const f32x4 sh = *(const f32x4*)(modn + b * 6144 + shn_off + c), sc = *(const f32x4*)(modn + b * 6144 + scn_off + c);
                const f32x4 hv = o * (sc + 1.0f) + sh; u32x2 w; w.x = pk2(hv[0], hv[1]); w.y = pk2(hv[2], hv[3]); *(u32x2*)(hn + (size_t)m * 1024 + c) = w; } }
    }
}
__device__ __forceinline__ void ph_convglu(const bf16_t* __restrict__ U, int nrows, const float* __restrict__ cw, const float* __restrict__ cb, bf16_t* __restrict__ S) {
    for (size_t e = (size_t)blockIdx.x * 512 + threadIdx.x; e < (size_t)nrows * 704; e += (size_t)gridDim.x * 512) {
        const int r = (int)(e / 704), c = (int)(e % 704) * 4, s = r % cf::SEQ;
        f32x4 g = *(const f32x4*)(cb + c), v = *(const f32x4*)(cb + 2816 + c);
#pragma unroll
        for (int j = 0; j < 3; ++j) if (s - j >= 0) {
            const u32x2 ug = *(const u32x2*)(U + (size_t)(r - j) * 5632 + c), uv = *(const u32x2*)(U + (size_t)(r - j) * 5632 + 2816 + c);
            const f32x4 wg = *(const f32x4*)(cw + j * 5632 + c), wv = *(const f32x4*)(cw + j * 5632 + 2816 + c);
            g[0] += wg[0] * bflo(ug.x); g[1] += wg[1] * bfhi(ug.x); g[2] += wg[2] * bflo(ug.y); g[3] += wg[3] * bfhi(ug.y);
            v[0] += wv[0] * bflo(uv.x); v[1] += wv[1] * bfhi(uv.x); v[2] += wv[2] * bflo(uv.y); v[3] += wv[3] * bfhi(uv.y); }
        u32x2 w; w.x = pk2(silu_(g[0]) * v[0], silu_(g[1]) * v[1]); w.y = pk2(silu_(g[2]) * v[2], silu_(g[3]) * v[3]);
        *(u32x2*)(S + (size_t)r * 2816 + c) = w; }
}

struct LruArgs { const bf16_t* XA; bf16_t* GA  ; const float *cw, *cb, *wa, *ba, *wx, *bx, *lam; };
__device__ __forceinline__ void ph_lru_item(unsigned char* lds, const LruArgs& a, int item) {
    float* xraw = LDSF(0); float* xc = LDSF(67 * 64 * 4); float* Bb = LDSF(67 * 64 * 4 + 16384); float* Aa = xraw;
    const int b = item >> 4, g = item & 15, tid = opaque_tid(), j = tid & 63, tq = tid >> 6, gj = g * 64 + j;
    const float* wa = a.wa + (size_t)g * 4096 + j; const float* wx = a.wx + (size_t)g * 4096 + j;
    const float lamv = a.lam[gj]; const float c8 = 8.0f * (fmaxf(-lamv, 0.f) + log1pf(expf(-fabsf(lamv))));
    const float bav = a.ba[gj], bxv = a.bx[gj], cbv = a.cb[gj];
    float cwv[4];
#pragma unroll
    for (int q = 0; q < 4; ++q) cwv[q] = a.cw[q * 1024 + gj];
    float hstate = 0.f;
    for (int ch = 0; ch < cf::SEQ / 64; ++ch) {
        const int s0 = ch * 64; const size_t m0 = (size_t)b * cf::SEQ + s0;
        for (int e = tid; e < 67 * 64; e += 512) { const int r = e >> 6, cc = e & 63, s = s0 - 3 + r; xraw[e] = (s >= 0) ? bf2f(a.XA[((size_t)b * cf::SEQ + s) * 1024 + g * 64 + cc]) : 0.f; }
        __syncthreads();
        for (int e = tid; e < 64 * 64; e += 512) { const int tt = e >> 6;
            xc[e] = cbv + cwv[0] * xraw[(tt + 3) * 64 + j] + cwv[1] * xraw[(tt + 2) * 64 + j] + cwv[2] * xraw[(tt + 1) * 64 + j] + cwv[3] * xraw[tt * 64 + j]; }
        __syncthreads();
        float ar[8], ai[8];
#pragma unroll
        for (int q = 0; q < 8; ++q) { ar[q] = 0.f; ai[q] = 0.f; }
        for (int i = 0; i < 64; ++i) { const float wav = wa[i * 64], wxv = wx[i * 64];
#pragma unroll
            for (int q = 0; q < 8; ++q) { const float xv = xc[(tq * 8 + q) * 64 + i]; ar[q] += xv * wav; ai[q] += xv * wxv; } }
#pragma unroll
        for (int q = 0; q < 8; ++q) { const int tt = tq * 8 + q;
            const float r = sigmoidf_(ar[q] + bav), ig = sigmoidf_(ai[q] + bxv), la = -c8 * r;
            Aa[tt * 64 + j] = expf(la); Bb[tt * 64 + j] = sqrtf(-expm1f(2.0f * la)) * (ig * xc[tt * 64 + j]); }
        __syncthreads();
        if (tid < 64) { float h = hstate;
            for (int tt = 0; tt < 64; ++tt) { h = Aa[tt * 64 + j] * h + Bb[tt * 64 + j]; Bb[tt * 64 + j] = h; }
            hstate = h; }
        __syncthreads();
        for (int e = tid; e < 64 * 64; e += 512) { const int tt = e >> 6; bf16_t* p = a.GA + (m0 + tt) * 1024 + g * 64 + j; *p = (bf16_t)f2bf(Bb[e] * bf2f(*p)); }
        __syncthreads();
    }
}

__device__ __forceinline__ void ph_attn(unsigned char* lds, const bf16_t* __restrict__ Q, const bf16_t* __restrict__ K, const bf16_t* __restrict__ V, bf16_t* __restrict__ YB, int vb0, int vbstride) {
    const int tid_ = opaque_tid(); const int wave = tid_ >> 6, lane = tid_ & 63, hs = wave & 3;
    float* p = LDSF(wave * 3 * 132 * 4);
    for (int vb = vb0; vb < cf::M / 2; vb += vbstride) {
        const int m = vb * 2 + (wave >> 2), b = m / cf::SEQ, s = m % cf::SEQ;
        float sc[3][3]; float mx = -INFINITY;
#pragma unroll
        for (int g = 0; g < 3; ++g) {
            const int dil = (g == 0) ? 1 : (g == 1 ? 4 : 16), head = g * 4 + hs;
            float qf[64];
            { const u32x4* qp = (const u32x4*)(Q + (size_t)m * 768 + head * 64);
#pragma unroll
              for (int i = 0; i < 8; ++i) { const u32x4 w = qp[i]; qf[8 * i] = bflo(w.x); qf[8 * i + 1] = bfhi(w.x); qf[8 * i + 2] = bflo(w.y); qf[8 * i + 3] = bfhi(w.y); qf[8 * i + 4] = bflo(w.z); qf[8 * i + 5] = bfhi(w.z); qf[8 * i + 6] = bflo(w.w); qf[8 * i + 7] = bfhi(w.w); } }
#pragma unroll
            for (int r = 0; r < 3; ++r) {
                const int jj = lane + 64 * r; const int sk = s - dil * jj; float d = -INFINITY;
                if (jj <= 128 && sk >= 0) { const u32x4* kp = (const u32x4*)(K + ((size_t)b * cf::SEQ + sk) * 768 + head * 64); d = 0.f;
#pragma unroll
                    for (int i = 0; i < 8; ++i) { const u32x4 w = kp[i]; d += qf[8 * i] * bflo(w.x) + qf[8 * i + 1] * bfhi(w.x) + qf[8 * i + 2] * bflo(w.y) + qf[8 * i + 3] * bfhi(w.y) + qf[8 * i + 4] * bflo(w.z) + qf[8 * i + 5] * bfhi(w.z) + qf[8 * i + 6] * bflo(w.w) + qf[8 * i + 7] * bfhi(w.w); } }
                sc[g][r] = d; mx = fmaxf(mx, d); }
        }
        mx = wave_max(mx);
        float sum = 0.f;
#pragma unroll
        for (int g = 0; g < 3; ++g)
#pragma unroll
            for (int r = 0; r < 3; ++r) { const int jj = lane + 64 * r; const float e = (sc[g][r] == -INFINITY) ? 0.f : __expf(sc[g][r] - mx); sum += e; if (jj <= 128) p[g * 132 + jj] = e; }
        sum = wave_sum(sum);
        __builtin_amdgcn_wave_barrier(); asm volatile("s_waitcnt lgkmcnt(0)" ::: "memory");
        float o = 0.f;
#pragma unroll
        for (int g = 0; g < 3; ++g) {
            const int dil = (g == 0) ? 1 : (g == 1 ? 4 : 16), head = g * 4 + hs;
            const int nj = min(128, s / dil);
            const bf16_t* vp = V + ((size_t)b * cf::SEQ + s) * 768 + head * 64 + lane;
            for (int jj = 0; jj <= nj; ++jj) o += p[g * 132 + jj] * bf2f(vp[-(ptrdiff_t)jj * dil * 768]);
        }
        YB[(size_t)m * 256 + hs * 64 + lane] = (bf16_t)f2bf(o / sum);
        __builtin_amdgcn_wave_barrier(); asm volatile("s_waitcnt lgkmcnt(0)" ::: "memory");
    }
}

struct WkvArgs {
    const bf16_t* ZC; const bf16_t* ZV1; bf16_t* VF; bf16_t* YC;
    const float *mu, *mu_v, *w0, *w2, *a0, *a2, *g2, *v0, *v2, *k_k, *k_a, *r_k, *lnw, *lnb;
    int layer; int pad_;
};
constexpr int WKV_TC = 32;
constexpr int WKV_LDS = (8 * WKV_TC * 64 + 2 * WKV_TC * 64 + WKV_TC * 128 + WKV_TC * 32 + WKV_TC) * 4;
__device__ __forceinline__ void ph_wkv_item(unsigned char* lds, const WkvArgs& a, int item) {
    float* sm = LDSF(0);
    constexpr int TC = WKV_TC;
    float* R = sm; float* Wd = R + TC * 64; float* Kp = Wd + TC * 64; float* Vv = Kp + TC * 64; float* KK = Vv + TC * 64; float* BB = KK + TC * 64; float* G = BB + TC * 64; float* Y = G + TC * 64;
    float* LW = Y + TC * 64; float* LA = LW + TC * 64; float* LG = LA + TC * 64; float* LV = LG + TC * 128; float* BD = LV + TC * 32;
    const int b = item >> 4, h = item & 15, tid = opaque_tid(), lane = tid & 63, wv = tid >> 6;
    const int hj = h * 64 + lane;
    const float w0v = a.w0[hj], a0v = a.a0[hj], kkv = a.k_k[hj], kav = a.k_a[hj], rkv = a.r_k[hj], lnwv = a.lnw[hj], lnbv = a.lnb[hj];
    const float v0v = a.layer ? a.v0[hj] : 0.f;
    const int rr = lane >> 3, cg = lane & 7, irow = wv * 8 + rr;
    float st[8];
#pragma unroll
    for (int c = 0; c < 8; ++c) st[c] = 0.f;
    const int ncol = a.layer ? 480 : 448;
    for (int ch = 0; ch < cf::SEQ / TC; ++ch) {
        const int s0 = ch * TC; const size_t m0 = (size_t)b * cf::SEQ + s0;
        for (int e = tid; e < TC * ncol; e += 512) {
            const int tt = e / ncol, col = e % ncol; const size_t m = m0 + tt; const bool hasp = (s0 + tt) > 0;
            if (col < 448) {
                int zcol; if (col < 192) zcol = (col >> 6) * 1024 + h * 64 + (col & 63); else zcol = 3072 + (col - 192);
                const float z = bf2f(a.ZC[m * 3328 + zcol]), zp = hasp ? bf2f(a.ZC[(m - 1) * 3328 + zcol]) : 0.f;
                const float zs = z + (zp - z) * a.mu[zcol];
                if (col < 64) R[tt * 64 + col] = zs; else if (col < 128) Kp[tt * 64 + col - 64] = zs; else if (col < 192) Vv[tt * 64 + col - 128] = zs;
                else if (col < 256) LW[tt * 64 + col - 192] = tanhf_(zs); else if (col < 320) LA[tt * 64 + col - 256] = zs; else LG[tt * 128 + col - 320] = sigmoidf_(zs);
            } else { const int i = col - 448;
                const float z = bf2f(a.ZV1[m * 32 + i]), zp = hasp ? bf2f(a.ZV1[(m - 1) * 32 + i]) : 0.f;
                LV[tt * 32 + i] = z + (zp - z) * a.mu_v[i]; }
        }
        __syncthreads();
        {
            float aw[4] = {0.f, 0.f, 0.f, 0.f}, aa[4] = {0.f, 0.f, 0.f, 0.f}, ag[4] = {0.f, 0.f, 0.f, 0.f}, av4[4] = {0.f, 0.f, 0.f, 0.f};
            for (int i = 0; i < 64; ++i) { const float w2v = a.w2[i * 1024 + hj], a2v = a.a2[i * 1024 + hj];
#pragma unroll
                for (int q = 0; q < 4; ++q) { const int tt = wv + 8 * q; aw[q] += LW[tt * 64 + i] * w2v; aa[q] += LA[tt * 64 + i] * a2v; } }
            for (int i = 0; i < 128; ++i) { const float g2v = a.g2[i * 1024 + hj];
#pragma unroll
                for (int q = 0; q < 4; ++q) ag[q] += LG[(wv + 8 * q) * 128 + i] * g2v; }
            if (a.layer) for (int i = 0; i < 32; ++i) { const float v2v = a.v2[i * 1024 + hj];
#pragma unroll
                for (int q = 0; q < 4; ++q) av4[q] += LV[(wv + 8 * q) * 32 + i] * v2v; }
#pragma unroll
            for (int q = 0; q < 4; ++q) { const int tt = wv + 8 * q; const size_t m = m0 + tt;
                const float wl = w0v + aw[q]; const float sp = fmaxf(-wl, 0.f) + log1pf(expf(-fabsf(wl)));
                const float decay = expf(-expf(-sp - 0.5f));
                const float av = sigmoidf_(a0v + aa[q]);
                const float rv = R[tt * 64 + lane], kr = Kp[tt * 64 + lane], vr = Vv[tt * 64 + lane];
                float v;
                if (a.layer == 0) { a.VF[m * 1024 + hj] = (bf16_t)f2bf(vr); v = vr; }
                else { const float vf = bf2f(a.VF[m * 1024 + hj]); v = vr + (vf - vr) * sigmoidf_(v0v + av4[q]); }
                const float kkr = kr * kkv; const float ss = wave_sum(kkr * kkr); const float kk = kkr * rsqrtf(ss + 1e-12f);
                const float kp = kr * (1.0f + (av - 1.0f) * kav);
                const float bd = wave_sum(rv * kp * rkv);
                Wd[tt * 64 + lane] = decay; Kp[tt * 64 + lane] = kp; Vv[tt * 64 + lane] = v; KK[tt * 64 + lane] = kk; BB[tt * 64 + lane] = kk * av; G[tt * 64 + lane] = ag[q];
                if (lane == 0) BD[tt] = bd; }
        }
        __syncthreads();
        for (int tt = 0; tt < TC; ++tt) {
            const f32x4* pk = (const f32x4*)(KK + tt * 64 + 8 * cg); const f32x4* pw = (const f32x4*)(Wd + tt * 64 + 8 * cg); const f32x4* pb = (const f32x4*)(BB + tt * 64 + 8 * cg);
            const f32x4* pkp = (const f32x4*)(Kp + tt * 64 + 8 * cg); const f32x4* pr = (const f32x4*)(R + tt * 64 + 8 * cg);
            const f32x4 k0 = pk[0], k1 = pk[1], w0_ = pw[0], w1_ = pw[1], b0 = pb[0], b1 = pb[1], q0 = pkp[0], q1 = pkp[1], r0 = pr[0], r1 = pr[1];
            const float vi = Vv[tt * 64 + irow];
            float p = (st[0] * k0[0] + st[1] * k0[1]) + (st[2] * k0[2] + st[3] * k0[3]) + (st[4] * k1[0] + st[5] * k1[1]) + (st[6] * k1[2] + st[7] * k1[3]);
            p += __shfl_xor(p, 1); p += __shfl_xor(p, 2); p += __shfl_xor(p, 4);
            const float sa = -p;
            st[0] = st[0] * w0_[0] + sa * b0[0] + vi * q0[0]; st[1] = st[1] * w0_[1] + sa * b0[1] + vi * q0[1]; st[2] = st[2] * w0_[2] + sa * b0[2] + vi * q0[2]; st[3] = st[3] * w0_[3] + sa * b0[3] + vi * q0[3];
            st[4] = st[4] * w1_[0] + sa * b1[0] + vi * q1[0]; st[5] = st[5] * w1_[1] + sa * b1[1] + vi * q1[1]; st[6] = st[6] * w1_[2] + sa * b1[2] + vi * q1[2]; st[7] = st[7] * w1_[3] + sa * b1[3] + vi * q1[3];
            float yq = (st[0] * r0[0] + st[1] * r0[1]) + (st[2] * r0[2] + st[3] * r0[3]) + (st[4] * r1[0] + st[5] * r1[1]) + (st[6] * r1[2] + st[7] * r1[3]);
            yq += __shfl_xor(yq, 1); yq += __shfl_xor(yq, 2); yq += __shfl_xor(yq, 4);
            if (cg == 0) Y[tt * 64 + irow] = yq;
        }
        __syncthreads();
#pragma unroll
        for (int q = 0; q < 4; ++q) { const int tt = wv + 8 * q; const size_t m = m0 + tt;
            const float y = Y[tt * 64 + lane]; const float mu = wave_sum(y) * (1.f / 64.f); const float d = y - mu; const float var = wave_sum(d * d) * (1.f / 64.f);
            const float o = (d * rsqrtf(var + cf::GN_EPS) * lnwv + lnbv + BD[tt] * Vv[tt * 64 + lane]) * G[tt * 64 + lane];
            a.YC[m * 1024 + hj] = (bf16_t)f2bf(o); }
        __syncthreads();
    }
}
#include <hip/hip_cooperative_groups.h>
namespace cg = cooperative_groups;
namespace wsmap {
using cf::MiB;
constexpr size_t CTL = 0, MOD = 1 * MiB, CS = MiB + MiB / 2, H = 3 * MiB, VF = 35 * MiB, W = 67 * MiB, AR = 84 * MiB;
constexpr size_t XA = AR, GA = AR + 32 * MiB, Q = AR + 64 * MiB, K = AR + 88 * MiB, V = AR + 112 * MiB, ZC = AR + 136 * MiB, ZV1 = AR + 240 * MiB, YB = AR + 241 * MiB;
constexpr size_t GT = Q, MG = AR + 96 * MiB, YO = AR + 128 * MiB;
constexpr size_t U = AR, SS = AR + 88 * MiB, YF = AR + 132 * MiB;
constexpr size_t W_G = W, W_PA = W + 6 * MiB, W_PB = W + 8 * MiB, W_PC = W + 8 * MiB + MiB / 2, W_O = W + 10 * MiB + MiB / 2;
constexpr size_t W_UP = W, W_DN = W + 11 * MiB;
}
constexpr int MEGA_LDS = 147456;
struct MegaArgs { const float* in[40]; float* out; unsigned char* ws; };

template <class Epi> __device__ __forceinline__ void run_gemm(unsigned char* lds, const bf16_t* A, int lda, const bf16_t* Bt, int M, int N, int K, const Epi& E) {
    pg8::Gemm g; g.A = A; g.Bt = Bt; g.M = M; g.N = N; g.K = K; g.lda = lda;
    pg8::StaticOrder S; S.init(M, N, (int)gridDim.x, (int)blockIdx.x);
    pg8::gemm_phase<Epi, pg8::StaticOrder, true, true>((PG8_LAS unsigned char*)lds, g, S, E);
}

__global__ __launch_bounds__(512, 2) void mega(MegaArgs A) {
    using namespace wsmap;
    cg::grid_group grid = cg::this_grid();
    extern __shared__ __attribute__((aligned(16))) unsigned char lds[];
#define KARG(i) (((const float* const volatile __attribute__((address_space(4)))*)__builtin_amdgcn_kernarg_segment_ptr())[i])
#define F(i) ((const float*)KARG(i))
#define P_WS ((unsigned char*)KARG(41))
#define GSYNC() do { __syncthreads(); grid.sync(); } while (0)
#define P_X ((float*)KARG(40))
#define P_MOD ((float*)(P_WS + MOD))
#define P_CS ((float*)(P_WS + CS))
#define P_H ((bf16_t*)(P_WS + H))
#define P_VF ((bf16_t*)(P_WS + VF))
#define P_WINT ((bf16_t*)(P_WS + W))
    ph_mod(lds, F(1), F(3), F(4), P_MOD);
    ph_rope((const int*)F(2), P_CS);
    __syncthreads();
    ph_transpose(lds, F(5), 1024, 10752, 0, 7680, P_WINT, 0);
    GSYNC();
    ph_modulate(F(0), P_MOD, 0, 1024, P_H);
    GSYNC();
#pragma unroll 1
    for (int l = 0; l < 2; ++l) {
#define P_MODL (P_MOD + (size_t)l * 4 * 6144)
        { pg8::EpiIn E; E.XA = (bf16_t*)(P_WS + XA); E.GA = (bf16_t*)(P_WS + GA); E.Q = (bf16_t*)(P_WS + Q); E.K = (bf16_t*)(P_WS + K); E.V = (bf16_t*)(P_WS + V); E.ZC = (bf16_t*)(P_WS + ZC); E.ZV1 = (bf16_t*)(P_WS + ZV1); E.cs = P_CS;
          run_gemm(lds, P_H, 1024, P_WINT, cf::M, (30 + l) * 256, 1024, E); }
        GSYNC();
        ph_transpose(lds, F(5) + (size_t)l * 1024 * 10752, 1024, 10752, 7680, 3072, (bf16_t*)(P_WS + W_G), 0);
        ph_transpose(lds, F(28) + (size_t)l * 1024 * 1024, 1024, 1024, 0, 1024, (bf16_t*)(P_WS + W_PA), 0);
        ph_transpose(lds, F(29) + (size_t)l * 256 * 1024, 256, 1024, 0, 1024, (bf16_t*)(P_WS + W_PB), 0);
        ph_transpose(lds, F(30) + (size_t)l * 1024 * 1024, 1024, 1024, 0, 1024, (bf16_t*)(P_WS + W_PC), 0);
        ph_transpose(lds, F(31) + (size_t)l * 1024 * 1024, 1024, 1024, 0, 1024, (bf16_t*)(P_WS + W_O), 0);
        __syncthreads();
        if (blockIdx.x < 64) {
            LruArgs a; a.XA = (const bf16_t*)(P_WS + XA); a.GA = (bf16_t*)(P_WS + GA); a.cw = F(7) + l * 4096; a.cb = F(8) + l * 1024; a.wa = F(9) + l * 65536; a.ba = F(10) + l * 1024; a.wx = F(11) + l * 65536; a.bx = F(12) + l * 1024; a.lam = F(13) + l * 1024;
            ph_lru_item(lds, a, (int)blockIdx.x);
        } else ph_attn(lds, (const bf16_t*)(P_WS + Q), (const bf16_t*)(P_WS + K), (const bf16_t*)(P_WS + V), (bf16_t*)(P_WS + YB), (int)blockIdx.x - 64, (int)gridDim.x - 64);
        GSYNC();
        if (blockIdx.x < 64) {
            WkvArgs a; a.ZC = (const bf16_t*)(P_WS + ZC); a.ZV1 = (const bf16_t*)(P_WS + ZV1); a.VF = P_VF; a.YC = (bf16_t*)(P_WS + XA);
            a.mu = F(14) + l * 3328; a.mu_v = F(15); a.w0 = F(16) + l * 1024; a.w2 = F(17) + l * 65536; a.a0 = F(18) + l * 1024; a.a2 = F(19) + l * 65536; a.g2 = F(20) + l * 131072; a.v0 = F(21); a.v2 = F(22);
            a.k_k = F(23) + l * 1024; a.k_a = F(24) + l * 1024; a.r_k = F(25) + l * 1024; a.lnw = F(26) + l * 1024; a.lnb = F(27) + l * 1024; a.layer = l; a.pad_ = 0;
            ph_wkv_item(lds, a, (int)blockIdx.x);
        }
        GSYNC();
#pragma unroll 1
        for (int br = 0; br < 3; ++br) {
            { pg8::EpiBf16<1> Eg; Eg.O = (bf16_t*)(P_WS + GT); Eg.ldc = 1024; Eg.pad_ = 0;
              run_gemm(lds, P_H, 1024, (const bf16_t*)(P_WS + W_G) + (size_t)br * 1024 * 1024, cf::M, 1024, 1024, Eg); }
            const bf16_t* Y = (const bf16_t*)(P_WS + (br == 0 ? GA : (br == 1 ? YB : XA))); const bf16_t* P = (const bf16_t*)(P_WS + (br == 0 ? W_PA : (br == 1 ? W_PB : W_PC))); const int Kb = (br == 1) ? 256 : 1024;
            if (br == 0) { pg8::EpiMerge<0> Em; Em.MG = (bf16_t*)(P_WS + MG); Em.GT = (const bf16_t*)(P_WS + GT); Em.ldc = 1024; Em.pad_ = 0; run_gemm(lds, Y, Kb, P, cf::M, 1024, Kb, Em); }
            else { pg8::EpiMerge<1> Em; Em.MG = (bf16_t*)(P_WS + MG); Em.GT = (const bf16_t*)(P_WS + GT); Em.ldc = 1024; Em.pad_ = 0; run_gemm(lds, Y, Kb, P, cf::M, 1024, Kb, Em); }
        }
        GSYNC();
        { pg8::EpiF32 E; E.C = (float*)(P_WS + YO); E.ldc = 1024; E.pad_ = 0; run_gemm(lds, (const bf16_t*)(P_WS + MG), 1024, (const bf16_t*)(P_WS + W_O), cf::M, 1024, 1024, E); }
        GSYNC();
        ph_ln(l == 0 ? F(0) : (const float*)P_X, (const float*)(P_WS + YO), 0, cf::M, P_MODL, 2048, F(32) + l * 1024, F(33) + l * 1024, P_X, P_MODL, 3072, 4096, P_H);
        ph_transpose(lds, F(34) + (size_t)l * 1024 * 5632, 1024, 5632, 0, 5632, (bf16_t*)(P_WS + W_UP), 0);
        ph_transpose(lds, F(37) + (size_t)l * 2816 * 1024, 2816, 1024, 0, 1024, (bf16_t*)(P_WS + W_DN), 0);
        GSYNC();
#pragma unroll 1
        for (int hf = 0; hf < 2; ++hf) {
            const int m0 = hf * 8192;
            { pg8::EpiBf16<0> E; E.O = (bf16_t*)(P_WS + U); E.ldc = 5632; E.pad_ = 0; run_gemm(lds, P_H + (size_t)m0 * 1024, 1024, (const bf16_t*)(P_WS + W_UP), 8192, 5632, 1024, E); }
            GSYNC();
            ph_convglu((const bf16_t*)(P_WS + U), 8192, F(35) + l * 3 * 5632, F(36) + l * 5632, (bf16_t*)(P_WS + SS));
            GSYNC();
            { pg8::EpiF32 E; E.C = (float*)(P_WS + YF); E.ldc = 1024; E.pad_ = 0; run_gemm(lds, (const bf16_t*)(P_WS + SS), 2816, (const bf16_t*)(P_WS + W_DN), 8192, 1024, 2816, E); }
            GSYNC();
            ph_ln((const float*)P_X, (const float*)(P_WS + YF), m0, 8192, P_MODL, 5120, F(38) + l * 1024, F(39) + l * 1024, P_X, P_MOD + 4 * 6144, 0, 1024, l == 0 ? P_H : (bf16_t*)nullptr);
            GSYNC();
        }
        if (l == 0) {
            ph_transpose(lds, F(5) + (size_t)1024 * 10752, 1024, 10752, 0, 7680, P_WINT, 0);
            ph_transpose(lds, F(6), 1024, 32, 0, 32, P_WINT, 7680);
            ph_zero16((u32x4*)(P_WINT + (size_t)7712 * 1024), (size_t)224 * 1024 * 2 / 16);
            GSYNC();
        }
    }
#undef F
#undef GSYNC
#undef P_WS
#undef P_X
#undef P_MOD
#undef P_CS
#undef P_H
#undef P_VF
#undef P_WINT
#undef P_MODL
}

extern "C" void kernel_launch(void* const* d_in, const int* in_sizes, int n_in, void* d_out, int out_size, void* d_ws, size_t ws_size, hipStream_t stream) {
    static int grid = 0;
    if (grid == 0) {
        int dev = 0, cus = 0, per_cu = 0;
        (void)hipGetDevice(&dev); (void)hipDeviceGetAttribute(&cus, hipDeviceAttributeMultiprocessorCount, dev);
        (void)hipFuncSetAttribute((const void*)mega, hipFuncAttributeMaxDynamicSharedMemorySize, MEGA_LDS);
        (void)hipOccupancyMaxActiveBlocksPerMultiprocessor(&per_cu, (const void*)mega, 512, MEGA_LDS);
        if (per_cu < 1) { fprintf(stderr, "kernel_launch: occupancy query says %d workgroups per CU\n", per_cu); per_cu = 1; }
        grid = cus;
        if (grid != 256) fprintf(stderr, "kernel_launch: %d CUs (built for 256)\n", grid);
    }
    (void)hipMemsetAsync((char*)d_ws + wsmap::CTL, 0, cf::MiB, stream);
    MegaArgs a{};
    for (int i = 0; i < 40; ++i) a.in[i] = (const float*)d_in[i];
    a.out = (float*)d_out; a.ws = (unsigned char*)d_ws;
    void* args[] = {&a};
    hipError_t e = hipLaunchCooperativeKernel((const void*)mega, dim3(grid), dim3(512), args, MEGA_LDS, stream);
    if (e != hipSuccess) fprintf(stderr, "cooperative launch failed: %s (grid %d)\n", hipGetErrorString(e), grid);
}
```

```cpp
#include <hip/hip_runtime.h>
#include <cstdio>
#include <cstdint>
namespace pg8 {
#define PG8_LAS __attribute__((address_space(3)))
typedef unsigned short bf16_t;
typedef short bf16x8 __attribute__((ext_vector_type(8)));
typedef float f32x4 __attribute__((ext_vector_type(4)));
typedef unsigned u32x4 __attribute__((ext_vector_type(4)));
typedef unsigned u32x2 __attribute__((ext_vector_type(2)));
constexpr int BM = 256, BK = 64, HALF = 128, HTB = HALF * BK * 2, STAGE_BYTES = 8 * HTB, NXCD = 8, WGM = 8;

__host__ __device__ __forceinline__ int lds_byte(int r, int c) { const int st = (r >> 4) * 2 + (c >> 5), rr = r & 15, cc = c & 31, ob = rr * 64 + cc * 2; return st * 1024 + (ob ^ (((ob >> 9) & 1) << 5)); }
__host__ __device__ __forceinline__ void stage_rc(int b, int& R, int& C) { const int st = b / 1024, sb = b % 1024, swz = sb ^ (((sb >> 9) & 1) << 5); R = (st >> 1) * 16 + swz / 64; C = (st & 1) * 32 + (swz % 64) / 2; }
__host__ __device__ __forceinline__ int perm32(int rho) { const int n = rho >> 4, i = rho & 15; return 8 * (i >> 2) + 4 * n + (i & 3); }

struct Unit { int pm, pn; };
struct Gemm { const bf16_t* A; const bf16_t* Bt; int M, N, K, lda; };

struct StaticOrder {
    int nM, nN, nwg, G, c;
    __host__ __device__ void init(int M, int N, int G_, int c_) { nM = M / BM; nN = N / BM; nwg = nM * nN; G = G_; c = c_; }
    __host__ __device__ bool next(int i, Unit& u) const {
        const long L = (long)i * G + c; if (L >= nwg) return false;
        int wgid = (int)L; { const int q = nwg / NXCD, r = nwg % NXCD, xcd = wgid % NXCD, off = wgid / NXCD; wgid = (xcd < r ? xcd * (q + 1) : r * (q + 1) + (xcd - r) * q) + off; }
        const int nig = WGM * nN, gid = wgid / nig, fm = gid * WGM, gsz = (nM - fm) < WGM ? (nM - fm) : WGM;
        u.pm = fm + ((wgid % nig) % gsz); u.pn = (wgid % nig) / gsz; return true;
    }
    __device__ __forceinline__ void a_ready(const Unit&) const {}
    __device__ __forceinline__ void done(const Unit&) const {}
};

typedef float f32x2_cv __attribute__((ext_vector_type(2)));
typedef __bf16 bf16x2_cv __attribute__((ext_vector_type(2)));
__device__ __forceinline__ unsigned cvt_pk_bf16(float lo, float hi) { const f32x2_cv f = {lo, hi}; const bf16x2_cv r = __builtin_convertvector(f, bf16x2_cv); return __builtin_bit_cast(unsigned, r); }

template <class Epi, class Sched, bool ALIGN_EPI = false, bool SP2 = false>
__device__ __forceinline__ void gemm_phase(PG8_LAS unsigned char* lds, const Gemm g, const Sched& S, const Epi& E) {
    int tid = threadIdx.x; asm volatile("" : "+v"(tid));
    const int wid = __builtin_amdgcn_readfirstlane(tid >> 6), lane = tid & 63, wr = wid >> 2, wc = wid & 3, fr = lane & 15, fq = lane >> 4;
    const int K = g.K, nt = K / BK, lda = g.lda;
    unsigned voffA[2], voffB[2];
#pragma unroll
    for (int i = 0; i < 2; ++i) { int R, C; stage_rc(tid * 16 + i * 8192, R, C); const int Rb = Epi::PERM ? ((R & ~31) + perm32(R & 31)) : R;
        voffA[i] = (unsigned)(R * lda + C) * 2u; voffB[i] = (unsigned)(Rb * K + C) * 2u; }
    const size_t kstep = (size_t)(BK * 2);
    const size_t hstepA = (size_t)HALF * lda * 2, hstepB = (size_t)HALF * K * 2;
    const size_t tstepA = 2 * hstepA, tstepB = 2 * hstepB;
    const unsigned ldsw = (unsigned)wid * 1024u;
    const int aoff = lds_byte(wr * 64 + fr, fq * 8), boff = lds_byte(wc * 32 + fr, fq * 8);
#define PG8_SA(b, h) (((b) * 2 + (h)) * HTB)
#define PG8_SB(b, h) ((4 + (b) * 2 + (h)) * HTB)
#define PG8_STAGE(bufoff, gbase, voff) do { _Pragma("unroll") for (int _i = 0; _i < 2; ++_i) \
        __builtin_amdgcn_global_load_lds((const unsigned*)((const char*)(gbase) + (voff)[_i]), (PG8_LAS unsigned*)(lds + (bufoff) + ldsw + _i * 8192), 16, 0, 0); } while (0)
#define PG8_LDA(dst, b, h) do { _Pragma("unroll") for (int m = 0; m < 4; ++m) _Pragma("unroll") for (int k = 0; k < 2; ++k) dst[m][k] = *(const PG8_LAS bf16x8*)(lds + PG8_SA(b, h) + aoff + m * 2048 + k * 1024); } while (0)
#define PG8_LDB(dst, b, h) do { _Pragma("unroll") for (int n = 0; n < 2; ++n) _Pragma("unroll") for (int k = 0; k < 2; ++k) dst[n][k] = *(const PG8_LAS bf16x8*)(lds + PG8_SB(b, h) + boff + n * 2048 + k * 1024); } while (0)
#define PG8_MMA(ai, bj, At, Bt) do { __builtin_amdgcn_s_setprio(1); _Pragma("unroll") for (int m = 0; m < 4; ++m) _Pragma("unroll") for (int n = 0; n < 2; ++n) _Pragma("unroll") for (int k = 0; k < 2; ++k) \
        acc[ai][bj][m][n] = __builtin_amdgcn_mfma_f32_16x16x32_bf16(Bt[n][k], At[m][k], acc[ai][bj][m][n], 0, 0, 0); __builtin_amdgcn_s_setprio(0); } while (0)
#define PG8_WAIT_V(n) asm volatile("s_waitcnt vmcnt(" #n ")" ::: "memory")
#define PG8_WAIT_L(n) asm volatile("s_waitcnt lgkmcnt(" #n ")" ::: "memory")
#define PG8_BAR __builtin_amdgcn_s_barrier()
#define PG8_SCHED __builtin_amdgcn_sched_barrier(0)
    Unit cur, nxt; int ui = 0;
    if (!S.next(0, cur)) return;
    f32x4 acc[2][2][4][2];
#pragma unroll
    for (int a = 0; a < 2; ++a)
#pragma unroll
        for (int b = 0; b < 2; ++b)
#pragma unroll
            for (int m = 0; m < 4; ++m)
#pragma unroll
                for (int n = 0; n < 2; ++n) acc[a][b][m][n] = (f32x4){0.f, 0.f, 0.f, 0.f};
    bf16x8 At[4][2], B0[2][2], B1[2][2];
    const char* cA = (const char*)g.A + (size_t)cur.pm * tstepA; const char* cB = (const char*)g.Bt + (size_t)cur.pn * tstepB;
    S.a_ready(cur);
    if constexpr (SP2) {
        PG8_STAGE(PG8_SB(0, 0), cB, voffB); PG8_STAGE(PG8_SB(0, 1), cB + hstepB, voffB); PG8_STAGE(PG8_SA(0, 0), cA, voffA); PG8_STAGE(PG8_SA(0, 1), cA + hstepA, voffA);
        if (wr == 1) PG8_BAR;
        PG8_WAIT_V(2); PG8_BAR;
        PG8_STAGE(PG8_SB(1, 0), cB + kstep, voffB); PG8_STAGE(PG8_SA(1, 0), cA + kstep, voffA); PG8_STAGE(PG8_SB(1, 1), cB + hstepB + kstep, voffB);
        PG8_WAIT_V(6); PG8_BAR;
    } else {
        PG8_STAGE(PG8_SB(0, 0), cB, voffB); PG8_STAGE(PG8_SA(0, 0), cA, voffA); PG8_STAGE(PG8_SB(0, 1), cB + hstepB, voffB); PG8_STAGE(PG8_SA(0, 1), cA + hstepA, voffA);
        if (wr == 1) PG8_BAR;
        PG8_WAIT_V(4); PG8_BAR;
        PG8_STAGE(PG8_SB(1, 0), cB + kstep, voffB); PG8_STAGE(PG8_SA(1, 0), cA + kstep, voffA); PG8_STAGE(PG8_SB(1, 1), cB + hstepB + kstep, voffB);
        PG8_WAIT_V(6); PG8_BAR;
    }
    for (;;) {
        const bool has_next = S.next(ui + 1, nxt);
        const char* nA = has_next ? (const char*)g.A + (size_t)nxt.pm * tstepA : cA; const char* nB = has_next ? (const char*)g.Bt + (size_t)nxt.pn * tstepB : cB;
        for (int t = 0; t < nt; t += 2) {
            const bool last = (t == nt - 2);
            const char* a1 = cA + (size_t)(t + 1) * kstep;
            const char* a2 = last ? nA : cA + (size_t)(t + 2) * kstep; const char* b2 = last ? nB : cB + (size_t)(t + 2) * kstep;
            const char* a3 = a2 + kstep; const char* b3 = b2 + kstep;
            if (last && has_next) S.a_ready(nxt);
            if constexpr (SP2) {
            PG8_LDB(B0, 0, 0); PG8_LDB(B1, 0, 1); PG8_SCHED; PG8_LDA(At, 0, 0); PG8_STAGE(PG8_SA(1, 1), a1 + hstepA, voffA);
            PG8_WAIT_V(8); PG8_WAIT_L(0); PG8_BAR; PG8_MMA(0, 0, At, B0); PG8_MMA(0, 1, At, B1); PG8_BAR; PG8_SCHED;
            PG8_LDA(At, 0, 1); PG8_STAGE(PG8_SB(0, 0), b2, voffB); PG8_STAGE(PG8_SB(0, 1), b2 + hstepB, voffB); PG8_STAGE(PG8_SA(0, 0), a2, voffA);
            PG8_WAIT_V(8); PG8_WAIT_L(0); PG8_BAR; PG8_MMA(1, 0, At, B0); PG8_MMA(1, 1, At, B1); PG8_BAR; PG8_SCHED;
            PG8_LDB(B0, 1, 0); PG8_LDB(B1, 1, 1); PG8_SCHED; PG8_LDA(At, 1, 0); PG8_STAGE(PG8_SA(0, 1), a2 + hstepA, voffA);
            PG8_WAIT_V(8); PG8_WAIT_L(0); PG8_BAR; PG8_MMA(0, 0, At, B0); PG8_MMA(0, 1, At, B1); PG8_BAR; PG8_SCHED;
            PG8_LDA(At, 1, 1); PG8_STAGE(PG8_SB(1, 0), b3, voffB); PG8_STAGE(PG8_SB(1, 1), b3 + hstepB, voffB); PG8_STAGE(PG8_SA(1, 0), a3, voffA);
            PG8_WAIT_V(8); PG8_WAIT_L(0); PG8_BAR; PG8_MMA(1, 0, At, B0); PG8_MMA(1, 1, At, B1); PG8_BAR; PG8_SCHED;
            } else {
            PG8_LDB(B0, 0, 0); PG8_SCHED; PG8_LDA(At, 0, 0); PG8_STAGE(PG8_SA(1, 1), a1 + hstepA, voffA);
            PG8_WAIT_L(8); PG8_BAR; PG8_WAIT_L(0); PG8_MMA(0, 0, At, B0); PG8_BAR; PG8_SCHED;
            PG8_LDB(B1, 0, 1); PG8_STAGE(PG8_SB(0, 0), b2, voffB);
            PG8_BAR; PG8_WAIT_L(0); PG8_MMA(0, 1, At, B1); PG8_BAR;
            PG8_LDA(At, 0, 1); PG8_STAGE(PG8_SA(0, 0), a2, voffA);
            PG8_BAR; PG8_WAIT_L(0); PG8_MMA(1, 0, At, B0); PG8_BAR; PG8_SCHED;
            PG8_STAGE(PG8_SB(0, 1), b2 + hstepB, voffB);
            PG8_WAIT_V(6); PG8_BAR; PG8_MMA(1, 1, At, B1); PG8_BAR;
            PG8_LDB(B0, 1, 0); PG8_SCHED; PG8_LDA(At, 1, 0); PG8_STAGE(PG8_SA(0, 1), a2 + hstepA, voffA);
            PG8_WAIT_L(8); PG8_BAR; PG8_WAIT_L(0); PG8_MMA(0, 0, At, B0); PG8_BAR; PG8_SCHED;
            PG8_LDB(B1, 1, 1); PG8_STAGE(PG8_SB(1, 0), b3, voffB);
            PG8_BAR; PG8_WAIT_L(0); PG8_MMA(0, 1, At, B1); PG8_BAR;
            PG8_LDA(At, 1, 1); PG8_STAGE(PG8_SA(1, 0), a3, voffA);
            PG8_BAR; PG8_WAIT_L(0); PG8_MMA(1, 0, At, B0); PG8_BAR; PG8_SCHED;
            PG8_STAGE(PG8_SB(1, 1), b3 + hstepB, voffB);
            PG8_WAIT_V(6); PG8_BAR; PG8_MMA(1, 1, At, B1); PG8_BAR;
            }
        }
        if constexpr (ALIGN_EPI) { if (wr == 0) PG8_BAR; }
        if constexpr (!Epi::AFTER_DRAIN) { E(acc, cur, wr, wc, fr, fq); S.done(cur); }
        if (!has_next) break;
#pragma unroll
        for (int a = 0; a < 2; ++a)
#pragma unroll
            for (int b = 0; b < 2; ++b)
#pragma unroll
                for (int m = 0; m < 4; ++m)
#pragma unroll
                    for (int n = 0; n < 2; ++n) acc[a][b][m][n] = (f32x4){0.f, 0.f, 0.f, 0.f};
        cur = nxt; cA = nA; cB = nB; ++ui;
        if constexpr (ALIGN_EPI) { if (wr == 1) PG8_BAR; }
    }
    PG8_WAIT_V(0);
    if constexpr (!ALIGN_EPI) { if (wr == 0) PG8_BAR; }
    PG8_BAR;
    if constexpr (Epi::AFTER_DRAIN) { E.fused(acc, cur, wr, wc, fr, fq, lds, wid, lane); S.done(cur); }
#undef PG8_SA
#undef PG8_SB
#undef PG8_STAGE
#undef PG8_LDA
#undef PG8_LDB
#undef PG8_MMA
#undef PG8_WAIT_V
#undef PG8_WAIT_L
#undef PG8_BAR
#undef PG8_SCHED
}
}
namespace cf {
constexpr int D = 1024, NB = 4, SEQ = 4096, M = NB * SEQ;
constexpr int DFF = 2816, NSHIFT = 3328;
constexpr float ALPHA = 1.41421356237309515f;
constexpr float LN_EPS = 1e-5f, GN_EPS = 64e-5f;
constexpr size_t MiB = 1u << 20;
}
typedef unsigned short bf16_t;
typedef float f32x4 __attribute__((ext_vector_type(4)));
typedef unsigned u32x4 __attribute__((ext_vector_type(4)));
typedef unsigned u32x2 __attribute__((ext_vector_type(2)));

__device__ __forceinline__ unsigned f2bf(float f) { return pg8::cvt_pk_bf16(f, 0.f) & 0xffffu; }
__device__ __forceinline__ unsigned pk2(float lo, float hi) { return pg8::cvt_pk_bf16(lo, hi); }
__device__ __forceinline__ float bf2f(unsigned short b) { return __builtin_bit_cast(float, ((unsigned)b) << 16); }
__device__ __forceinline__ float bflo(unsigned w) { return __builtin_bit_cast(float, w << 16); }
__device__ __forceinline__ float bfhi(unsigned w) { return __builtin_bit_cast(float, w & 0xffff0000u); }
__device__ __forceinline__ float rcpf_(float x) { return __builtin_amdgcn_rcpf(x); }
__device__ __forceinline__ float sigmoidf_(float x) { return rcpf_(1.0f + __expf(-x)); }
__device__ __forceinline__ float tanhf_(float x) { const float e = __expf(2.0f * x); return 1.0f - 2.0f * rcpf_(e + 1.0f); }
__device__ __forceinline__ float gelu_tanh(float x) { const float u = 0.7978845608028654f * (x + 0.044715f * x * x * x); return 0.5f * x * (1.0f + tanhf_(u)); }
__device__ __forceinline__ float silu_(float x) { return x * rcpf_(1.0f + __expf(-x)); }
template <int CTRL> __device__ __forceinline__ float dpp_mov(float v) { return __builtin_bit_cast(float, __builtin_amdgcn_update_dpp(0, __builtin_bit_cast(int, v), CTRL, 0xf, 0xf, true)); }
__device__ __forceinline__ float sum_quad(float v) { v += dpp_mov<0xB1>(v); v += dpp_mov<0x4E>(v); return v; }
__device__ __forceinline__ float sum_oct(float v) { v = sum_quad(v); v += dpp_mov<0x141>(v); return v; }
__device__ __forceinline__ float sum_row16(float v) { v = sum_oct(v); v += dpp_mov<0x140>(v); return v; }
__device__ __forceinline__ float readlane_f(float v, int l) { return __builtin_bit_cast(float, __builtin_amdgcn_readlane(__builtin_bit_cast(int, v), l)); }
__device__ __forceinline__ float wave_sum(float v) { v = sum_row16(v); return (readlane_f(v, 0) + readlane_f(v, 16)) + (readlane_f(v, 32) + readlane_f(v, 48)); }
__device__ __forceinline__ float wave_max(float v) {
#pragma unroll
    for (int o = 1; o < 64; o <<= 1) v = fmaxf(v, __shfl_xor(v, o));
    return v;
}

namespace pg8 {
struct EpiIn {
    static constexpr bool PERM = true, AFTER_DRAIN = false;
    bf16_t *XA, *GA, *Q, *K, *V, *ZC, *ZV1; const float* cs;
    __device__ __forceinline__ void operator()(const f32x4 (&acc)[2][2][4][2], const Unit& u, int wr, int wc, int fr, int fq) const {
        const int pn = u.pn; bf16_t* dst; int ldc, colt, mode;
        if (pn < 4) { dst = XA; ldc = 1024; colt = pn * 256; mode = 0; }
        else if (pn < 8) { dst = GA; ldc = 1024; colt = (pn - 4) * 256; mode = 1; }
        else if (pn < 11) { dst = Q; ldc = 768; colt = (pn - 8) * 256; mode = 2; }
        else if (pn < 14) { dst = K; ldc = 768; colt = (pn - 11) * 256; mode = 3; }
        else if (pn < 17) { dst = V; ldc = 768; colt = (pn - 14) * 256; mode = 5; }
        else if (pn < 30) { dst = ZC; ldc = 3328; colt = (pn - 17) * 256; mode = 0; }
        else { dst = ZV1; ldc = 32; colt = 0; mode = 4; }
        const int row0 = u.pm * BM + wr * 64 + fr;
        const bool rot = (mode == 2 || mode == 3) && ((wc & 1) == 0);
        const float sgn = (fq == 0) ? -1.0f : 1.0f; const bool rl = fq < 2;
#pragma unroll
        for (int ai = 0; ai < 2; ++ai)
#pragma unroll
            for (int m = 0; m < 4; ++m) {
                const int row = row0 + ai * HALF + m * 16;
                f32x4 c0 = {1.f, 1.f, 1.f, 1.f}, c1 = c0, s0 = {0.f, 0.f, 0.f, 0.f}, s1 = s0;
                if (rot) { const f32x4* p = (const f32x4*)(cs + (size_t)row * 16); c0 = p[0]; c1 = p[1]; s0 = p[2]; s1 = p[3]; }
#pragma unroll
                for (int bj = 0; bj < 2; ++bj) {
                    f32x4 v0 = acc[ai][bj][m][0], v1 = acc[ai][bj][m][1];
                    if (mode == 1) {
#pragma unroll
                        for (int j = 0; j < 4; ++j) { v0[j] = gelu_tanh(v0[j]); v1[j] = gelu_tanh(v1[j]); }
                    }
                    if (rot) {
                        f32x4 p0, p1;
#pragma unroll
                        for (int j = 0; j < 4; ++j) { p0[j] = __shfl_xor(v0[j], 16); p1[j] = __shfl_xor(v1[j], 16); }
                        if (rl) { v0 = v0 * c0 + (p0 * s0) * sgn; v1 = v1 * c1 + (p1 * s1) * sgn; }
                    }
                    if (mode == 2) { v0 = v0 * 0.125f; v1 = v1 * 0.125f; }
                    u32x4 w; w.x = cvt_pk_bf16(v0[0], v0[1]); w.y = cvt_pk_bf16(v0[2], v0[3]); w.z = cvt_pk_bf16(v1[0], v1[1]); w.w = cvt_pk_bf16(v1[2], v1[3]);
                    const int col = colt + bj * HALF + wc * 32 + 8 * fq;
                    if (mode == 5) {
                        const int head = col >> 6, dim0 = col & 63, lg = (head >> 2) * 2, bb = row >> 12, ss = row & 4095;
                        const int perm = ((ss & ((1 << lg) - 1)) << (12 - lg)) + (ss >> lg);
                        bf16_t* vp = dst + ((size_t)(bb * 12 + head) * 64 + dim0) * 4096 + perm;
                        vp[0] = (bf16_t)(w.x & 0xffffu); vp[4096] = (bf16_t)(w.x >> 16); vp[2 * 4096] = (bf16_t)(w.y & 0xffffu); vp[3 * 4096] = (bf16_t)(w.y >> 16);
                        vp[4 * 4096] = (bf16_t)(w.z & 0xffffu); vp[5 * 4096] = (bf16_t)(w.z >> 16); vp[6 * 4096] = (bf16_t)(w.w & 0xffffu); vp[7 * 4096] = (bf16_t)(w.w >> 16);
                    } else if (mode != 4 || (bj == 0 && wc == 0)) *(u32x4*)(dst + (size_t)row * ldc + col) = w;
                }
            }
    }
};
template <int ACT  > struct EpiBf16 {
    static constexpr bool PERM = true, AFTER_DRAIN = false;
    bf16_t* O; int ldc; int pad_;
    __device__ __forceinline__ void operator()(const f32x4 (&acc)[2][2][4][2], const Unit& u, int wr, int wc, int fr, int fq) const {
        const int row0 = u.pm * BM + wr * 64 + fr, col0 = u.pn * BM + wc * 32 + 8 * fq;
#pragma unroll
        for (int ai = 0; ai < 2; ++ai)
#pragma unroll
            for (int m = 0; m < 4; ++m) { bf16_t* rowp = O + (size_t)(row0 + ai * HALF + m * 16) * ldc + col0;
#pragma unroll
                for (int bj = 0; bj < 2; ++bj) { f32x4 v0 = acc[ai][bj][m][0], v1 = acc[ai][bj][m][1];
                    if (ACT == 1) {
#pragma unroll
                        for (int j = 0; j < 4; ++j) { v0[j] = sigmoidf_(v0[j]); v1[j] = sigmoidf_(v1[j]); }
                    }
                    u32x4 w; w.x = cvt_pk_bf16(v0[0], v0[1]); w.y = cvt_pk_bf16(v0[2], v0[3]); w.z = cvt_pk_bf16(v1[0], v1[1]); w.w = cvt_pk_bf16(v1[2], v1[3]);
                    *(u32x4*)(rowp + bj * HALF) = w; } }
    }
};
struct EpiF32 {
    static constexpr bool PERM = false, AFTER_DRAIN = false;
    float* C; int ldc; int pad_;
    __device__ __forceinline__ void operator()(const f32x4 (&acc)[2][2][4][2], const Unit& u, int wr, int wc, int fr, int fq) const {
        const int row0 = u.pm * BM + wr * 64 + fr, col0 = u.pn * BM + wc * 32 + 4 * fq;
#pragma unroll
        for (int ai = 0; ai < 2; ++ai)
#pragma unroll
            for (int m = 0; m < 4; ++m) { float* rowp = C + (size_t)(row0 + ai * HALF + m * 16) * ldc + col0;
#pragma unroll
                for (int bj = 0; bj < 2; ++bj)
#pragma unroll
                    for (int n = 0; n < 2; ++n) *(f32x4*)(rowp + bj * HALF + n * 16) = acc[ai][bj][m][n]; }
    }
};
template <int ADD> struct EpiMerge {
    static constexpr bool PERM = true, AFTER_DRAIN = false;
    bf16_t* MG; const bf16_t* GT; int ldc; int pad_;
    __device__ __forceinline__ void operator()(const f32x4 (&acc)[2][2][4][2], const Unit& u, int wr, int wc, int fr, int fq) const {
        const int row0 = u.pm * BM + wr * 64 + fr, col0 = u.pn * BM + wc * 32 + 8 * fq;
#pragma unroll
        for (int ai = 0; ai < 2; ++ai)
#pragma unroll
            for (int m = 0; m < 4; ++m) { const size_t off = (size_t)(row0 + ai * HALF + m * 16) * ldc + col0;
#pragma unroll
                for (int bj = 0; bj < 2; ++bj) { f32x4 v0 = acc[ai][bj][m][0], v1 = acc[ai][bj][m][1];
                    const u32x4 gw = *(const u32x4*)(GT + off + bj * HALF);
                    v0[0] *= bflo(gw.x); v0[1] *= bfhi(gw.x); v0[2] *= bflo(gw.y); v0[3] *= bfhi(gw.y);
                    v1[0] *= bflo(gw.z); v1[1] *= bfhi(gw.z); v1[2] *= bflo(gw.w); v1[3] *= bfhi(gw.w);
                    if (ADD) { const u32x4 mw = *(const u32x4*)(MG + off + bj * HALF);
                        v0[0] += bflo(mw.x); v0[1] += bfhi(mw.x); v0[2] += bflo(mw.y); v0[3] += bfhi(mw.y);
                        v1[0] += bflo(mw.z); v1[1] += bfhi(mw.z); v1[2] += bflo(mw.w); v1[3] += bfhi(mw.w); }
                    u32x4 w; w.x = cvt_pk_bf16(v0[0], v0[1]); w.y = cvt_pk_bf16(v0[2], v0[3]); w.z = cvt_pk_bf16(v1[0], v1[1]); w.w = cvt_pk_bf16(v1[2], v1[3]);
                    *(u32x4*)(MG + off + bj * HALF) = w; } }
    }
};
}

constexpr int GEMM_LDS = 147456;
template <class Epi> __global__ __launch_bounds__(512, 2) void k_gemm(pg8::Gemm g, Epi E) {
    extern __shared__ __attribute__((aligned(16))) unsigned char shm[];
    pg8::StaticOrder S; S.init(g.M, g.N, (int)gridDim.x, (int)blockIdx.x);
    pg8::gemm_phase<Epi, pg8::StaticOrder, true, true>((PG8_LAS unsigned char*)shm, g, S, E);
}
#define LAS __attribute__((address_space(3)))
#define XB_TMO      128
#define XB_XCNT(j)  (256  + 64 * (j))
#define XB_XSUB(j)  (1280 + 64 * (j))
#define XB_XGEN(j)  (2304 + 64 * (j))
#define XB_TOP      3328
#define XB_TOPGEN   3392
#define XCD_BAR_WORDS 3456
#define XB_SPIN_CAP (1u << 18)
__device__ __forceinline__ unsigned xb_ld(unsigned* p)              { return __hip_atomic_load(p, __ATOMIC_RELAXED, __HIP_MEMORY_SCOPE_AGENT); }
__device__ __forceinline__ unsigned xb_add(unsigned* p, unsigned v) { return __hip_atomic_fetch_add(p, v, __ATOMIC_RELAXED, __HIP_MEMORY_SCOPE_AGENT); }
__device__ __forceinline__ unsigned xb_xcc_id() { return (unsigned)__builtin_amdgcn_s_getreg((3 << 11) | 20) & 0xFu; }
#define XB_SPIN(cond, bar) do { unsigned _sp = 0; while (cond) { __builtin_amdgcn_s_sleep(1); \
    if ((++_sp & 255u) == 0u) { if (xb_ld(&(bar)[XB_TMO])) break; if (_sp > XB_SPIN_CAP) { atomicAdd(&(bar)[XB_TMO], 1u); break; } } } } while (0)
struct XcdBarrier { unsigned* bar; unsigned x; volatile LAS unsigned* st; };
__device__ __forceinline__ XcdBarrier xcd_barrier_post(unsigned* bar, volatile LAS unsigned* st) {
    XcdBarrier b; b.bar = bar; b.x = xb_xcc_id(); b.st = st;
    if (threadIdx.x == 0) (void)xb_add(&bar[XB_XCNT(b.x)], 1u);
    return b;
}
__device__ __forceinline__ void xcd_barrier_complete(unsigned* bar, unsigned x, unsigned& nloc, unsigned& nx) {
    const unsigned G = gridDim.x * gridDim.y * gridDim.z;
    unsigned sum, cnt, mine, sp = 0u;
    for (;;) {
        sum = 0u; cnt = 0u; mine = 0u;
#pragma unroll
        for (unsigned j = 0; j < 16; ++j) { const unsigned c = xb_ld(&bar[XB_XCNT(j)]); sum += c; cnt += (c > 0u) ? 1u : 0u; mine = (j == x) ? c : mine; }
        if (sum == G) break;
        __builtin_amdgcn_s_sleep(1);
        if ((++sp & 255u) == 0u) { if (xb_ld(&bar[XB_TMO])) break; if (sp > XB_SPIN_CAP) { atomicAdd(&bar[XB_TMO], 1u); break; } }
    }
    nloc = mine > 0u ? mine : 1u; nx = cnt > 0u ? cnt : 1u;
}
__device__ __forceinline__ void xcd_barrier(const XcdBarrier& b) {
    asm volatile("s_waitcnt vmcnt(0)" ::: "memory");
    __syncthreads();
    if (threadIdx.x == 0) {
        unsigned* bar = b.bar;
        __builtin_amdgcn_s_waitcnt(0);
        unsigned nloc = b.st[0], nx = b.st[1];
        if (nloc == 0u) { xcd_barrier_complete(bar, b.x, nloc, nx); b.st[0] = nloc; b.st[1] = nx; }
        const unsigned old = xb_add(&bar[XB_XSUB(b.x)], 1u);
        const unsigned gen = old / nloc;
        if (old + 1u == (gen + 1u) * nloc) {
            __builtin_amdgcn_fence(__ATOMIC_RELEASE, "agent");
            asm volatile("s_waitcnt vmcnt(0)" ::: "memory");
            const unsigned og = xb_add(&bar[XB_TOP], 1u);
            const unsigned tg = og / nx;
            if (og + 1u == (tg + 1u) * nx) xb_add(&bar[XB_TOPGEN], 1u);
            else XB_SPIN(xb_ld(&bar[XB_TOPGEN]) == tg, bar);
            __builtin_amdgcn_fence(__ATOMIC_ACQUIRE, "agent");
            xb_add(&bar[XB_XGEN(b.x)], 1u);
            asm volatile("s_waitcnt vmcnt(0)" ::: "memory");
        } else {
            XB_SPIN(xb_ld(&bar[XB_XGEN(b.x)]) == gen, bar);
            __builtin_amdgcn_fence(__ATOMIC_ACQUIRE, "agent");
            asm volatile("s_waitcnt vmcnt(0)" ::: "memory");
        }
    }
    __syncthreads();
}
#define LDSF(off) ((float*)(lds + (off)))
typedef short bf16x8_t __attribute__((ext_vector_type(8)));
__device__ __forceinline__ int opaque_tid() { int t = threadIdx.x; asm volatile("" : "+v"(t)); return t; }
__device__ __forceinline__ void ph_mod(unsigned char* lds, const float* __restrict__ c, const float* __restrict__ mod_w, const float* __restrict__ mod_b, float* __restrict__ mod) {
    float* sc = LDSF(0); float* red = LDSF(16384);
    const int tid = opaque_tid(), col = tid & 63, ks = tid >> 6;
    for (int i = tid; i < 4096; i += 512) sc[i] = silu_(c[i]);
    __syncthreads();
    for (int it = blockIdx.x; it < 192; it += gridDim.x) {
        const int l = it / 96, n = (it % 96) * 64 + col;
        const float* W = mod_w + (size_t)l * 1024 * 6144 + n;
        float a0 = 0.f, a1 = 0.f, a2 = 0.f, a3 = 0.f;
        for (int k = ks * 128; k < ks * 128 + 128; ++k) { const float w = W[(size_t)k * 6144]; a0 += sc[k] * w; a1 += sc[1024 + k] * w; a2 += sc[2048 + k] * w; a3 += sc[3072 + k] * w; }
        red[(ks * 4 + 0) * 64 + col] = a0; red[(ks * 4 + 1) * 64 + col] = a1; red[(ks * 4 + 2) * 64 + col] = a2; red[(ks * 4 + 3) * 64 + col] = a3;
        __syncthreads();
        if (tid < 256) { const int b = tid >> 6; float s = mod_b[l * 6144 + n];
#pragma unroll
            for (int q = 0; q < 8; ++q) s += red[(q * 4 + b) * 64 + col];
            mod[((size_t)l * 4 + b) * 6144 + n] = s; }
        __syncthreads();
    }
}
__device__ __forceinline__ void ph_rope(const int* __restrict__ pos, float* __restrict__ cs) {
    for (int e = blockIdx.x * 512 + opaque_tid(); e < cf::M * 8; e += gridDim.x * 512) {
        const int m = e >> 3, i = e & 7;
        const float inv = powf(500000.0f, -(float)i / 8.0f);
        const float ang = (float)pos[m] * inv;
        cs[m * 16 + i] = cosf(ang); cs[m * 16 + 8 + i] = sinf(ang); }
}
__device__ __forceinline__ void ph_transpose(unsigned char* lds, const float* __restrict__ W, int K, int Nsrc, int c0, int nc, bf16_t* __restrict__ WT, int r0) {
    const int tid_ = opaque_tid(); const int lane = tid_ & 63, wave = tid_ >> 6;
    float* scr = LDSF(wave * 64 * 33 * 4);
    const int nblk = nc / 32, nitems = (K / 64) * nblk;
    for (int item = blockIdx.x * 8 + wave; item < nitems; item += gridDim.x * 8) {
        const int kb = item / nblk, nb = item % nblk, k0 = 64 * kb, n0 = 32 * nb;
#pragma unroll 8
        for (int i = 0; i < 32; ++i) { const int kk = 2 * i + (lane >> 5); scr[kk * 33 + (lane & 31)] = W[(size_t)(k0 + kk) * Nsrc + c0 + n0 + (lane & 31)]; }
        __builtin_amdgcn_wave_barrier(); asm volatile("s_waitcnt lgkmcnt(0)" ::: "memory");
        const int c = lane & 7;
#pragma unroll
        for (int j = 0; j < 4; ++j) { const int n = (lane >> 3) + 8 * j; const float* s = scr + (8 * c) * 33 + n;
            u32x4 o; o.x = pk2(s[0 * 33], s[1 * 33]); o.y = pk2(s[2 * 33], s[3 * 33]); o.z = pk2(s[4 * 33], s[5 * 33]); o.w = pk2(s[6 * 33], s[7 * 33]);
            *(u32x4*)(WT + (size_t)(r0 + n0 + n) * K + k0 + 8 * c) = o; }
        __builtin_amdgcn_wave_barrier(); asm volatile("s_waitcnt lgkmcnt(0)" ::: "memory");
    }
}
__device__ __forceinline__ void ph_zero16(u32x4* p, size_t n16) { for (size_t i = (size_t)blockIdx.x * 512 + opaque_tid(); i < n16; i += (size_t)gridDim.x * 512) p[i] = (u32x4){0u, 0u, 0u, 0u}; }
__device__ __forceinline__ void ph_modulate(const float* __restrict__ x, const float* __restrict__ modl, int sh_off, int sc_off, bf16_t* __restrict__ h) {
    for (size_t e4 = (size_t)blockIdx.x * 512 + opaque_tid(); e4 < (size_t)cf::M * 256; e4 += (size_t)gridDim.x * 512) {
        const int m = (int)(e4 >> 8), c = (int)(e4 & 255) * 4, b = m / cf::SEQ;
        const f32x4 xv = *(const f32x4*)(x + (size_t)m * 1024 + c);
        const f32x4 sh = *(const f32x4*)(modl + b * 6144 + sh_off + c), sc = *(const f32x4*)(modl + b * 6144 + sc_off + c);
        const f32x4 o = xv * (sc + 1.0f) + sh;
        u32x2 w; w.x = pk2(o[0], o[1]); w.y = pk2(o[2], o[3]);
        *(u32x2*)(h + (size_t)m * 1024 + c) = w; }
}
__device__ __forceinline__ void ph_ln(const float* __restrict__ xin, const float* __restrict__ y, int m0, int nrows, const float* __restrict__ modl, int gt_off,
                                      const float* __restrict__ lw, const float* __restrict__ lb, float* __restrict__ xo,
                                      const float* __restrict__ modn, int shn_off, int scn_off, bf16_t* __restrict__ hn) {
    const int tid_ = opaque_tid(); const int lane = tid_ & 63;
    for (int r = blockIdx.x * 8 + (tid_ >> 6); r < nrows; r += gridDim.x * 8) {
        const int m = m0 + r, b = m / cf::SEQ;
        f32x4 v[4]; float s = 0.f;
#pragma unroll
        for (int j = 0; j < 4; ++j) { const int c = 4 * lane + 256 * j;
            const f32x4 xv = *(const f32x4*)(xin + (size_t)m * 1024 + c), yv = *(const f32x4*)(y + (size_t)r * 1024 + c), g = *(const f32x4*)(modl + b * 6144 + gt_off + c);
            v[j] = xv * cf::ALPHA + (g + 1.0f) * yv; s += (v[j][0] + v[j][1]) + (v[j][2] + v[j][3]); }
        const float mean = wave_sum(s) * (1.f / 1024.f); float s2 = 0.f;
#pragma unroll
        for (int j = 0; j < 4; ++j) { v[j] = v[j] - mean; s2 += (v[j][0] * v[j][0] + v[j][1] * v[j][1]) + (v[j][2] * v[j][2] + v[j][3] * v[j][3]); }
        const float rstd = rsqrtf(wave_sum(s2) * (1.f / 1024.f) + cf::LN_EPS);
#pragma unroll
        for (int j = 0; j < 4; ++j) { const int c = 4 * lane + 256 * j;
            const f32x4 o = v[j] * rstd * *(const f32x4*)(lw + c) + *(const f32x4*)(lb + c);
            *(f32x4*)(xo + (size_t)m * 1024 + c) = o;
            if (hn) { const f32x4 sh = *(const f32x4*)(modn + b * 6144 + shn_off + c), sc = *(const f32x4*)(modn + b * 6144 + scn_off + c);
                const f32x4 hv = o * (sc + 1.0f) + sh; u32x2 w; w.x = pk2(hv[0], hv[1]); w.y = pk2(hv[2], hv[3]); *(u32x2*)(hn + (size_t)m * 1024 + c) = w; } }
    }
}
__device__ __forceinline__ void ph_convglu(const bf16_t* __restrict__ U, int nrows, const float* __restrict__ cw, const float* __restrict__ cb, bf16_t* __restrict__ S) {
    for (size_t e = (size_t)blockIdx.x * 512 + opaque_tid(); e < (size_t)nrows * 704; e += (size_t)gridDim.x * 512) {
        const int r = (int)(e / 704), c = (int)(e % 704) * 4, s = r % cf::SEQ;
        f32x4 g = *(const f32x4*)(cb + c), v = *(const f32x4*)(cb + 2816 + c);
#pragma unroll
        for (int j = 0; j < 3; ++j) if (s - j >= 0) {
            const u32x2 ug = *(const u32x2*)(U + (size_t)(r - j) * 5632 + c), uv = *(const u32x2*)(U + (size_t)(r - j) * 5632 + 2816 + c);
            const f32x4 wg = *(const f32x4*)(cw + j * 5632 + c), wv = *(const f32x4*)(cw + j * 5632 + 2816 + c);
            g[0] += wg[0] * bflo(ug.x); g[1] += wg[1] * bfhi(ug.x); g[2] += wg[2] * bflo(ug.y); g[3] += wg[3] * bfhi(ug.y);
            v[0] += wv[0] * bflo(uv.x); v[1] += wv[1] * bfhi(uv.x); v[2] += wv[2] * bflo(uv.y); v[3] += wv[3] * bfhi(uv.y); }
        u32x2 w; w.x = pk2(silu_(g[0]) * v[0], silu_(g[1]) * v[1]); w.y = pk2(silu_(g[2]) * v[2], silu_(g[3]) * v[3]);
        *(u32x2*)(S + (size_t)r * 2816 + c) = w; }
}

struct LruArgs { const bf16_t* XA; bf16_t* GA  ; const float *cw, *cb, *wa, *ba, *wx, *bx, *lam; };
namespace lr {
constexpr int O_RX = 0;
constexpr int O_RG = 8704;
constexpr int O_XC = O_RG + 8192;
constexpr int O_XB = O_XC + 16384;
constexpr int O_A = O_XB + 9216;
constexpr int O_B = O_A + 16384;
constexpr int O_SUM = O_B + 16384;
constexpr int O_HS = O_SUM + 4096;
constexpr int O_END = O_HS + 256;
}
__device__ __forceinline__ void ph_lru_item(unsigned char* lds, const LruArgs& a, int item) {
    using namespace lr;
    bf16_t* RX = (bf16_t*)(lds + O_RX); bf16_t* RG = (bf16_t*)(lds + O_RG); float* XC = LDSF(O_XC); bf16_t* XB = (bf16_t*)(lds + O_XB); float* Aa = LDSF(O_A); float* Bb = LDSF(O_B); float* SUM = LDSF(O_SUM); float* HS = LDSF(O_HS);
    const int b = item >> 4, g = item & 15, tid0 = opaque_tid();
    bf16x8_t fr_[2][2], fi_[2][2];
    float c8v[2], bav[2], bxv[2];
    float cbv, cwv[4];
    { const int tid = tid0, lane = tid & 63, wv = tid >> 6, l15 = lane & 15, q4 = lane >> 4, hh = wv >> 2;
      bf16_t* T = (bf16_t*)(lds + O_A);
      for (int e = tid; e < 64 * 64; e += 512) { const int i = e >> 6, c = e & 63; T[c * 72 + i] = (bf16_t)f2bf(a.wa[(size_t)g * 4096 + e]); T[64 * 72 + c * 72 + i] = (bf16_t)f2bf(a.wx[(size_t)g * 4096 + e]); }
      if (tid < 64) HS[tid] = 0.f;
      __syncthreads();
#pragma unroll
      for (int nn = 0; nn < 2; ++nn) { const int cl = 32 * hh + 16 * nn + l15, gc = g * 64 + cl;
#pragma unroll
          for (int ks = 0; ks < 2; ++ks) { fr_[nn][ks] = *(const bf16x8_t*)(T + cl * 72 + 8 * q4 + 32 * ks); fi_[nn][ks] = *(const bf16x8_t*)(T + 64 * 72 + cl * 72 + 8 * q4 + 32 * ks); }
          const float lamv = a.lam[gc]; c8v[nn] = 8.0f * (fmaxf(-lamv, 0.f) + log1pf(expf(-fabsf(lamv)))); bav[nn] = a.ba[gc]; bxv[nn] = a.bx[gc]; }
      cbv = a.cb[g * 64 + lane];
#pragma unroll
      for (int q = 0; q < 4; ++q) cwv[q] = a.cw[q * 1024 + g * 64 + lane];
      __syncthreads(); }
    u32x4 pre[3];
    auto issue = [&](int s0, int tid) {
#pragma unroll
        for (int q = 0; q < 3; ++q) { const int pc = tid + 512 * q; u32x4 v = (u32x4){0u, 0u, 0u, 0u};
            if (pc < 536) { const int rw = pc >> 3, s = s0 - 3 + rw; if (s >= 0) v = *(const u32x4*)(a.XA + ((size_t)b * cf::SEQ + s) * 1024 + g * 64 + (pc & 7) * 8); }
            else if (pc < 1048) { const int p2 = pc - 536; v = *(const u32x4*)(a.GA + ((size_t)b * cf::SEQ + s0 + (p2 >> 3)) * 1024 + g * 64 + (p2 & 7) * 8); }
            pre[q] = v; }
    };
    auto commit = [&](int tid) {
#pragma unroll
        for (int q = 0; q < 3; ++q) { const int pc = tid + 512 * q;
            if (pc < 536) *(u32x4*)(RX + pc * 8) = pre[q]; else if (pc < 1048) *(u32x4*)(RG + (pc - 536) * 8) = pre[q]; }
    };
    issue(0, tid0); commit(tid0);
    __syncthreads();
#pragma unroll 1
    for (int ch = 0; ch < cf::SEQ / 64; ++ch) {
        const int s0 = ch * 64; const size_t m0 = (size_t)b * cf::SEQ + s0;
        int tid = tid0; asm volatile("" : "+v"(tid));
        const int lane = tid & 63, wv = tid >> 6, l15 = lane & 15, q4 = lane >> 4, mt = wv & 3, hh = wv >> 2;
        if (ch + 1 < cf::SEQ / 64) issue(s0 + 64, tid);
        { float xw[11];
#pragma unroll
          for (int q = 0; q < 11; ++q) xw[q] = bf2f(RX[(8 * wv + q) * 64 + lane]);
#pragma unroll
          for (int q = 0; q < 8; ++q) { const int tt = 8 * wv + q; const float xcv = cbv + cwv[0] * xw[q + 3] + cwv[1] * xw[q + 2] + cwv[2] * xw[q + 1] + cwv[3] * xw[q];
              XC[tt * 64 + lane] = xcv; XB[tt * 72 + lane] = (bf16_t)f2bf(xcv); } }
        __syncthreads();
        { const bf16x8_t xa0 = *(const bf16x8_t*)(XB + (16 * mt + l15) * 72 + 8 * q4), xa1 = *(const bf16x8_t*)(XB + (16 * mt + l15) * 72 + 8 * q4 + 32);
#pragma unroll
          for (int nn = 0; nn < 2; ++nn) { f32x4 cr = (f32x4){0.f, 0.f, 0.f, 0.f}, ci = cr;
              cr = __builtin_amdgcn_mfma_f32_16x16x32_bf16(xa0, fr_[nn][0], cr, 0, 0, 0); cr = __builtin_amdgcn_mfma_f32_16x16x32_bf16(xa1, fr_[nn][1], cr, 0, 0, 0);
              ci = __builtin_amdgcn_mfma_f32_16x16x32_bf16(xa0, fi_[nn][0], ci, 0, 0, 0); ci = __builtin_amdgcn_mfma_f32_16x16x32_bf16(xa1, fi_[nn][1], ci, 0, 0, 0);
              const int cl = 32 * hh + 16 * nn + l15;
#pragma unroll
              for (int j = 0; j < 4; ++j) { const int e = (16 * mt + 4 * q4 + j) * 64 + cl;
                  const float r = sigmoidf_(cr[j] + bav[nn]), ig = sigmoidf_(ci[j] + bxv[nn]), av = __expf(-c8v[nn] * r);
                  Aa[e] = av; Bb[e] = __builtin_amdgcn_sqrtf(fmaxf(1.0f - av * av, 0.f)) * (ig * XC[e]); } } }
        __syncthreads();
        { float hl[8], pp[8]; float h = 0.f, pr = 1.f;
#pragma unroll
          for (int q = 0; q < 8; ++q) { const int e = (8 * wv + q) * 64 + lane; const float av = Aa[e]; h = av * h + Bb[e]; pr *= av; hl[q] = h; pp[q] = pr; }
          SUM[(wv * 2 + 0) * 64 + lane] = pr; SUM[(wv * 2 + 1) * 64 + lane] = h;
          __syncthreads();
          float c = HS[lane];
          for (int w2 = 0; w2 < wv; ++w2) c = SUM[(w2 * 2 + 0) * 64 + lane] * c + SUM[(w2 * 2 + 1) * 64 + lane];
#pragma unroll
          for (int q = 0; q < 8; ++q) { const int tt = 8 * wv + q; const float hv = hl[q] + pp[q] * c;
              a.GA[(m0 + tt) * 1024 + g * 64 + lane] = (bf16_t)f2bf(hv * bf2f(RG[tt * 64 + lane])); }
          __syncthreads();
          if (wv == 7) HS[lane] = pr * c + h; }
        if (ch + 1 < cf::SEQ / 64) commit(tid);
        __syncthreads();
    }
}

__device__ __forceinline__ void ph_attn(const bf16_t* __restrict__ Q, const bf16_t* __restrict__ K, const bf16_t* __restrict__ VT, bf16_t* __restrict__ YB, int w0, int wstride) {
    const int tid_ = opaque_tid(); const int lane = tid_ & 63, l15 = lane & 15, q4 = lane >> 4;
    for (int w = w0; w < 4096; w += wstride) {
        const int r = w & 15, tile = (w >> 4) & 15, hs = (w >> 8) & 3, b = w >> 10, T0 = tile * 256;
        f32x4 O[4];
#pragma unroll
        for (int nt = 0; nt < 4; ++nt) O[nt] = (f32x4){0.f, 0.f, 0.f, 0.f};
        float m_used = -1e30f, l_part = 0.f;
#pragma unroll
        for (int g = 0; g < 3; ++g) {
            const int lg = 2 * g, d = 1 << lg, qs = 16 >> lg, ucls = 4096 >> lg, head = 4 * g + hs;
            const int c = r & (d - 1), u0 = (T0 + r - c) >> lg, uq = u0 + qs * l15;
            const bf16_t* qp = Q + (size_t)(b * 4096 + T0 + r + 16 * l15) * 768 + head * 64 + 8 * q4;
            const bf16x8_t bq0 = *(const bf16x8_t*)qp, bq1 = *(const bf16x8_t*)(qp + 32);
            const int ua = ((u0 - 128) >> 5) << 5, uend = u0 + 15 * qs, np = ((uend - ua) >> 5) + 1;
            const bf16_t* kbase = K + (size_t)b * 4096 * 768 + head * 64 + 8 * q4;
            const bf16_t* vbase = VT + ((size_t)(b * 12 + head) * 64 + l15) * 4096 + c * ucls;
            const int kidxA = 8 * (l15 >> 2) + (l15 & 3);
            for (int p = 0; p < np; ++p) {
                const int ub = ua + 32 * p;
                const int uA = min(max(ub + kidxA, 0), ucls - 1), uB = min(max(ub + kidxA + 4, 0), ucls - 1);
                const bf16_t* ka = kbase + (size_t)(c + d * uA) * 768; const bf16_t* kb = kbase + (size_t)(c + d * uB) * 768;
                const bf16x8_t a0 = *(const bf16x8_t*)ka, a1 = *(const bf16x8_t*)(ka + 32), b0 = *(const bf16x8_t*)kb, b1 = *(const bf16x8_t*)(kb + 32);
                const int uv = min(max(ub + 8 * q4, 0), ucls - 8);
                bf16x8_t vf[4];
#pragma unroll
                for (int nt = 0; nt < 4; ++nt) vf[nt] = *(const bf16x8_t*)(vbase + (size_t)nt * 16 * 4096 + uv);
                f32x4 sA = (f32x4){0.f, 0.f, 0.f, 0.f}, sB = sA;
                sA = __builtin_amdgcn_mfma_f32_16x16x32_bf16(a0, bq0, sA, 0, 0, 0); sA = __builtin_amdgcn_mfma_f32_16x16x32_bf16(a1, bq1, sA, 0, 0, 0);
                sB = __builtin_amdgcn_mfma_f32_16x16x32_bf16(b0, bq0, sB, 0, 0, 0); sB = __builtin_amdgcn_mfma_f32_16x16x32_bf16(b1, bq1, sB, 0, 0, 0);
                float s[8]; bool ok[8]; float pm = -1e30f;
#pragma unroll
                for (int j = 0; j < 8; ++j) { const int u = ub + 8 * q4 + j, dl = uq - u; ok[j] = (u >= 0) && (dl >= 0) && (dl <= 128); s[j] = ok[j] ? (j < 4 ? sA[j] : sB[j - 4]) : -1e30f; pm = fmaxf(pm, s[j]); }
                pm = fmaxf(pm, __shfl_xor(pm, 16)); pm = fmaxf(pm, __shfl_xor(pm, 32));
                if (__any(pm > m_used + 8.0f)) {
                    const float m_new = fmaxf(m_used, pm), alpha = __expf(m_used - m_new);
                    l_part *= alpha;
#pragma unroll
                    for (int j = 0; j < 4; ++j) { const float aB = __shfl(alpha, 4 * q4 + j);
#pragma unroll
                        for (int nt = 0; nt < 4; ++nt) O[nt][j] *= aB; }
                    m_used = m_new;
                }
                float pr[8];
#pragma unroll
                for (int j = 0; j < 8; ++j) { pr[j] = ok[j] ? __expf(s[j] - m_used) : 0.f; l_part += pr[j]; }
                u32x4 pw; pw.x = pg8::cvt_pk_bf16(pr[0], pr[1]); pw.y = pg8::cvt_pk_bf16(pr[2], pr[3]); pw.z = pg8::cvt_pk_bf16(pr[4], pr[5]); pw.w = pg8::cvt_pk_bf16(pr[6], pr[7]);
                const bf16x8_t pa = __builtin_bit_cast(bf16x8_t, pw);
#pragma unroll
                for (int nt = 0; nt < 4; ++nt) O[nt] = __builtin_amdgcn_mfma_f32_16x16x32_bf16(pa, vf[nt], O[nt], 0, 0, 0);
            }
        }
        float l = l_part; l += __shfl_xor(l, 16); l += __shfl_xor(l, 32);
#pragma unroll
        for (int j = 0; j < 4; ++j) { const float inv = rcpf_(__shfl(l, 4 * q4 + j));
            bf16_t* yp = YB + (size_t)(b * 4096 + T0 + r + 16 * (4 * q4 + j)) * 256 + hs * 64 + l15;
#pragma unroll
            for (int nt = 0; nt < 4; ++nt) yp[16 * nt] = (bf16_t)f2bf(O[nt][j] * inv); }
    }
}

struct WkvArgs {
    const bf16_t* ZC; const bf16_t* ZV1; bf16_t* VF; bf16_t* YC;
    const float *mu, *mu_v, *w0, *w2, *a0, *a2, *g2, *v0, *v2, *k_k, *k_a, *r_k, *lnw, *lnb;
    int layer; int pad_;
};
namespace wk {
constexpr int TC = 32, RAWP = 544;
constexpr int O_RAW = 0;
constexpr int O_R = 35904, O_W = O_R + 8192, O_KP = O_W + 8192, O_V = O_KP + 8192, O_KK = O_V + 8192, O_BB = O_KK + 8192, O_G = O_BB + 8192, O_Y = O_G + 8192;
constexpr int O_LW = O_Y + 8192, O_LA = O_LW + 32 * 72 * 2, O_LG = O_LA + 32 * 72 * 2, O_LV = O_LG + 32 * 136 * 2, O_BD = O_LV + 32 * 40 * 2, O_END = O_BD + 4 * 32 * 4;
static_assert(O_END <= 131072, "wkv LDS map");
constexpr int O_PA = O_R;
constexpr int O_PB = O_PA + 9216;
constexpr int O_VT = O_PB + 9216;
static_assert(O_VT + 5120 <= O_V, "wkv LDS map 2");
constexpr int O_PBT = O_KK;
constexpr int O_AF = O_PBT + 9216;
constexpr int O_GAM = O_AF + 4224;
static_assert(O_GAM + 256 <= O_G, "wkv LDS map 3");
constexpr int O_AM = O_LW;
constexpr int O_TT = O_AM + 9216;
constexpr int O_TDT = O_TT + 2560;
constexpr int O_M1T = O_TDT + 1536;
constexpr int O_WS = O_M1T + 768;
static_assert(O_WS + 2048 <= O_BD, "wkv LDS map 4");
}
__device__ __forceinline__ bf16x8_t wk_perm(const bf16_t* p) { u32x4 w; const u32x2 lo = *(const u32x2*)p, hi = *(const u32x2*)(p + 16); w.x = lo.x; w.y = lo.y; w.z = hi.x; w.w = hi.y; return __builtin_bit_cast(bf16x8_t, w); }
__device__ __forceinline__ bf16x8_t wk_pack(const f32x4& x0, const f32x4& x1) { u32x4 w; w.x = pg8::cvt_pk_bf16(x0[0], x0[1]); w.y = pg8::cvt_pk_bf16(x0[2], x0[3]); w.z = pg8::cvt_pk_bf16(x1[0], x1[1]); w.w = pg8::cvt_pk_bf16(x1[2], x1[3]); return __builtin_bit_cast(bf16x8_t, w); }
__device__ __forceinline__ void ph_wkv_item(unsigned char* lds, const WkvArgs& a, int item) {
    using namespace wk;
    bf16_t* RAW = (bf16_t*)(lds + O_RAW);
    float* R = LDSF(O_R); float* Wd = LDSF(O_W); float* Kp = LDSF(O_KP); float* Vv = LDSF(O_V); float* KK = LDSF(O_KK); float* BB = LDSF(O_BB); float* G = LDSF(O_G); float* Y = LDSF(O_Y);
    bf16_t* LW = (bf16_t*)(lds + O_LW); bf16_t* LA = (bf16_t*)(lds + O_LA); bf16_t* LG = (bf16_t*)(lds + O_LG); bf16_t* LV = (bf16_t*)(lds + O_LV); float* BD = LDSF(O_BD);
    const int b = item >> 4, h = item & 15, tid0 = opaque_tid(), tid = tid0, lane = tid & 63, wv = tid >> 6, l15 = lane & 15, q4 = lane >> 4;
    const int layer = a.layer;
    const int hj = h * 64 + lane;
    const float kkv = a.k_k[hj], lnwv = a.lnw[hj], lnbv = a.lnb[hj];
    const float mur = a.mu[hj], muk = a.mu[1024 + hj], muv = a.mu[2048 + hj];
    float muL[5];
#pragma unroll
    for (int e = 0; e < 5; ++e) { const int i = lane + 64 * e; muL[e] = (i < 256) ? a.mu[3072 + i] : ((i < 288 && layer) ? a.mu_v[i - 256] : 0.f); }
    const int mt = wv >> 2, nt = wv & 3, hc = h * 64 + 16 * nt + l15;
    const float w0v = a.w0[hc], a0v = a.a0[hc], kav = a.k_a[hc], rkv = a.r_k[hc], v0v = layer ? a.v0[hc] : 0.f;
    bf16x8_t fw[2], fa[2], fg[4], fv;
    { bf16_t* T = (bf16_t*)(lds + O_R);
      for (int e = tid; e < 64 * 64; e += 512) { const int i = e >> 6, c = e & 63; T[c * 72 + i] = (bf16_t)f2bf(a.w2[(size_t)i * 1024 + h * 64 + c]); T[64 * 72 + c * 72 + i] = (bf16_t)f2bf(a.a2[(size_t)i * 1024 + h * 64 + c]); }
      for (int e = tid; e < 128 * 64; e += 512) { const int i = e >> 6, c = e & 63; T[2 * 64 * 72 + c * 136 + i] = (bf16_t)f2bf(a.g2[(size_t)i * 1024 + h * 64 + c]); }
      if (layer) for (int e = tid; e < 32 * 64; e += 512) { const int i = e >> 6, c = e & 63; T[2 * 64 * 72 + 64 * 136 + c * 40 + i] = (bf16_t)f2bf(a.v2[(size_t)i * 1024 + h * 64 + c]); }
      __syncthreads();
      const int cl = 16 * nt + l15;
#pragma unroll
      for (int ks = 0; ks < 2; ++ks) { fw[ks] = *(const bf16x8_t*)(T + cl * 72 + 8 * q4 + 32 * ks); fa[ks] = *(const bf16x8_t*)(T + 64 * 72 + cl * 72 + 8 * q4 + 32 * ks); }
#pragma unroll
      for (int ks = 0; ks < 4; ++ks) fg[ks] = *(const bf16x8_t*)(T + 2 * 64 * 72 + cl * 136 + 8 * q4 + 32 * ks);
      fv = layer ? *(const bf16x8_t*)(T + 2 * 64 * 72 + 64 * 136 + cl * 40 + 8 * q4) : fw[0];
      __syncthreads(); }
    const int rr = lane >> 3, cg = lane & 7, irow = wv * 8 + rr;
    f32x4 Hs[4];
#pragma unroll
    for (int c = 0; c < 4; ++c) Hs[c] = (f32x4){0.f, 0.f, 0.f, 0.f};
    bf16x8_t hb0 = (bf16x8_t){0, 0, 0, 0, 0, 0, 0, 0}, hb1 = hb0;
    constexpr int NPC = 33 * 68;
    auto dma = [&](int s0, int tid) {
        const int ln = tid & 63, wvu = __builtin_amdgcn_readfirstlane(tid >> 6);
#pragma unroll
        for (int q = 0; q < 5; ++q) { const int pcb = (q * 8 + wvu) * 64, pc = pcb + ln;
            if (pc < NPC) { const int rw = pc / 68, c = pc % 68; int s = s0 - 1 + rw; s = s < 0 ? 0 : s; const size_t m = (size_t)b * cf::SEQ + s;
                const bf16_t* src; bool on = true;
                if (c < 24) src = a.ZC + m * 3328 + (c >> 3) * 1024 + h * 64 + (c & 7) * 8;
                else if (c < 56) src = a.ZC + m * 3328 + 3072 + (c - 24) * 8;
                else if (c < 60) { src = a.ZV1 + m * 32 + (c - 56) * 8; on = layer != 0; }
                else { src = a.VF + m * 1024 + h * 64 + (c - 60) * 8; on = layer != 0; }
                if (on) __builtin_amdgcn_global_load_lds((const unsigned*)src, (LAS unsigned*)((LAS unsigned char*)lds + O_RAW + pcb * 16), 16, 0, 0); } }
    };
#define WK_BAR() do { asm volatile("s_waitcnt lgkmcnt(0)" ::: "memory"); __builtin_amdgcn_s_barrier(); asm volatile("" ::: "memory"); } while (0)
    dma(0, tid0);
    asm volatile("s_waitcnt vmcnt(0)" ::: "memory"); __syncthreads();
    if (tid0 < 68) *(u32x4*)(RAW + tid0 * 8) = (u32x4){0u, 0u, 0u, 0u};
    __syncthreads();
#pragma unroll 1
    for (int ch = 0; ch < cf::SEQ / TC; ++ch) {
        const int s0 = ch * TC; const size_t m0 = (size_t)b * cf::SEQ + s0;
        int tid = tid0; asm volatile("" : "+v"(tid));
        const int lane = tid & 63, wv = tid >> 6, l15 = lane & 15, q4 = lane >> 4, hj = h * 64 + lane, mt = wv >> 2, nt = wv & 3, rr = lane >> 3, cg = lane & 7, irow = wv * 8 + rr;
#pragma unroll
        for (int q = 0; q < 4; ++q) { const int tt = 4 * wv + q; const bf16_t* cur = RAW + (tt + 1) * RAWP; const bf16_t* prv = RAW + tt * RAWP;
            const float r1 = bf2f(cur[lane]), r0 = bf2f(prv[lane]), k1 = bf2f(cur[64 + lane]), k0 = bf2f(prv[64 + lane]), v1 = bf2f(cur[128 + lane]), v0_ = bf2f(prv[128 + lane]);
            const float rs = r1 + (r0 - r1) * mur, ks = k1 + (k0 - k1) * muk, vs = v1 + (v0_ - v1) * muv;
            const float kkr = ks * kkv; const float ss = wave_sum(kkr * kkr);
            R[tt * 64 + lane] = rs; Kp[tt * 64 + lane] = ks; Vv[tt * 64 + lane] = vs; KK[tt * 64 + lane] = kkr * rsqrtf(ss + 1e-12f);
            if (layer == 0) a.VF[(m0 + tt) * 1024 + hj] = (bf16_t)f2bf(vs);
#pragma unroll
            for (int e = 0; e < 5; ++e) { const int i = lane + 64 * e;
                if (i < 288 && (i < 256 || layer)) { const float z1 = bf2f(cur[192 + i]), z0 = bf2f(prv[192 + i]);
                    const float zs = z1 + (z0 - z1) * muL[e];
                    if (i < 64) LW[tt * 72 + i] = (bf16_t)f2bf(tanhf_(zs)); else if (i < 128) LA[tt * 72 + i - 64] = (bf16_t)f2bf(zs); else if (i < 256) LG[tt * 136 + i - 128] = (bf16_t)f2bf(sigmoidf_(zs)); else LV[tt * 40 + i - 256] = (bf16_t)f2bf(zs); } }
        }
        __syncthreads();
        {
            f32x4 cw = (f32x4){0.f, 0.f, 0.f, 0.f}, ca = cw, cgt = cw, cv = cw;
            const int arow = 16 * mt + l15;
#pragma unroll
            for (int ks = 0; ks < 2; ++ks) { const bf16x8_t xw = *(const bf16x8_t*)(LW + arow * 72 + 8 * q4 + 32 * ks), xa = *(const bf16x8_t*)(LA + arow * 72 + 8 * q4 + 32 * ks);
                cw = __builtin_amdgcn_mfma_f32_16x16x32_bf16(xw, fw[ks], cw, 0, 0, 0); ca = __builtin_amdgcn_mfma_f32_16x16x32_bf16(xa, fa[ks], ca, 0, 0, 0); }
#pragma unroll
            for (int ks = 0; ks < 4; ++ks) { const bf16x8_t xg = *(const bf16x8_t*)(LG + arow * 136 + 8 * q4 + 32 * ks); cgt = __builtin_amdgcn_mfma_f32_16x16x32_bf16(xg, fg[ks], cgt, 0, 0, 0); }
            if (layer) { bf16x8_t xv = *(const bf16x8_t*)(LV + arow * 40 + 8 * q4); cv = __builtin_amdgcn_mfma_f32_16x16x32_bf16(xv, fv, cv, 0, 0, 0); }
            const int chn = 16 * nt + l15;
#pragma unroll
            for (int j = 0; j < 4; ++j) { const int tt = 16 * mt + 4 * q4 + j, e = tt * 64 + chn;
                const float decay = -0.60653065971f * sigmoidf_(w0v + cw[j]);
                const float av = sigmoidf_(a0v + ca[j]);
                const float rv = R[e], kr = Kp[e], vr = Vv[e];
                float v = vr;
                if (layer) { const float vf = bf2f(RAW[(tt + 1) * RAWP + 480 + chn]); v = vr + (vf - vr) * sigmoidf_(v0v + cv[j]); }
                const float kp = kr * (1.0f + (av - 1.0f) * kav);
                const float bd = sum_row16(rv * kp * rkv);
                Wd[e] = decay; Kp[e] = kp; Vv[e] = v; BB[e] = KK[e] * av; G[e] = cgt[j];
                if (l15 == 0) BD[nt * 32 + tt] = bd; }
        }
        __syncthreads();
        if (ch + 1 < cf::SEQ / TC) dma(s0 + TC, tid);
        { float rv[4], lwv[4], kpv[4], kkv4[4], bbv[4], vv4[4]; float* WS = LDSF(O_WS);
#pragma unroll
          for (int q = 0; q < 4; ++q) { const int e = (4 * wv + q) * 64 + lane; rv[q] = R[e]; lwv[q] = Wd[e]; kpv[q] = Kp[e]; kkv4[q] = KK[e]; bbv[q] = BB[e]; vv4[q] = Vv[e]; }
          WS[wv * 64 + lane] = (lwv[0] + lwv[1]) + (lwv[2] + lwv[3]);
          WK_BAR();
          float cprev = 0.f;
#pragma unroll
          for (int w2 = 0; w2 < 7; ++w2) { const float x_ = WS[w2 * 64 + lane]; cprev += (w2 < wv) ? x_ : 0.f; }
          bf16_t* PA = (bf16_t*)(lds + O_PA); bf16_t* PB = (bf16_t*)(lds + O_PB); bf16_t* PBT = (bf16_t*)(lds + O_PBT); bf16_t* VTl = (bf16_t*)(lds + O_VT);
          float ep = __expf(cprev), cl = cprev; float bt4[4], kt4[4];
#pragma unroll
          for (int q = 0; q < 4; ++q) { const int t = 4 * wv + q; cl += lwv[q]; const float e = __expf(cl), ei = __expf(-cl);
              PA[t * 72 + lane] = (bf16_t)f2bf(kkv4[q] * ep); PA[(32 + t) * 72 + lane] = (bf16_t)f2bf(rv[q] * e);
              bt4[q] = bbv[q] * ei; kt4[q] = kpv[q] * ei;
              PB[t * 72 + lane] = (bf16_t)f2bf(bt4[q]); PB[(32 + t) * 72 + lane] = (bf16_t)f2bf(kt4[q]);
              ep = e; }
          u32x2 w; w.x = pk2(bt4[0], bt4[1]); w.y = pk2(bt4[2], bt4[3]); *(u32x2*)(PBT + lane * 72 + 4 * wv) = w;
          w.x = pk2(kt4[0], kt4[1]); w.y = pk2(kt4[2], kt4[3]); *(u32x2*)(PBT + lane * 72 + 32 + 4 * wv) = w;
          w.x = pk2(vv4[0], vv4[1]); w.y = pk2(vv4[2], vv4[3]); *(u32x2*)(VTl + lane * 40 + 4 * wv) = w;
          if (wv == 7) LDSF(O_GAM)[lane] = ep; }
        WK_BAR();
        { const bf16_t* PA = (const bf16_t*)(lds + O_PA); const bf16_t* PB = (const bf16_t*)(lds + O_PB); bf16_t* AM = (bf16_t*)(lds + O_AM); float* AF = LDSF(O_AF);
          const int mtile = wv >> 1;
          const bf16x8_t a0 = *(const bf16x8_t*)(PA + (16 * mtile + l15) * 72 + 8 * q4), a1 = *(const bf16x8_t*)(PA + (16 * mtile + l15) * 72 + 8 * q4 + 32);
#pragma unroll
          for (int nn = 0; nn < 2; ++nn) { const int ntile = 2 * (wv & 1) + nn;
              const bf16x8_t b0 = *(const bf16x8_t*)(PB + (16 * ntile + l15) * 72 + 8 * q4), b1 = *(const bf16x8_t*)(PB + (16 * ntile + l15) * 72 + 8 * q4 + 32);
              f32x4 c = (f32x4){0.f, 0.f, 0.f, 0.f};
              c = __builtin_amdgcn_mfma_f32_16x16x32_bf16(a0, b0, c, 0, 0, 0); c = __builtin_amdgcn_mfma_f32_16x16x32_bf16(a1, b1, c, 0, 0, 0);
              const int sg = 16 * ntile + l15, s_ = sg & 31;
#pragma unroll
              for (int j = 0; j < 4; ++j) { const int rho = 16 * mtile + 4 * q4 + j, t_ = rho & 31; const bool keep = (rho < 32) ? (t_ > s_) : (t_ >= s_); const float val = keep ? c[j] : 0.f;
                  AM[rho * 72 + sg] = (bf16_t)f2bf(val); if (rho < 32 && sg < 32) AF[rho * 33 + sg] = val; } } }
        WK_BAR();
        { bf16_t* TT = (bf16_t*)(lds + O_TT); bf16_t* TDT = (bf16_t*)(lds + O_TDT);
          if (wv < 2 && lane < 16) { const float* AF = LDSF(O_AF) + (16 * wv) * 33 + 16 * wv; float x[16];
#pragma unroll
              for (int t = 0; t < 16; ++t) { float acc = (t == lane) ? 1.f : 0.f;
#pragma unroll
                  for (int s = 0; s < 16; ++s) if (s < t) acc -= AF[t * 33 + s] * x[s];
                  x[t] = acc; }
#pragma unroll
              for (int t = 0; t < 16; ++t) TT[(16 * wv + t) * 40 + 16 * wv + lane] = (bf16_t)f2bf(x[t]);
              u32x4 w0_, w1_; w0_.x = pk2(x[0], x[1]); w0_.y = pk2(x[2], x[3]); w0_.z = pk2(x[4], x[5]); w0_.w = pk2(x[6], x[7]); w1_.x = pk2(x[8], x[9]); w1_.y = pk2(x[10], x[11]); w1_.z = pk2(x[12], x[13]); w1_.w = pk2(x[14], x[15]);
              *(u32x4*)(TDT + (wv * 16 + lane) * 24) = w0_; *(u32x4*)(TDT + (wv * 16 + lane) * 24 + 8) = w1_; }
          if (wv == 2 && lane < 32) { const int rw = lane >> 1; *(u32x4*)(TT + rw * 40 + 16 + 8 * (lane & 1)) = (u32x4){0u, 0u, 0u, 0u}; }
        }
        WK_BAR();
        if (wv == 0) { const bf16_t* AM = (const bf16_t*)(lds + O_AM); bf16_t* TT = (bf16_t*)(lds + O_TT); const bf16_t* TDT = (const bf16_t*)(lds + O_TDT); bf16_t* M1T = (bf16_t*)(lds + O_M1T);
            const bf16x8_t zf = (bf16x8_t){0, 0, 0, 0, 0, 0, 0, 0};
            bf16x8_t af = zf, bf = zf;
            if (q4 < 2) { af = *(const bf16x8_t*)(AM + (16 + l15) * 72 + 8 * q4); bf = *(const bf16x8_t*)(TDT + l15 * 24 + 8 * q4); }
            f32x4 c = (f32x4){0.f, 0.f, 0.f, 0.f};
            c = __builtin_amdgcn_mfma_f32_16x16x32_bf16(af, bf, c, 0, 0, 0);
            u32x2 w; w.x = pk2(c[0], c[1]); w.y = pk2(c[2], c[3]); *(u32x2*)(M1T + l15 * 24 + 4 * q4) = w;
            __builtin_amdgcn_wave_barrier(); asm volatile("s_waitcnt lgkmcnt(0)" ::: "memory");
            af = zf; bf = zf;
            if (q4 < 2) { af = *(const bf16x8_t*)(TT + (16 + l15) * 40 + 16 + 8 * q4); bf = *(const bf16x8_t*)(M1T + l15 * 24 + 8 * q4); }
            c = (f32x4){0.f, 0.f, 0.f, 0.f};
            c = __builtin_amdgcn_mfma_f32_16x16x32_bf16(af, bf, c, 0, 0, 0);
#pragma unroll
            for (int j = 0; j < 4; ++j) TT[(16 + 4 * q4 + j) * 40 + l15] = (bf16_t)f2bf(-c[j]); }
        WK_BAR();
        if (wv < 4) { const bf16_t* PA = (const bf16_t*)(lds + O_PA); const bf16_t* AM = (const bf16_t*)(lds + O_AM); const bf16_t* TT = (const bf16_t*)(lds + O_TT); const bf16_t* PBT = (const bf16_t*)(lds + O_PBT);
            const bf16x8_t vfrag = *(const bf16x8_t*)((const bf16_t*)(lds + O_VT) + (16 * wv + l15) * 40 + 8 * q4);
#define WK_NAT(base, stride, row, col0) (*(const bf16x8_t*)((base) + (row) * (stride) + (col0) + 8 * q4))
#define WK_PERM(base, stride, row, col0) wk_perm((base) + (row) * (stride) + (col0) + 4 * q4)
#define WK_PACK(x0, x1) wk_pack((x0), (x1))
            f32x4 x1[2];
#pragma unroll
            for (int m2 = 0; m2 < 2; ++m2) { const int row = 16 * m2 + l15; f32x4 c = (f32x4){0.f, 0.f, 0.f, 0.f};
                c = __builtin_amdgcn_mfma_f32_16x16x32_bf16(WK_NAT(AM, 72, row, 32), vfrag, c, 0, 0, 0);
                c = __builtin_amdgcn_mfma_f32_16x16x32_bf16(WK_PERM(PA, 72, row, 0), hb0, c, 0, 0, 0);
                c = __builtin_amdgcn_mfma_f32_16x16x32_bf16(WK_PERM(PA, 72, row, 32), hb1, c, 0, 0, 0);
                x1[m2] = -c; }
            const bf16x8_t xb = WK_PACK(x1[0], x1[1]);
            f32x4 uu[2];
#pragma unroll
            for (int m2 = 0; m2 < 2; ++m2) { f32x4 c = (f32x4){0.f, 0.f, 0.f, 0.f}; uu[m2] = __builtin_amdgcn_mfma_f32_16x16x32_bf16(WK_PERM(TT, 40, 16 * m2 + l15, 0), xb, c, 0, 0, 0); }
            const bf16x8_t ub = WK_PACK(uu[0], uu[1]);
#pragma unroll
            for (int m2 = 0; m2 < 2; ++m2) { const int row = 32 + 16 * m2 + l15; f32x4 c = (f32x4){0.f, 0.f, 0.f, 0.f};
                c = __builtin_amdgcn_mfma_f32_16x16x32_bf16(WK_NAT(AM, 72, row, 32), vfrag, c, 0, 0, 0);
                c = __builtin_amdgcn_mfma_f32_16x16x32_bf16(WK_PERM(PA, 72, row, 0), hb0, c, 0, 0, 0);
                c = __builtin_amdgcn_mfma_f32_16x16x32_bf16(WK_PERM(PA, 72, row, 32), hb1, c, 0, 0, 0);
                c = __builtin_amdgcn_mfma_f32_16x16x32_bf16(WK_PERM(AM, 72, row, 0), ub, c, 0, 0, 0);
#pragma unroll
                for (int j = 0; j < 4; ++j) Y[(16 * m2 + 4 * q4 + j) * 64 + 16 * wv + l15] = c[j]; }
#pragma unroll
            for (int jm = 0; jm < 4; ++jm) { const int row = 16 * jm + l15;
                Hs[jm] = __builtin_amdgcn_mfma_f32_16x16x32_bf16(WK_NAT(PBT, 72, row, 32), vfrag, Hs[jm], 0, 0, 0);
                Hs[jm] = __builtin_amdgcn_mfma_f32_16x16x32_bf16(WK_PERM(PBT, 72, row, 0), ub, Hs[jm], 0, 0, 0);
                const f32x4 gm = *(const f32x4*)(LDSF(O_GAM) + 16 * jm + 4 * q4); Hs[jm] = Hs[jm] * gm; }
            hb0 = WK_PACK(Hs[0], Hs[1]); hb1 = WK_PACK(Hs[2], Hs[3]);
#undef WK_NAT
#undef WK_PERM
#undef WK_PACK
        }
        WK_BAR();
#pragma unroll
        for (int q = 0; q < 4; ++q) { const int tt = 4 * wv + q;
            const float y = Y[tt * 64 + lane]; const float mu = wave_sum(y) * (1.f / 64.f); const float d = y - mu; const float var = wave_sum(d * d) * (1.f / 64.f);
            const float bd = (BD[tt] + BD[32 + tt]) + (BD[64 + tt] + BD[96 + tt]);
            const float o = (d * rsqrtf(var + cf::GN_EPS) * lnwv + lnbv + bd * Vv[tt * 64 + lane]) * G[tt * 64 + lane];
            a.YC[(m0 + tt) * 1024 + hj] = (bf16_t)f2bf(o); }
        asm volatile("s_waitcnt vmcnt(0)" ::: "memory");
        WK_BAR();
    }
#undef WK_BAR
}
#include <hip/hip_cooperative_groups.h>
namespace cg = cooperative_groups;
namespace wsmap {
using cf::MiB;
constexpr size_t CTL = 0, MOD = 1 * MiB, CS = MiB + MiB / 2, H = 3 * MiB, VF = 35 * MiB, W = 67 * MiB, AR = 84 * MiB;
constexpr size_t XA = AR, GA = AR + 32 * MiB, Q = AR + 64 * MiB, K = AR + 88 * MiB, V = AR + 112 * MiB, ZC = AR + 136 * MiB, ZV1 = AR + 240 * MiB, YB = AR + 241 * MiB;
constexpr size_t GT = Q, MG = AR + 96 * MiB, YO = AR + 128 * MiB;
constexpr size_t U = AR, SS = AR + 88 * MiB, YF = AR + 132 * MiB;
constexpr size_t W_G = W, W_PA = W + 6 * MiB, W_PB = W + 8 * MiB, W_PC = W + 8 * MiB + MiB / 2, W_O = W + 10 * MiB + MiB / 2;
constexpr size_t W_UP = W, W_DN = W + 11 * MiB;
}
constexpr int MEGA_LDS = 147456;
struct MegaArgs { const float* in[40]; float* out; unsigned char* ws; };

template <class Epi> __device__ __forceinline__ void run_gemm(unsigned char* lds, const bf16_t* A, int lda, const bf16_t* Bt, int M, int N, int K, const Epi& E) {
    pg8::Gemm g; g.A = A; g.Bt = Bt; g.M = M; g.N = N; g.K = K; g.lda = lda;
    pg8::StaticOrder S; S.init(M, N, (int)gridDim.x, (int)blockIdx.x);
    pg8::gemm_phase<Epi, pg8::StaticOrder, true, true>((PG8_LAS unsigned char*)lds, g, S, E);
}

__global__ __launch_bounds__(512, 2) void mega(MegaArgs A) {
    using namespace wsmap;
    cg::grid_group grid = cg::this_grid();
    extern __shared__ __attribute__((aligned(16))) unsigned char lds[];
#define KARG(i) (((const float* const volatile __attribute__((address_space(4)))*)__builtin_amdgcn_kernarg_segment_ptr())[i])
#define F(i) ((const float*)KARG(i))
#define P_WS ((unsigned char*)KARG(41))
    { volatile LAS unsigned* misc = (volatile LAS unsigned*)((LAS unsigned char*)lds + 131072 + 320); { const int t_ = opaque_tid(); if (t_ < 32) misc[t_] = 0u; } }
    __syncthreads();
    (void)xcd_barrier_post((unsigned*)(P_WS) + 4096, (volatile LAS unsigned*)((LAS unsigned char*)lds + 131072 + 320) + 8);
#define GSYNC() do { XcdBarrier xb_; xb_.bar = (unsigned*)(P_WS) + 4096; xb_.x = xb_xcc_id(); xb_.st = (volatile LAS unsigned*)((LAS unsigned char*)lds + 131072 + 320) + 8; xcd_barrier(xb_); } while (0)
#define P_X ((float*)KARG(40))
#define P_MOD ((float*)(P_WS + MOD))
#define P_CS ((float*)(P_WS + CS))
#define P_H ((bf16_t*)(P_WS + H))
#define P_VF ((bf16_t*)(P_WS + VF))
#define P_WINT ((bf16_t*)(P_WS + W))
    ph_mod(lds, F(1), F(3), F(4), P_MOD);
    ph_rope((const int*)F(2), P_CS);
    __syncthreads();
    ph_transpose(lds, F(5), 1024, 10752, 0, 7680, P_WINT, 0);
    __syncthreads(); grid.sync();
    ph_modulate(F(0), P_MOD, 0, 1024, P_H);
    GSYNC();
#pragma unroll 1
    for (int l = 0; l < 2; ++l) {
#define P_MODL (P_MOD + (size_t)l * 4 * 6144)
        { pg8::EpiIn E; E.XA = (bf16_t*)(P_WS + XA); E.GA = (bf16_t*)(P_WS + GA); E.Q = (bf16_t*)(P_WS + Q); E.K = (bf16_t*)(P_WS + K); E.V = (bf16_t*)(P_WS + V); E.ZC = (bf16_t*)(P_WS + ZC); E.ZV1 = (bf16_t*)(P_WS + ZV1); E.cs = P_CS;
          run_gemm(lds, P_H, 1024, P_WINT, cf::M, (30 + l) * 256, 1024, E); }
        GSYNC();
        ph_transpose(lds, F(5) + (size_t)l * 1024 * 10752, 1024, 10752, 7680, 3072, (bf16_t*)(P_WS + W_G), 0);
        ph_transpose(lds, F(28) + (size_t)l * 1024 * 1024, 1024, 1024, 0, 1024, (bf16_t*)(P_WS + W_PA), 0);
        ph_transpose(lds, F(29) + (size_t)l * 256 * 1024, 256, 1024, 0, 1024, (bf16_t*)(P_WS + W_PB), 0);
        ph_transpose(lds, F(30) + (size_t)l * 1024 * 1024, 1024, 1024, 0, 1024, (bf16_t*)(P_WS + W_PC), 0);
        ph_transpose(lds, F(31) + (size_t)l * 1024 * 1024, 1024, 1024, 0, 1024, (bf16_t*)(P_WS + W_O), 0);
        __syncthreads();
        if (blockIdx.x < 64) {
            LruArgs a; a.XA = (const bf16_t*)(P_WS + XA); a.GA = (bf16_t*)(P_WS + GA); a.cw = F(7) + l * 4096; a.cb = F(8) + l * 1024; a.wa = F(9) + l * 65536; a.ba = F(10) + l * 1024; a.wx = F(11) + l * 65536; a.bx = F(12) + l * 1024; a.lam = F(13) + l * 1024;
            ph_lru_item(lds, a, (int)blockIdx.x);
        } else ph_attn((const bf16_t*)(P_WS + Q), (const bf16_t*)(P_WS + K), (const bf16_t*)(P_WS + V), (bf16_t*)(P_WS + YB), ((int)blockIdx.x - 64) * 8 + (opaque_tid() >> 6), ((int)gridDim.x - 64) * 8);
        GSYNC();
        if (blockIdx.x < 64) {
            WkvArgs a; a.ZC = (const bf16_t*)(P_WS + ZC); a.ZV1 = (const bf16_t*)(P_WS + ZV1); a.VF = P_VF; a.YC = (bf16_t*)(P_WS + XA);
            a.mu = F(14) + l * 3328; a.mu_v = F(15); a.w0 = F(16) + l * 1024; a.w2 = F(17) + l * 65536; a.a0 = F(18) + l * 1024; a.a2 = F(19) + l * 65536; a.g2 = F(20) + l * 131072; a.v0 = F(21); a.v2 = F(22);
            a.k_k = F(23) + l * 1024; a.k_a = F(24) + l * 1024; a.r_k = F(25) + l * 1024; a.lnw = F(26) + l * 1024; a.lnb = F(27) + l * 1024; a.layer = l; a.pad_ = 0;
            ph_wkv_item(lds, a, (int)blockIdx.x);
        }
        GSYNC();
#pragma unroll 1
        for (int br = 0; br < 3; ++br) {
            { pg8::EpiBf16<1> Eg; Eg.O = (bf16_t*)(P_WS + GT); Eg.ldc = 1024; Eg.pad_ = 0;
              run_gemm(lds, P_H, 1024, (const bf16_t*)(P_WS + W_G) + (size_t)br * 1024 * 1024, cf::M, 1024, 1024, Eg); }
            const bf16_t* Y = (const bf16_t*)(P_WS + (br == 0 ? GA : (br == 1 ? YB : XA))); const bf16_t* P = (const bf16_t*)(P_WS + (br == 0 ? W_PA : (br == 1 ? W_PB : W_PC))); const int Kb = (br == 1) ? 256 : 1024;
            if (br == 0) { pg8::EpiMerge<0> Em; Em.MG = (bf16_t*)(P_WS + MG); Em.GT = (const bf16_t*)(P_WS + GT); Em.ldc = 1024; Em.pad_ = 0; run_gemm(lds, Y, Kb, P, cf::M, 1024, Kb, Em); }
            else { pg8::EpiMerge<1> Em; Em.MG = (bf16_t*)(P_WS + MG); Em.GT = (const bf16_t*)(P_WS + GT); Em.ldc = 1024; Em.pad_ = 0; run_gemm(lds, Y, Kb, P, cf::M, 1024, Kb, Em); }
        }
        GSYNC();
        { pg8::EpiF32 E; E.C = (float*)(P_WS + YO); E.ldc = 1024; E.pad_ = 0; run_gemm(lds, (const bf16_t*)(P_WS + MG), 1024, (const bf16_t*)(P_WS + W_O), cf::M, 1024, 1024, E); }
        GSYNC();
        ph_ln(l == 0 ? F(0) : (const float*)P_X, (const float*)(P_WS + YO), 0, cf::M, P_MODL, 2048, F(32) + l * 1024, F(33) + l * 1024, P_X, P_MODL, 3072, 4096, P_H);
        ph_transpose(lds, F(34) + (size_t)l * 1024 * 5632, 1024, 5632, 0, 5632, (bf16_t*)(P_WS + W_UP), 0);
        ph_transpose(lds, F(37) + (size_t)l * 2816 * 1024, 2816, 1024, 0, 1024, (bf16_t*)(P_WS + W_DN), 0);
        GSYNC();
#pragma unroll 1
        for (int hf = 0; hf < 2; ++hf) {
            const int m0 = hf * 8192;
            { pg8::EpiBf16<0> E; E.O = (bf16_t*)(P_WS + U); E.ldc = 5632; E.pad_ = 0; run_gemm(lds, P_H + (size_t)m0 * 1024, 1024, (const bf16_t*)(P_WS + W_UP), 8192, 5632, 1024, E); }
            GSYNC();
            ph_convglu((const bf16_t*)(P_WS + U), 8192, F(35) + l * 3 * 5632, F(36) + l * 5632, (bf16_t*)(P_WS + SS));
            GSYNC();
            { pg8::EpiF32 E; E.C = (float*)(P_WS + YF); E.ldc = 1024; E.pad_ = 0; run_gemm(lds, (const bf16_t*)(P_WS + SS), 2816, (const bf16_t*)(P_WS + W_DN), 8192, 1024, 2816, E); }
            GSYNC();
            ph_ln((const float*)P_X, (const float*)(P_WS + YF), m0, 8192, P_MODL, 5120, F(38) + l * 1024, F(39) + l * 1024, P_X, P_MOD + 4 * 6144, 0, 1024, l == 0 ? P_H : (bf16_t*)nullptr);
            GSYNC();
        }
        if (l == 0) {
            ph_transpose(lds, F(5) + (size_t)1024 * 10752, 1024, 10752, 0, 7680, P_WINT, 0);
            ph_transpose(lds, F(6), 1024, 32, 0, 32, P_WINT, 7680);
            ph_zero16((u32x4*)(P_WINT + (size_t)7712 * 1024), (size_t)224 * 1024 * 2 / 16);
            GSYNC();
        }
    }
#undef F
#undef GSYNC
#undef P_WS
#undef P_X
#undef P_MOD
#undef P_CS
#undef P_H
#undef P_VF
#undef P_WINT
#undef P_MODL
}

extern "C" void kernel_launch(void* const* d_in, const int* in_sizes, int n_in, void* d_out, int out_size, void* d_ws, size_t ws_size, hipStream_t stream) {
    static int grid = 0;
    if (grid == 0) {
        int dev = 0, cus = 0, per_cu = 0;
        (void)hipGetDevice(&dev); (void)hipDeviceGetAttribute(&cus, hipDeviceAttributeMultiprocessorCount, dev);
        (void)hipFuncSetAttribute((const void*)mega, hipFuncAttributeMaxDynamicSharedMemorySize, MEGA_LDS);
        (void)hipOccupancyMaxActiveBlocksPerMultiprocessor(&per_cu, (const void*)mega, 512, MEGA_LDS);
        if (per_cu < 1) { fprintf(stderr, "kernel_launch: occupancy query says %d workgroups per CU\n", per_cu); per_cu = 1; }
        grid = cus;
        if (grid != 256) fprintf(stderr, "kernel_launch: %d CUs (built for 256)\n", grid);
    }
    (void)hipMemsetAsync((char*)d_ws + wsmap::CTL, 0, cf::MiB, stream);
    MegaArgs a{};
    for (int i = 0; i < 40; ++i) a.in[i] = (const float*)d_in[i];
    a.out = (float*)d_out; a.ws = (unsigned char*)d_ws;
    void* args[] = {&a};
    hipError_t e = hipLaunchCooperativeKernel((const void*)mega, dim3(grid), dim3(512), args, MEGA_LDS, stream);
    if (e != hipSuccess) fprintf(stderr, "cooperative launch failed: %s (grid %d)\n", hipGetErrorString(e), grid);
}
```

```cpp
#include <hip/hip_runtime.h>
#include <cstdio>
#include <cstdint>
namespace pg8 {
#define PG8_LAS __attribute__((address_space(3)))
typedef unsigned short bf16_t;
typedef short bf16x8 __attribute__((ext_vector_type(8)));
typedef float f32x4 __attribute__((ext_vector_type(4)));
typedef unsigned u32x4 __attribute__((ext_vector_type(4)));
typedef unsigned u32x2 __attribute__((ext_vector_type(2)));
constexpr int BM = 256, BK = 64, HALF = 128, HTB = HALF * BK * 2, STAGE_BYTES = 8 * HTB, NXCD = 8, WGM = 8;

__host__ __device__ __forceinline__ int lds_byte(int r, int c) { const int st = (r >> 4) * 2 + (c >> 5), rr = r & 15, cc = c & 31, ob = rr * 64 + cc * 2; return st * 1024 + (ob ^ (((ob >> 9) & 1) << 5)); }
__host__ __device__ __forceinline__ void stage_rc(int b, int& R, int& C) { const int st = b / 1024, sb = b % 1024, swz = sb ^ (((sb >> 9) & 1) << 5); R = (st >> 1) * 16 + swz / 64; C = (st & 1) * 32 + (swz % 64) / 2; }
__host__ __device__ __forceinline__ int perm32(int rho) { const int n = rho >> 4, i = rho & 15; return 8 * (i >> 2) + 4 * n + (i & 3); }

struct Unit { int pm, pn; };
struct Gemm { const bf16_t* A; const bf16_t* Bt; int M, N, K, lda; };

struct StaticOrder {
    int nM, nN, nwg, G, c;
    __host__ __device__ void init(int M, int N, int G_, int c_) { nM = M / BM; nN = N / BM; nwg = nM * nN; G = G_; c = c_; }
    __host__ __device__ bool next(int i, Unit& u) const {
        const long L = (long)i * G + c; if (L >= nwg) return false;
        int wgid = (int)L; { const int q = nwg / NXCD, r = nwg % NXCD, xcd = wgid % NXCD, off = wgid / NXCD; wgid = (xcd < r ? xcd * (q + 1) : r * (q + 1) + (xcd - r) * q) + off; }
        const int nig = WGM * nN, gid = wgid / nig, fm = gid * WGM, gsz = (nM - fm) < WGM ? (nM - fm) : WGM;
        u.pm = fm + ((wgid % nig) % gsz); u.pn = (wgid % nig) / gsz; return true;
    }
    __device__ __forceinline__ void a_ready(const Unit&) const {}
    __device__ __forceinline__ void done(const Unit&) const {}
};

typedef float f32x2_cv __attribute__((ext_vector_type(2)));
typedef __bf16 bf16x2_cv __attribute__((ext_vector_type(2)));
__device__ __forceinline__ unsigned cvt_pk_bf16(float lo, float hi) { const f32x2_cv f = {lo, hi}; const bf16x2_cv r = __builtin_convertvector(f, bf16x2_cv); return __builtin_bit_cast(unsigned, r); }

template <class Epi, class Sched, bool ALIGN_EPI = false, bool SP2 = false>
__device__ __forceinline__ void gemm_phase(PG8_LAS unsigned char* lds, const Gemm g, const Sched& S, const Epi& E) {
    int tid = threadIdx.x; asm volatile("" : "+v"(tid));
    const int wid = __builtin_amdgcn_readfirstlane(tid >> 6), lane = tid & 63, wr = wid >> 2, wc = wid & 3, fr = lane & 15, fq = lane >> 4;
    const int K = g.K, nt = K / BK, lda = g.lda;
    unsigned voffA[2], voffB[2];
#pragma unroll
    for (int i = 0; i < 2; ++i) { int R, C; stage_rc(tid * 16 + i * 8192, R, C); const int Rb = Epi::PERM ? ((R & ~31) + perm32(R & 31)) : R;
        voffA[i] = (unsigned)(R * lda + C) * 2u; voffB[i] = (unsigned)(Rb * K + C) * 2u; }
    const size_t kstep = (size_t)(BK * 2);
    const size_t hstepA = (size_t)HALF * lda * 2, hstepB = (size_t)HALF * K * 2;
    const size_t tstepA = 2 * hstepA, tstepB = 2 * hstepB;
    const unsigned ldsw = (unsigned)wid * 1024u;
    const int aoff = lds_byte(wr * 64 + fr, fq * 8), boff = lds_byte(wc * 32 + fr, fq * 8);
#define PG8_SA(b, h) (((b) * 2 + (h)) * HTB)
#define PG8_SB(b, h) ((4 + (b) * 2 + (h)) * HTB)
#define PG8_STAGE(bufoff, gbase, voff) do { _Pragma("unroll") for (int _i = 0; _i < 2; ++_i) \
        __builtin_amdgcn_global_load_lds((const unsigned*)((const char*)(gbase) + (voff)[_i]), (PG8_LAS unsigned*)(lds + (bufoff) + ldsw + _i * 8192), 16, 0, 0); } while (0)
#define PG8_LDA(dst, b, h) do { _Pragma("unroll") for (int m = 0; m < 4; ++m) _Pragma("unroll") for (int k = 0; k < 2; ++k) dst[m][k] = *(const PG8_LAS bf16x8*)(lds + PG8_SA(b, h) + aoff + m * 2048 + k * 1024); } while (0)
#define PG8_LDB(dst, b, h) do { _Pragma("unroll") for (int n = 0; n < 2; ++n) _Pragma("unroll") for (int k = 0; k < 2; ++k) dst[n][k] = *(const PG8_LAS bf16x8*)(lds + PG8_SB(b, h) + boff + n * 2048 + k * 1024); } while (0)
#define PG8_MMA(ai, bj, At, Bt) do { __builtin_amdgcn_s_setprio(1); _Pragma("unroll") for (int m = 0; m < 4; ++m) _Pragma("unroll") for (int n = 0; n < 2; ++n) _Pragma("unroll") for (int k = 0; k < 2; ++k) \
        acc[ai][bj][m][n] = __builtin_amdgcn_mfma_f32_16x16x32_bf16(Bt[n][k], At[m][k], acc[ai][bj][m][n], 0, 0, 0); __builtin_amdgcn_s_setprio(0); } while (0)
#define PG8_WAIT_V(n) asm volatile("s_waitcnt vmcnt(" #n ")" ::: "memory")
#define PG8_WAIT_L(n) asm volatile("s_waitcnt lgkmcnt(" #n ")" ::: "memory")
#define PG8_BAR __builtin_amdgcn_s_barrier()
#define PG8_SCHED __builtin_amdgcn_sched_barrier(0)
    Unit cur, nxt; int ui = 0;
    if (!S.next(0, cur)) return;
    f32x4 acc[2][2][4][2];
#pragma unroll
    for (int a = 0; a < 2; ++a)
#pragma unroll
        for (int b = 0; b < 2; ++b)
#pragma unroll
            for (int m = 0; m < 4; ++m)
#pragma unroll
                for (int n = 0; n < 2; ++n) acc[a][b][m][n] = (f32x4){0.f, 0.f, 0.f, 0.f};
    bf16x8 At[4][2], B0[2][2], B1[2][2];
    const char* cA = (const char*)g.A + (size_t)cur.pm * tstepA; const char* cB = (const char*)g.Bt + (size_t)cur.pn * tstepB;
    S.a_ready(cur);
    if constexpr (SP2) {
        PG8_STAGE(PG8_SB(0, 0), cB, voffB); PG8_STAGE(PG8_SB(0, 1), cB + hstepB, voffB); PG8_STAGE(PG8_SA(0, 0), cA, voffA); PG8_STAGE(PG8_SA(0, 1), cA + hstepA, voffA);
        if (wr == 1) PG8_BAR;
        PG8_WAIT_V(2); PG8_BAR;
        PG8_STAGE(PG8_SB(1, 0), cB + kstep, voffB); PG8_STAGE(PG8_SA(1, 0), cA + kstep, voffA); PG8_STAGE(PG8_SB(1, 1), cB + hstepB + kstep, voffB);
        PG8_WAIT_V(6); PG8_BAR;
    } else {
        PG8_STAGE(PG8_SB(0, 0), cB, voffB); PG8_STAGE(PG8_SA(0, 0), cA, voffA); PG8_STAGE(PG8_SB(0, 1), cB + hstepB, voffB); PG8_STAGE(PG8_SA(0, 1), cA + hstepA, voffA);
        if (wr == 1) PG8_BAR;
        PG8_WAIT_V(4); PG8_BAR;
        PG8_STAGE(PG8_SB(1, 0), cB + kstep, voffB); PG8_STAGE(PG8_SA(1, 0), cA + kstep, voffA); PG8_STAGE(PG8_SB(1, 1), cB + hstepB + kstep, voffB);
        PG8_WAIT_V(6); PG8_BAR;
    }
    for (;;) {
        const bool has_next = S.next(ui + 1, nxt);
        const char* nA = has_next ? (const char*)g.A + (size_t)nxt.pm * tstepA : cA; const char* nB = has_next ? (const char*)g.Bt + (size_t)nxt.pn * tstepB : cB;
        for (int t = 0; t < nt; t += 2) {
            const bool last = (t == nt - 2);
            const char* a1 = cA + (size_t)(t + 1) * kstep;
            const char* a2 = last ? nA : cA + (size_t)(t + 2) * kstep; const char* b2 = last ? nB : cB + (size_t)(t + 2) * kstep;
            const char* a3 = a2 + kstep; const char* b3 = b2 + kstep;
            if (last && has_next) S.a_ready(nxt);
            if constexpr (SP2) {
            PG8_LDB(B0, 0, 0); PG8_LDB(B1, 0, 1); PG8_SCHED; PG8_LDA(At, 0, 0); PG8_STAGE(PG8_SA(1, 1), a1 + hstepA, voffA);
            PG8_WAIT_V(8); PG8_WAIT_L(0); PG8_BAR; PG8_MMA(0, 0, At, B0); PG8_MMA(0, 1, At, B1); PG8_BAR; PG8_SCHED;
            PG8_LDA(At, 0, 1); PG8_STAGE(PG8_SB(0, 0), b2, voffB); PG8_STAGE(PG8_SB(0, 1), b2 + hstepB, voffB); PG8_STAGE(PG8_SA(0, 0), a2, voffA);
            PG8_WAIT_V(8); PG8_WAIT_L(0); PG8_BAR; PG8_MMA(1, 0, At, B0); PG8_MMA(1, 1, At, B1); PG8_BAR; PG8_SCHED;
            PG8_LDB(B0, 1, 0); PG8_LDB(B1, 1, 1); PG8_SCHED; PG8_LDA(At, 1, 0); PG8_STAGE(PG8_SA(0, 1), a2 + hstepA, voffA);
            PG8_WAIT_V(8); PG8_WAIT_L(0); PG8_BAR; PG8_MMA(0, 0, At, B0); PG8_MMA(0, 1, At, B1); PG8_BAR; PG8_SCHED;
            PG8_LDA(At, 1, 1); PG8_STAGE(PG8_SB(1, 0), b3, voffB); PG8_STAGE(PG8_SB(1, 1), b3 + hstepB, voffB); PG8_STAGE(PG8_SA(1, 0), a3, voffA);
            PG8_WAIT_V(8); PG8_WAIT_L(0); PG8_BAR; PG8_MMA(1, 0, At, B0); PG8_MMA(1, 1, At, B1); PG8_BAR; PG8_SCHED;
            } else {
            PG8_LDB(B0, 0, 0); PG8_SCHED; PG8_LDA(At, 0, 0); PG8_STAGE(PG8_SA(1, 1), a1 + hstepA, voffA);
            PG8_WAIT_L(8); PG8_BAR; PG8_WAIT_L(0); PG8_MMA(0, 0, At, B0); PG8_BAR; PG8_SCHED;
            PG8_LDB(B1, 0, 1); PG8_STAGE(PG8_SB(0, 0), b2, voffB);
            PG8_BAR; PG8_WAIT_L(0); PG8_MMA(0, 1, At, B1); PG8_BAR;
            PG8_LDA(At, 0, 1); PG8_STAGE(PG8_SA(0, 0), a2, voffA);
            PG8_BAR; PG8_WAIT_L(0); PG8_MMA(1, 0, At, B0); PG8_BAR; PG8_SCHED;
            PG8_STAGE(PG8_SB(0, 1), b2 + hstepB, voffB);
            PG8_WAIT_V(6); PG8_BAR; PG8_MMA(1, 1, At, B1); PG8_BAR;
            PG8_LDB(B0, 1, 0); PG8_SCHED; PG8_LDA(At, 1, 0); PG8_STAGE(PG8_SA(0, 1), a2 + hstepA, voffA);
            PG8_WAIT_L(8); PG8_BAR; PG8_WAIT_L(0); PG8_MMA(0, 0, At, B0); PG8_BAR; PG8_SCHED;
            PG8_LDB(B1, 1, 1); PG8_STAGE(PG8_SB(1, 0), b3, voffB);
            PG8_BAR; PG8_WAIT_L(0); PG8_MMA(0, 1, At, B1); PG8_BAR;
            PG8_LDA(At, 1, 1); PG8_STAGE(PG8_SA(1, 0), a3, voffA);
            PG8_BAR; PG8_WAIT_L(0); PG8_MMA(1, 0, At, B0); PG8_BAR; PG8_SCHED;
            PG8_STAGE(PG8_SB(1, 1), b3 + hstepB, voffB);
            PG8_WAIT_V(6); PG8_BAR; PG8_MMA(1, 1, At, B1); PG8_BAR;
            }
        }
        if constexpr (ALIGN_EPI) { if (wr == 0) PG8_BAR; }
        if constexpr (!Epi::AFTER_DRAIN) { E(acc, cur, wr, wc, fr, fq); S.done(cur); }
        if (!has_next) break;
#pragma unroll
        for (int a = 0; a < 2; ++a)
#pragma unroll
            for (int b = 0; b < 2; ++b)
#pragma unroll
                for (int m = 0; m < 4; ++m)
#pragma unroll
                    for (int n = 0; n < 2; ++n) acc[a][b][m][n] = (f32x4){0.f, 0.f, 0.f, 0.f};
        cur = nxt; cA = nA; cB = nB; ++ui;
        if constexpr (ALIGN_EPI) { if (wr == 1) PG8_BAR; }
    }
    PG8_WAIT_V(0);
    if constexpr (!ALIGN_EPI) { if (wr == 0) PG8_BAR; }
    PG8_BAR;
    if constexpr (Epi::AFTER_DRAIN) { E.fused(acc, cur, wr, wc, fr, fq, lds, wid, lane); S.done(cur); }
#undef PG8_SA
#undef PG8_SB
#undef PG8_STAGE
#undef PG8_LDA
#undef PG8_LDB
#undef PG8_MMA
#undef PG8_WAIT_V
#undef PG8_WAIT_L
#undef PG8_BAR
#undef PG8_SCHED
}
}
namespace cf {
constexpr int D = 1024, NB = 4, SEQ = 4096, M = NB * SEQ;
constexpr int DFF = 2816, NSHIFT = 3328;
constexpr float ALPHA = 1.41421356237309515f;
constexpr float LN_EPS = 1e-5f, GN_EPS = 64e-5f;
constexpr size_t MiB = 1u << 20;
}
typedef unsigned short bf16_t;
typedef float f32x4 __attribute__((ext_vector_type(4)));
typedef unsigned u32x4 __attribute__((ext_vector_type(4)));
typedef unsigned u32x2 __attribute__((ext_vector_type(2)));

__device__ __forceinline__ unsigned f2bf(float f) { return pg8::cvt_pk_bf16(f, 0.f) & 0xffffu; }
__device__ __forceinline__ unsigned pk2(float lo, float hi) { return pg8::cvt_pk_bf16(lo, hi); }
__device__ __forceinline__ float bf2f(unsigned short b) { return __builtin_bit_cast(float, ((unsigned)b) << 16); }
__device__ __forceinline__ float bflo(unsigned w) { return __builtin_bit_cast(float, w << 16); }
__device__ __forceinline__ float bfhi(unsigned w) { return __builtin_bit_cast(float, w & 0xffff0000u); }
__device__ __forceinline__ float rcpf_(float x) { return __builtin_amdgcn_rcpf(x); }
__device__ __forceinline__ float sigmoidf_(float x) { return rcpf_(1.0f + __expf(-x)); }
__device__ __forceinline__ float tanhf_(float x) { const float e = __expf(2.0f * x); return 1.0f - 2.0f * rcpf_(e + 1.0f); }
__device__ __forceinline__ float gelu_tanh(float x) { const float u = 0.7978845608028654f * (x + 0.044715f * x * x * x); return 0.5f * x * (1.0f + tanhf_(u)); }
__device__ __forceinline__ float silu_(float x) { return x * rcpf_(1.0f + __expf(-x)); }
template <int CTRL> __device__ __forceinline__ float dpp_mov(float v) { return __builtin_bit_cast(float, __builtin_amdgcn_update_dpp(0, __builtin_bit_cast(int, v), CTRL, 0xf, 0xf, true)); }
__device__ __forceinline__ float sum_quad(float v) { v += dpp_mov<0xB1>(v); v += dpp_mov<0x4E>(v); return v; }
__device__ __forceinline__ float sum_oct(float v) { v = sum_quad(v); v += dpp_mov<0x141>(v); return v; }
__device__ __forceinline__ float sum_row16(float v) { v = sum_oct(v); v += dpp_mov<0x140>(v); return v; }
__device__ __forceinline__ float readlane_f(float v, int l) { return __builtin_bit_cast(float, __builtin_amdgcn_readlane(__builtin_bit_cast(int, v), l)); }
__device__ __forceinline__ float wave_sum(float v) { v = sum_row16(v); return (readlane_f(v, 0) + readlane_f(v, 16)) + (readlane_f(v, 32) + readlane_f(v, 48)); }
__device__ __forceinline__ float wave_max(float v) {
#pragma unroll
    for (int o = 1; o < 64; o <<= 1) v = fmaxf(v, __shfl_xor(v, o));
    return v;
}

namespace pg8 {
struct EpiIn {
    static constexpr bool PERM = true, AFTER_DRAIN = false;
    bf16_t *XA, *GA, *Q, *K, *V, *ZC, *ZV1; const float* cs;
    __device__ __forceinline__ void operator()(const f32x4 (&acc)[2][2][4][2], const Unit& u, int wr, int wc, int fr, int fq) const {
        const int pn = u.pn; bf16_t* dst; int ldc, colt, mode;
        if (pn < 4) { dst = XA; ldc = 1024; colt = pn * 256; mode = 0; }
        else if (pn < 8) { dst = GA; ldc = 1024; colt = (pn - 4) * 256; mode = 1; }
        else if (pn < 11) { dst = Q; ldc = 768; colt = (pn - 8) * 256; mode = 2; }
        else if (pn < 14) { dst = K; ldc = 768; colt = (pn - 11) * 256; mode = 3; }
        else if (pn < 17) { dst = V; ldc = 768; colt = (pn - 14) * 256; mode = 5; }
        else if (pn < 30) { dst = ZC; ldc = 3328; colt = (pn - 17) * 256; mode = 0; }
        else { dst = ZV1; ldc = 32; colt = 0; mode = 4; }
        const int row0 = u.pm * BM + wr * 64 + fr;
        const bool rot = (mode == 2 || mode == 3) && ((wc & 1) == 0);
        const float sgn = (fq == 0) ? -1.0f : 1.0f; const bool rl = fq < 2;
#pragma unroll
        for (int ai = 0; ai < 2; ++ai)
#pragma unroll
            for (int m = 0; m < 4; ++m) {
                const int row = row0 + ai * HALF + m * 16;
                f32x4 c0 = {1.f, 1.f, 1.f, 1.f}, c1 = c0, s0 = {0.f, 0.f, 0.f, 0.f}, s1 = s0;
                if (rot) { const f32x4* p = (const f32x4*)(cs + (size_t)row * 16); c0 = p[0]; c1 = p[1]; s0 = p[2]; s1 = p[3]; }
#pragma unroll
                for (int bj = 0; bj < 2; ++bj) {
                    f32x4 v0 = acc[ai][bj][m][0], v1 = acc[ai][bj][m][1];
                    if (mode == 1) {
#pragma unroll
                        for (int j = 0; j < 4; ++j) { v0[j] = gelu_tanh(v0[j]); v1[j] = gelu_tanh(v1[j]); }
                    }
                    if (rot) {
                        f32x4 p0, p1;
#pragma unroll
                        for (int j = 0; j < 4; ++j) { p0[j] = __shfl_xor(v0[j], 16); p1[j] = __shfl_xor(v1[j], 16); }
                        if (rl) { v0 = v0 * c0 + (p0 * s0) * sgn; v1 = v1 * c1 + (p1 * s1) * sgn; }
                    }
                    if (mode == 2) { v0 = v0 * 0.125f; v1 = v1 * 0.125f; }
                    u32x4 w; w.x = cvt_pk_bf16(v0[0], v0[1]); w.y = cvt_pk_bf16(v0[2], v0[3]); w.z = cvt_pk_bf16(v1[0], v1[1]); w.w = cvt_pk_bf16(v1[2], v1[3]);
                    const int col = colt + bj * HALF + wc * 32 + 8 * fq;
                    if (mode == 5) {
                        const int head = col >> 6, dim0 = col & 63, lg = (head >> 2) * 2, bb = row >> 12, ss = row & 4095;
                        const int perm = ((ss & ((1 << lg) - 1)) << (12 - lg)) + (ss >> lg);
                        bf16_t* vp = dst + ((size_t)(bb * 12 + head) * 64 + dim0) * 4096 + perm;
                        vp[0] = (bf16_t)(w.x & 0xffffu); vp[4096] = (bf16_t)(w.x >> 16); vp[2 * 4096] = (bf16_t)(w.y & 0xffffu); vp[3 * 4096] = (bf16_t)(w.y >> 16);
                        vp[4 * 4096] = (bf16_t)(w.z & 0xffffu); vp[5 * 4096] = (bf16_t)(w.z >> 16); vp[6 * 4096] = (bf16_t)(w.w & 0xffffu); vp[7 * 4096] = (bf16_t)(w.w >> 16);
                    } else if (mode != 4 || (bj == 0 && wc == 0)) *(u32x4*)(dst + (size_t)row * ldc + col) = w;
                }
            }
    }
};
template <int ACT  > struct EpiBf16 {
    static constexpr bool PERM = true, AFTER_DRAIN = false;
    bf16_t* O; int ldc; int pad_;
    __device__ __forceinline__ void operator()(const f32x4 (&acc)[2][2][4][2], const Unit& u, int wr, int wc, int fr, int fq) const {
        const int row0 = u.pm * BM + wr * 64 + fr, col0 = u.pn * BM + wc * 32 + 8 * fq;
#pragma unroll
        for (int ai = 0; ai < 2; ++ai)
#pragma unroll
            for (int m = 0; m < 4; ++m) { bf16_t* rowp = O + (size_t)(row0 + ai * HALF + m * 16) * ldc + col0;
#pragma unroll
                for (int bj = 0; bj < 2; ++bj) { f32x4 v0 = acc[ai][bj][m][0], v1 = acc[ai][bj][m][1];
                    if (ACT == 1) {
#pragma unroll
                        for (int j = 0; j < 4; ++j) { v0[j] = sigmoidf_(v0[j]); v1[j] = sigmoidf_(v1[j]); }
                    }
                    u32x4 w; w.x = cvt_pk_bf16(v0[0], v0[1]); w.y = cvt_pk_bf16(v0[2], v0[3]); w.z = cvt_pk_bf16(v1[0], v1[1]); w.w = cvt_pk_bf16(v1[2], v1[3]);
                    *(u32x4*)(rowp + bj * HALF) = w; } }
    }
};
struct EpiF32 {
    static constexpr bool PERM = false, AFTER_DRAIN = false;
    float* C; int ldc; int pad_;
    __device__ __forceinline__ void operator()(const f32x4 (&acc)[2][2][4][2], const Unit& u, int wr, int wc, int fr, int fq) const {
        const int row0 = u.pm * BM + wr * 64 + fr, col0 = u.pn * BM + wc * 32 + 4 * fq;
#pragma unroll
        for (int ai = 0; ai < 2; ++ai)
#pragma unroll
            for (int m = 0; m < 4; ++m) { float* rowp = C + (size_t)(row0 + ai * HALF + m * 16) * ldc + col0;
#pragma unroll
                for (int bj = 0; bj < 2; ++bj)
#pragma unroll
                    for (int n = 0; n < 2; ++n) *(f32x4*)(rowp + bj * HALF + n * 16) = acc[ai][bj][m][n]; }
    }
};
template <int ADD> struct EpiMerge {
    static constexpr bool PERM = true, AFTER_DRAIN = false;
    bf16_t* MG; const bf16_t* GT; int ldc; int pad_;
    __device__ __forceinline__ void operator()(const f32x4 (&acc)[2][2][4][2], const Unit& u, int wr, int wc, int fr, int fq) const {
        const int row0 = u.pm * BM + wr * 64 + fr, col0 = u.pn * BM + wc * 32 + 8 * fq;
#pragma unroll
        for (int ai = 0; ai < 2; ++ai)
#pragma unroll
            for (int m = 0; m < 4; ++m) { const size_t off = (size_t)(row0 + ai * HALF + m * 16) * ldc + col0;
#pragma unroll
                for (int bj = 0; bj < 2; ++bj) { f32x4 v0 = acc[ai][bj][m][0], v1 = acc[ai][bj][m][1];
                    const u32x4 gw = *(const u32x4*)(GT + off + bj * HALF);
                    v0[0] *= bflo(gw.x); v0[1] *= bfhi(gw.x); v0[2] *= bflo(gw.y); v0[3] *= bfhi(gw.y);
                    v1[0] *= bflo(gw.z); v1[1] *= bfhi(gw.z); v1[2] *= bflo(gw.w); v1[3] *= bfhi(gw.w);
                    if (ADD) { const u32x4 mw = *(const u32x4*)(MG + off + bj * HALF);
                        v0[0] += bflo(mw.x); v0[1] += bfhi(mw.x); v0[2] += bflo(mw.y); v0[3] += bfhi(mw.y);
                        v1[0] += bflo(mw.z); v1[1] += bfhi(mw.z); v1[2] += bflo(mw.w); v1[3] += bfhi(mw.w); }
                    u32x4 w; w.x = cvt_pk_bf16(v0[0], v0[1]); w.y = cvt_pk_bf16(v0[2], v0[3]); w.z = cvt_pk_bf16(v1[0], v1[1]); w.w = cvt_pk_bf16(v1[2], v1[3]);
                    *(u32x4*)(MG + off + bj * HALF) = w; } }
    }
};
}

constexpr int GEMM_LDS = 147456;
template <class Epi> __global__ __launch_bounds__(512, 2) void k_gemm(pg8::Gemm g, Epi E) {
    extern __shared__ __attribute__((aligned(16))) unsigned char shm[];
    pg8::StaticOrder S; S.init(g.M, g.N, (int)gridDim.x, (int)blockIdx.x);
    pg8::gemm_phase<Epi, pg8::StaticOrder, true, true>((PG8_LAS unsigned char*)shm, g, S, E);
}
#define LAS __attribute__((address_space(3)))
#define XB_TMO      128
#define XB_XCNT(j)  (256  + 64 * (j))
#define XB_XSUB(j)  (1280 + 64 * (j))
#define XB_XGEN(j)  (2304 + 64 * (j))
#define XB_TOP      3328
#define XB_TOPGEN   3392
#define XCD_BAR_WORDS 3456
#define XB_SPIN_CAP (1u << 18)
__device__ __forceinline__ unsigned xb_ld(unsigned* p)              { return __hip_atomic_load(p, __ATOMIC_RELAXED, __HIP_MEMORY_SCOPE_AGENT); }
__device__ __forceinline__ unsigned xb_add(unsigned* p, unsigned v) { return __hip_atomic_fetch_add(p, v, __ATOMIC_RELAXED, __HIP_MEMORY_SCOPE_AGENT); }
__device__ __forceinline__ unsigned xb_xcc_id() { return (unsigned)__builtin_amdgcn_s_getreg((3 << 11) | 20) & 0xFu; }
#define XB_SPIN(cond, bar) do { unsigned _sp = 0; while (cond) { __builtin_amdgcn_s_sleep(1); \
    if ((++_sp & 255u) == 0u) { if (xb_ld(&(bar)[XB_TMO])) break; if (_sp > XB_SPIN_CAP) { atomicAdd(&(bar)[XB_TMO], 1u); break; } } } } while (0)
struct XcdBarrier { unsigned* bar; unsigned x; volatile LAS unsigned* st; };
__device__ __forceinline__ XcdBarrier xcd_barrier_post(unsigned* bar, volatile LAS unsigned* st) {
    XcdBarrier b; b.bar = bar; b.x = xb_xcc_id(); b.st = st;
    if (threadIdx.x == 0) (void)xb_add(&bar[XB_XCNT(b.x)], 1u);
    return b;
}
__device__ __forceinline__ void xcd_barrier_complete(unsigned* bar, unsigned x, unsigned& nloc, unsigned& nx) {
    const unsigned G = gridDim.x * gridDim.y * gridDim.z;
    unsigned sum, cnt, mine, sp = 0u;
    for (;;) {
        sum = 0u; cnt = 0u; mine = 0u;
#pragma unroll
        for (unsigned j = 0; j < 16; ++j) { const unsigned c = xb_ld(&bar[XB_XCNT(j)]); sum += c; cnt += (c > 0u) ? 1u : 0u; mine = (j == x) ? c : mine; }
        if (sum == G) break;
        __builtin_amdgcn_s_sleep(1);
        if ((++sp & 255u) == 0u) { if (xb_ld(&bar[XB_TMO])) break; if (sp > XB_SPIN_CAP) { atomicAdd(&bar[XB_TMO], 1u); break; } }
    }
    nloc = mine > 0u ? mine : 1u; nx = cnt > 0u ? cnt : 1u;
}
__device__ __forceinline__ void xcd_barrier(const XcdBarrier& b) {
    asm volatile("s_waitcnt vmcnt(0)" ::: "memory");
    __syncthreads();
    if (threadIdx.x == 0) {
        unsigned* bar = b.bar;
        __builtin_amdgcn_s_waitcnt(0);
        unsigned nloc = b.st[0], nx = b.st[1];
        if (nloc == 0u) { xcd_barrier_complete(bar, b.x, nloc, nx); b.st[0] = nloc; b.st[1] = nx; }
        const unsigned old = xb_add(&bar[XB_XSUB(b.x)], 1u);
        const unsigned gen = old / nloc;
        if (old + 1u == (gen + 1u) * nloc) {
            __builtin_amdgcn_fence(__ATOMIC_RELEASE, "agent");
            asm volatile("s_waitcnt vmcnt(0)" ::: "memory");
            const unsigned og = xb_add(&bar[XB_TOP], 1u);
            const unsigned tg = og / nx;
            if (og + 1u == (tg + 1u) * nx) xb_add(&bar[XB_TOPGEN], 1u);
            else XB_SPIN(xb_ld(&bar[XB_TOPGEN]) == tg, bar);
            __builtin_amdgcn_fence(__ATOMIC_ACQUIRE, "agent");
            xb_add(&bar[XB_XGEN(b.x)], 1u);
            asm volatile("s_waitcnt vmcnt(0)" ::: "memory");
        } else {
            XB_SPIN(xb_ld(&bar[XB_XGEN(b.x)]) == gen, bar);
            __builtin_amdgcn_fence(__ATOMIC_ACQUIRE, "agent");
            asm volatile("s_waitcnt vmcnt(0)" ::: "memory");
        }
    }
    __syncthreads();
}
#define LDSF(off) ((float*)(lds + (off)))
typedef short bf16x8_t __attribute__((ext_vector_type(8)));
__device__ __forceinline__ int opaque_tid() { int t = threadIdx.x; asm volatile("" : "+v"(t)); return t; }
__device__ __forceinline__ void ph_mod(unsigned char* lds, const float* __restrict__ c, const float* __restrict__ mod_w, const float* __restrict__ mod_b, float* __restrict__ mod) {
    float* sc = LDSF(0); float* red = LDSF(16384);
    const int tid = opaque_tid(), col = tid & 63, ks = tid >> 6;
    for (int i = tid; i < 4096; i += 512) sc[i] = silu_(c[i]);
    __syncthreads();
    for (int it = blockIdx.x; it < 192; it += gridDim.x) {
        const int l = it / 96, n = (it % 96) * 64 + col;
        const float* W = mod_w + (size_t)l * 1024 * 6144 + n;
        float a0 = 0.f, a1 = 0.f, a2 = 0.f, a3 = 0.f;
        for (int k = ks * 128; k < ks * 128 + 128; ++k) { const float w = W[(size_t)k * 6144]; a0 += sc[k] * w; a1 += sc[1024 + k] * w; a2 += sc[2048 + k] * w; a3 += sc[3072 + k] * w; }
        red[(ks * 4 + 0) * 64 + col] = a0; red[(ks * 4 + 1) * 64 + col] = a1; red[(ks * 4 + 2) * 64 + col] = a2; red[(ks * 4 + 3) * 64 + col] = a3;
        __syncthreads();
        if (tid < 256) { const int b = tid >> 6; float s = mod_b[l * 6144 + n];
#pragma unroll
            for (int q = 0; q < 8; ++q) s += red[(q * 4 + b) * 64 + col];
            mod[((size_t)l * 4 + b) * 6144 + n] = s; }
        __syncthreads();
    }
}
__device__ __forceinline__ void ph_rope(const int* __restrict__ pos, float* __restrict__ cs) {
    for (int e = blockIdx.x * 512 + opaque_tid(); e < cf::M * 8; e += gridDim.x * 512) {
        const int m = e >> 3, i = e & 7;
        const float inv = powf(500000.0f, -(float)i / 8.0f);
        const float ang = (float)pos[m] * inv;
        cs[m * 16 + i] = cosf(ang); cs[m * 16 + 8 + i] = sinf(ang); }
}
__device__ __forceinline__ void ph_transpose(unsigned char* lds, const float* __restrict__ W, int K, int Nsrc, int c0, int nc, bf16_t* __restrict__ WT, int r0) {
    const int tid_ = opaque_tid(); const int lane = tid_ & 63, wave = tid_ >> 6;
    float* scr = LDSF(wave * 64 * 33 * 4);
    const int nblk = nc / 32, nitems = (K / 64) * nblk;
    for (int item = blockIdx.x * 8 + wave; item < nitems; item += gridDim.x * 8) {
        const int kb = item / nblk, nb = item % nblk, k0 = 64 * kb, n0 = 32 * nb;
#pragma unroll 8
        for (int i = 0; i < 32; ++i) { const int kk = 2 * i + (lane >> 5); scr[kk * 33 + (lane & 31)] = W[(size_t)(k0 + kk) * Nsrc + c0 + n0 + (lane & 31)]; }
        __builtin_amdgcn_wave_barrier(); asm volatile("s_waitcnt lgkmcnt(0)" ::: "memory");
        const int c = lane & 7;
#pragma unroll
        for (int j = 0; j < 4; ++j) { const int n = (lane >> 3) + 8 * j; const float* s = scr + (8 * c) * 33 + n;
            u32x4 o; o.x = pk2(s[0 * 33], s[1 * 33]); o.y = pk2(s[2 * 33], s[3 * 33]); o.z = pk2(s[4 * 33], s[5 * 33]); o.w = pk2(s[6 * 33], s[7 * 33]);
            *(u32x4*)(WT + (size_t)(r0 + n0 + n) * K + k0 + 8 * c) = o; }
        __builtin_amdgcn_wave_barrier(); asm volatile("s_waitcnt lgkmcnt(0)" ::: "memory");
    }
}
__device__ __forceinline__ void ph_zero16(u32x4* p, size_t n16) { for (size_t i = (size_t)blockIdx.x * 512 + opaque_tid(); i < n16; i += (size_t)gridDim.x * 512) p[i] = (u32x4){0u, 0u, 0u, 0u}; }
__device__ __forceinline__ void ph_modulate(const float* __restrict__ x, const float* __restrict__ modl, int sh_off, int sc_off, bf16_t* __restrict__ h) {
    for (size_t e4 = (size_t)blockIdx.x * 512 + opaque_tid(); e4 < (size_t)cf::M * 256; e4 += (size_t)gridDim.x * 512) {
        const int m = (int)(e4 >> 8), c = (int)(e4 & 255) * 4, b = m / cf::SEQ;
        const f32x4 xv = *(const f32x4*)(x + (size_t)m * 1024 + c);
        const f32x4 sh = *(const f32x4*)(modl + b * 6144 + sh_off + c), sc = *(const f32x4*)(modl + b * 6144 + sc_off + c);
        const f32x4 o = xv * (sc + 1.0f) + sh;
        u32x2 w; w.x = pk2(o[0], o[1]); w.y = pk2(o[2], o[3]);
        *(u32x2*)(h + (size_t)m * 1024 + c) = w; }
}
__device__ __forceinline__ void ph_ln(const float* __restrict__ xin, const float* __restrict__ y, int m0, int nrows, const float* __restrict__ modl, int gt_off,
                                      const float* __restrict__ lw, const float* __restrict__ lb, float* __restrict__ xo,
                                      const float* __restrict__ modn, int shn_off, int scn_off, bf16_t* __restrict__ hn) {
    const int tid_ = opaque_tid(); const int lane = tid_ & 63;
    for (int r = (blockIdx.x * 8 + (tid_ >> 6)) * 2; r < nrows; r += gridDim.x * 16) {
        f32x4 v[2][4]; float s[2] = {0.f, 0.f};
#pragma unroll
        for (int u = 0; u < 2; ++u) { const int m = m0 + r + u, b = m / cf::SEQ;
#pragma unroll
            for (int j = 0; j < 4; ++j) { const int c = 4 * lane + 256 * j;
                const f32x4 xv = *(const f32x4*)(xin + (size_t)m * 1024 + c), yv = *(const f32x4*)(y + (size_t)(r + u) * 1024 + c), g = *(const f32x4*)(modl + b * 6144 + gt_off + c);
                v[u][j] = xv * cf::ALPHA + (g + 1.0f) * yv; s[u] += (v[u][j][0] + v[u][j][1]) + (v[u][j][2] + v[u][j][3]); } }
#pragma unroll
        for (int u = 0; u < 2; ++u) { const int m = m0 + r + u, b = m / cf::SEQ;
            const float mean = wave_sum(s[u]) * (1.f / 1024.f); float s2 = 0.f;
#pragma unroll
            for (int j = 0; j < 4; ++j) { v[u][j] = v[u][j] - mean; s2 += (v[u][j][0] * v[u][j][0] + v[u][j][1] * v[u][j][1]) + (v[u][j][2] * v[u][j][2] + v[u][j][3] * v[u][j][3]); }
            const float rstd = rsqrtf(wave_sum(s2) * (1.f / 1024.f) + cf::LN_EPS);
#pragma unroll
            for (int j = 0; j < 4; ++j) { const int c = 4 * lane + 256 * j;
                const f32x4 o = v[u][j] * rstd * *(const f32x4*)(lw + c) + *(const f32x4*)(lb + c);
                *(f32x4*)(xo + (size_t)m * 1024 + c) = o;
                if (hn) { const f32x4 sh = *(const f32x4*)(modn + b * 6144 + shn_off + c), sc = *(const f32x4*)(modn + b * 6144 + scn_off + c);
                    const f32x4 hv = o * (sc + 1.0f) + sh; u32x2 w; w.x = pk2(hv[0], hv[1]); w.y = pk2(hv[2], hv[3]); *(u32x2*)(hn + (size_t)m * 1024 + c) = w; } } }
    }
}
__device__ __forceinline__ void ph_convglu(const bf16_t* __restrict__ U, int nrows, const float* __restrict__ cw, const float* __restrict__ cb, bf16_t* __restrict__ S) {
    const int nitems = (nrows / 16) * 704;
    for (int item = blockIdx.x * 512 + opaque_tid(); item < nitems; item += gridDim.x * 512) {
        const int rb = item / 704, c = (item - rb * 704) * 4, r0 = rb * 16; const bool seq0 = (r0 % cf::SEQ) == 0;
        u32x2 ug[18], uv[18];
#pragma unroll
        for (int j = 0; j < 18; ++j) { const int r = r0 - 2 + j;
            if (j >= 2 || !seq0) { ug[j] = *(const u32x2*)(U + (size_t)r * 5632 + c); uv[j] = *(const u32x2*)(U + (size_t)r * 5632 + 2816 + c); }
            else { ug[j] = (u32x2){0u, 0u}; uv[j] = ug[j]; } }
        f32x4 wg[3], wv[3];
#pragma unroll
        for (int j = 0; j < 3; ++j) { wg[j] = *(const f32x4*)(cw + j * 5632 + c); wv[j] = *(const f32x4*)(cw + j * 5632 + 2816 + c); }
        const f32x4 bg = *(const f32x4*)(cb + c), bv = *(const f32x4*)(cb + 2816 + c);
#pragma unroll
        for (int j = 0; j < 16; ++j) { f32x4 g = bg, v = bv;
#pragma unroll
            for (int q = 0; q < 3; ++q) { const u32x2 a = ug[j + 2 - q], d = uv[j + 2 - q];
                g[0] += wg[q][0] * bflo(a.x); g[1] += wg[q][1] * bfhi(a.x); g[2] += wg[q][2] * bflo(a.y); g[3] += wg[q][3] * bfhi(a.y);
                v[0] += wv[q][0] * bflo(d.x); v[1] += wv[q][1] * bfhi(d.x); v[2] += wv[q][2] * bflo(d.y); v[3] += wv[q][3] * bfhi(d.y); }
            u32x2 w; w.x = pk2(silu_(g[0]) * v[0], silu_(g[1]) * v[1]); w.y = pk2(silu_(g[2]) * v[2], silu_(g[3]) * v[3]);
            *(u32x2*)(S + (size_t)(r0 + j) * 2816 + c) = w; }
    }
}

struct LruArgs { const bf16_t* XA; bf16_t* GA  ; const float *cw, *cb, *wa, *ba, *wx, *bx, *lam; };
namespace lr {
constexpr int O_RX = 0;
constexpr int O_RG = 8704;
constexpr int O_XC = O_RG + 8192;
constexpr int O_XB = O_XC + 16384;
constexpr int O_A = O_XB + 9216;
constexpr int O_B = O_A + 16384;
constexpr int O_SUM = O_B + 16384;
constexpr int O_HS = O_SUM + 4096;
constexpr int O_END = O_HS + 256;
}
__device__ __forceinline__ void ph_lru_item(unsigned char* lds, const LruArgs& a, int item) {
    using namespace lr;
    bf16_t* RX = (bf16_t*)(lds + O_RX); bf16_t* RG = (bf16_t*)(lds + O_RG); float* XC = LDSF(O_XC); bf16_t* XB = (bf16_t*)(lds + O_XB); float* Aa = LDSF(O_A); float* Bb = LDSF(O_B); float* SUM = LDSF(O_SUM); float* HS = LDSF(O_HS);
    const int b = item >> 4, g = item & 15, tid0 = opaque_tid();
    bf16x8_t fr_[2][2], fi_[2][2];
    float c8v[2], bav[2], bxv[2];
    float cbv, cwv[4];
    { const int tid = tid0, lane = tid & 63, wv = tid >> 6, l15 = lane & 15, q4 = lane >> 4, hh = wv >> 2;
      bf16_t* T = (bf16_t*)(lds + O_A);
      for (int e = tid; e < 64 * 64; e += 512) { const int i = e >> 6, c = e & 63; T[c * 72 + i] = (bf16_t)f2bf(a.wa[(size_t)g * 4096 + e]); T[64 * 72 + c * 72 + i] = (bf16_t)f2bf(a.wx[(size_t)g * 4096 + e]); }
      if (tid < 64) HS[tid] = 0.f;
      __syncthreads();
#pragma unroll
      for (int nn = 0; nn < 2; ++nn) { const int cl = 32 * hh + 16 * nn + l15, gc = g * 64 + cl;
#pragma unroll
          for (int ks = 0; ks < 2; ++ks) { fr_[nn][ks] = *(const bf16x8_t*)(T + cl * 72 + 8 * q4 + 32 * ks); fi_[nn][ks] = *(const bf16x8_t*)(T + 64 * 72 + cl * 72 + 8 * q4 + 32 * ks); }
          const float lamv = a.lam[gc]; c8v[nn] = 8.0f * (fmaxf(-lamv, 0.f) + log1pf(expf(-fabsf(lamv)))); bav[nn] = a.ba[gc]; bxv[nn] = a.bx[gc]; }
      cbv = a.cb[g * 64 + lane];
#pragma unroll
      for (int q = 0; q < 4; ++q) cwv[q] = a.cw[q * 1024 + g * 64 + lane];
      __syncthreads(); }
    u32x4 pre[3];
    auto issue = [&](int s0, int tid) {
#pragma unroll
        for (int q = 0; q < 3; ++q) { const int pc = tid + 512 * q; u32x4 v = (u32x4){0u, 0u, 0u, 0u};
            if (pc < 536) { const int rw = pc >> 3, s = s0 - 3 + rw; if (s >= 0) v = *(const u32x4*)(a.XA + ((size_t)b * cf::SEQ + s) * 1024 + g * 64 + (pc & 7) * 8); }
            else if (pc < 1048) { const int p2 = pc - 536; v = *(const u32x4*)(a.GA + ((size_t)b * cf::SEQ + s0 + (p2 >> 3)) * 1024 + g * 64 + (p2 & 7) * 8); }
            pre[q] = v; }
    };
    auto commit = [&](int tid) {
#pragma unroll
        for (int q = 0; q < 3; ++q) { const int pc = tid + 512 * q;
            if (pc < 536) *(u32x4*)(RX + pc * 8) = pre[q]; else if (pc < 1048) *(u32x4*)(RG + (pc - 536) * 8) = pre[q]; }
    };
    issue(0, tid0); commit(tid0);
    __syncthreads();
#pragma unroll 1
    for (int ch = 0; ch < cf::SEQ / 64; ++ch) {
        const int s0 = ch * 64; const size_t m0 = (size_t)b * cf::SEQ + s0;
        int tid = tid0; asm volatile("" : "+v"(tid));
        const int lane = tid & 63, wv = tid >> 6, l15 = lane & 15, q4 = lane >> 4, mt = wv & 3, hh = wv >> 2;
        if (ch + 1 < cf::SEQ / 64) issue(s0 + 64, tid);
        { float xw[11];
#pragma unroll
          for (int q = 0; q < 11; ++q) xw[q] = bf2f(RX[(8 * wv + q) * 64 + lane]);
#pragma unroll
          for (int q = 0; q < 8; ++q) { const int tt = 8 * wv + q; const float xcv = cbv + cwv[0] * xw[q + 3] + cwv[1] * xw[q + 2] + cwv[2] * xw[q + 1] + cwv[3] * xw[q];
              XC[tt * 64 + lane] = xcv; XB[tt * 72 + lane] = (bf16_t)f2bf(xcv); } }
        __syncthreads();
        { const bf16x8_t xa0 = *(const bf16x8_t*)(XB + (16 * mt + l15) * 72 + 8 * q4), xa1 = *(const bf16x8_t*)(XB + (16 * mt + l15) * 72 + 8 * q4 + 32);
#pragma unroll
          for (int nn = 0; nn < 2; ++nn) { f32x4 cr = (f32x4){0.f, 0.f, 0.f, 0.f}, ci = cr;
              cr = __builtin_amdgcn_mfma_f32_16x16x32_bf16(xa0, fr_[nn][0], cr, 0, 0, 0); cr = __builtin_amdgcn_mfma_f32_16x16x32_bf16(xa1, fr_[nn][1], cr, 0, 0, 0);
              ci = __builtin_amdgcn_mfma_f32_16x16x32_bf16(xa0, fi_[nn][0], ci, 0, 0, 0); ci = __builtin_amdgcn_mfma_f32_16x16x32_bf16(xa1, fi_[nn][1], ci, 0, 0, 0);
              const int cl = 32 * hh + 16 * nn + l15;
#pragma unroll
              for (int j = 0; j < 4; ++j) { const int e = (16 * mt + 4 * q4 + j) * 64 + cl;
                  const float r = sigmoidf_(cr[j] + bav[nn]), ig = sigmoidf_(ci[j] + bxv[nn]), av = __expf(-c8v[nn] * r);
                  Aa[e] = av; Bb[e] = __builtin_amdgcn_sqrtf(fmaxf(1.0f - av * av, 0.f)) * (ig * XC[e]); } } }
        __syncthreads();
        { float hl[8], pp[8]; float h = 0.f, pr = 1.f;
#pragma unroll
          for (int q = 0; q < 8; ++q) { const int e = (8 * wv + q) * 64 + lane; const float av = Aa[e]; h = av * h + Bb[e]; pr *= av; hl[q] = h; pp[q] = pr; }
          SUM[(wv * 2 + 0) * 64 + lane] = pr; SUM[(wv * 2 + 1) * 64 + lane] = h;
          __syncthreads();
          float c = HS[lane];
          for (int w2 = 0; w2 < wv; ++w2) c = SUM[(w2 * 2 + 0) * 64 + lane] * c + SUM[(w2 * 2 + 1) * 64 + lane];
#pragma unroll
          for (int q = 0; q < 8; ++q) { const int tt = 8 * wv + q; const float hv = hl[q] + pp[q] * c;
              a.GA[(m0 + tt) * 1024 + g * 64 + lane] = (bf16_t)f2bf(hv * bf2f(RG[tt * 64 + lane])); }
          __syncthreads();
          if (wv == 7) HS[lane] = pr * c + h; }
        if (ch + 1 < cf::SEQ / 64) commit(tid);
        __syncthreads();
    }
}

__device__ __forceinline__ void ph_attn(const bf16_t* __restrict__ Q, const bf16_t* __restrict__ K, const bf16_t* __restrict__ VT, bf16_t* __restrict__ YB, int w0, int wstride) {
    const int tid_ = opaque_tid(); const int lane = tid_ & 63, l15 = lane & 15, q4 = lane >> 4;
    for (int w = w0; w < 4096; w += wstride) {
        const int r = w & 15, tile = (w >> 4) & 15, hs = (w >> 8) & 3, b = w >> 10, T0 = tile * 256;
        f32x4 O[4];
#pragma unroll
        for (int nt = 0; nt < 4; ++nt) O[nt] = (f32x4){0.f, 0.f, 0.f, 0.f};
        float m_used = -1e30f, l_part = 0.f;
#pragma unroll
        for (int g = 0; g < 3; ++g) {
            const int lg = 2 * g, d = 1 << lg, qs = 16 >> lg, ucls = 4096 >> lg, head = 4 * g + hs;
            const int c = r & (d - 1), u0 = (T0 + r - c) >> lg, uq = u0 + qs * l15;
            const bf16_t* qp = Q + (size_t)(b * 4096 + T0 + r + 16 * l15) * 768 + head * 64 + 8 * q4;
            const bf16x8_t bq0 = *(const bf16x8_t*)qp, bq1 = *(const bf16x8_t*)(qp + 32);
            const int ua = ((u0 - 128) >> 5) << 5, uend = u0 + 15 * qs, np = ((uend - ua) >> 5) + 1;
            const bf16_t* kbase = K + (size_t)b * 4096 * 768 + head * 64 + 8 * q4;
            const bf16_t* vbase = VT + ((size_t)(b * 12 + head) * 64 + l15) * 4096 + c * ucls;
            const int kidxA = 8 * (l15 >> 2) + (l15 & 3);
            for (int p = 0; p < np; ++p) {
                const int ub = ua + 32 * p;
                const int uA = min(max(ub + kidxA, 0), ucls - 1), uB = min(max(ub + kidxA + 4, 0), ucls - 1);
                const bf16_t* ka = kbase + (size_t)(c + d * uA) * 768; const bf16_t* kb = kbase + (size_t)(c + d * uB) * 768;
                const bf16x8_t a0 = *(const bf16x8_t*)ka, a1 = *(const bf16x8_t*)(ka + 32), b0 = *(const bf16x8_t*)kb, b1 = *(const bf16x8_t*)(kb + 32);
                const int uv = min(max(ub + 8 * q4, 0), ucls - 8);
                bf16x8_t vf[4];
#pragma unroll
                for (int nt = 0; nt < 4; ++nt) vf[nt] = *(const bf16x8_t*)(vbase + (size_t)nt * 16 * 4096 + uv);
                f32x4 sA = (f32x4){0.f, 0.f, 0.f, 0.f}, sB = sA;
                sA = __builtin_amdgcn_mfma_f32_16x16x32_bf16(a0, bq0, sA, 0, 0, 0); sA = __builtin_amdgcn_mfma_f32_16x16x32_bf16(a1, bq1, sA, 0, 0, 0);
                sB = __builtin_amdgcn_mfma_f32_16x16x32_bf16(b0, bq0, sB, 0, 0, 0); sB = __builtin_amdgcn_mfma_f32_16x16x32_bf16(b1, bq1, sB, 0, 0, 0);
                float s[8]; bool ok[8]; float pm = -1e30f;
#pragma unroll
                for (int j = 0; j < 8; ++j) { const int u = ub + 8 * q4 + j, dl = uq - u; ok[j] = (u >= 0) && (dl >= 0) && (dl <= 128); s[j] = ok[j] ? (j < 4 ? sA[j] : sB[j - 4]) : -1e30f; pm = fmaxf(pm, s[j]); }
                pm = fmaxf(pm, __shfl_xor(pm, 16)); pm = fmaxf(pm, __shfl_xor(pm, 32));
                if (__any(pm > m_used + 8.0f)) {
                    const float m_new = fmaxf(m_used, pm), alpha = __expf(m_used - m_new);
                    l_part *= alpha;
#pragma unroll
                    for (int j = 0; j < 4; ++j) { const float aB = __shfl(alpha, 4 * q4 + j);
#pragma unroll
                        for (int nt = 0; nt < 4; ++nt) O[nt][j] *= aB; }
                    m_used = m_new;
                }
                float pr[8];
#pragma unroll
                for (int j = 0; j < 8; ++j) { pr[j] = ok[j] ? __expf(s[j] - m_used) : 0.f; l_part += pr[j]; }
                u32x4 pw; pw.x = pg8::cvt_pk_bf16(pr[0], pr[1]); pw.y = pg8::cvt_pk_bf16(pr[2], pr[3]); pw.z = pg8::cvt_pk_bf16(pr[4], pr[5]); pw.w = pg8::cvt_pk_bf16(pr[6], pr[7]);
                const bf16x8_t pa = __builtin_bit_cast(bf16x8_t, pw);
#pragma unroll
                for (int nt = 0; nt < 4; ++nt) O[nt] = __builtin_amdgcn_mfma_f32_16x16x32_bf16(pa, vf[nt], O[nt], 0, 0, 0);
            }
        }
        float l = l_part; l += __shfl_xor(l, 16); l += __shfl_xor(l, 32);
#pragma unroll
        for (int j = 0; j < 4; ++j) { const float inv = rcpf_(__shfl(l, 4 * q4 + j));
            bf16_t* yp = YB + (size_t)(b * 4096 + T0 + r + 16 * (4 * q4 + j)) * 256 + hs * 64 + l15;
#pragma unroll
            for (int nt = 0; nt < 4; ++nt) yp[16 * nt] = (bf16_t)f2bf(O[nt][j] * inv); }
    }
}

struct WkvArgs {
    const bf16_t* ZC; const bf16_t* ZV1; bf16_t* VF; bf16_t* YC;
    const float *mu, *mu_v, *w0, *w2, *a0, *a2, *g2, *v0, *v2, *k_k, *k_a, *r_k, *lnw, *lnb;
    int layer; int ldy;
};
namespace wk {
constexpr int TC = 32;
constexpr int O_IR = 0, O_IK = 4224, O_IV = 8448, O_IL = 12672, O_IZ = O_IL + 16896, O_IF = O_IZ + 2112;
constexpr int O_R = 35904, O_W = O_R + 8192, O_KP = O_W + 8192, O_V = O_KP + 8192, O_KK = O_V + 8192, O_BB = O_KK + 8192, O_G = O_BB + 8192, O_Y = O_G + 8192;
static_assert(O_IF + 4224 == O_R, "wkv LDS map 0");
constexpr int O_LW = O_Y + 8192, O_LA = O_LW + 32 * 72 * 2, O_LG = O_LA + 32 * 72 * 2, O_LV = O_LG + 32 * 136 * 2, O_BD = O_LV + 32 * 40 * 2, O_END = O_BD + 4 * 32 * 4;
static_assert(O_END <= 131072, "wkv LDS map");
constexpr int O_PA = O_R;
constexpr int O_PB = O_PA + 9216;
constexpr int O_VT = O_PB + 9216;
static_assert(O_VT + 5120 <= O_V, "wkv LDS map 2");
constexpr int O_PBT = O_KK;
constexpr int O_AF = O_PBT + 9216;
constexpr int O_GAM = O_AF + 4224;
static_assert(O_GAM + 256 <= O_G, "wkv LDS map 3");
constexpr int O_AM = O_LW;
constexpr int O_TT = O_AM + 9216;
constexpr int O_TDT = O_TT + 2560;
constexpr int O_M1T = O_TDT + 1536;
constexpr int O_WS = O_M1T + 768;
static_assert(O_WS + 2048 <= O_BD, "wkv LDS map 4");
}
__device__ __forceinline__ bf16x8_t wk_perm(const unsigned char* p) { u32x4 w; const u32x2 lo = *(const u32x2*)p, hi = *(const u32x2*)(p + 32); w.x = lo.x; w.y = lo.y; w.z = hi.x; w.w = hi.y; return __builtin_bit_cast(bf16x8_t, w); }
__device__ __forceinline__ bf16x8_t wk_pack(const f32x4& x0, const f32x4& x1) { u32x4 w; w.x = pg8::cvt_pk_bf16(x0[0], x0[1]); w.y = pg8::cvt_pk_bf16(x0[2], x0[3]); w.z = pg8::cvt_pk_bf16(x1[0], x1[1]); w.w = pg8::cvt_pk_bf16(x1[2], x1[3]); return __builtin_bit_cast(bf16x8_t, w); }
#ifndef PROBE_ID
#define PROBE_ID 0
#endif
#define WREP(id) _Pragma("unroll 1") for (int wrep_ = 0; wrep_ < ((PROBE_ID == (id)) ? 3 : 1); ++wrep_)
__device__ __forceinline__ void ph_wkv_item(unsigned char* lds, const WkvArgs& a, int item) {
    using namespace wk;
    float* R = LDSF(O_R); float* Wd = LDSF(O_W); float* Kp = LDSF(O_KP); float* Vv = LDSF(O_V); float* KK = LDSF(O_KK); float* BB = LDSF(O_BB); float* G = LDSF(O_G); float* Y = LDSF(O_Y);
    bf16_t* LW = (bf16_t*)(lds + O_LW); bf16_t* LA = (bf16_t*)(lds + O_LA); bf16_t* LG = (bf16_t*)(lds + O_LG); bf16_t* LV = (bf16_t*)(lds + O_LV); float* BD = LDSF(O_BD);
    const int b = item >> 4, h = item & 15, tid0 = opaque_tid();
    const int layer = a.layer;
    float mu1[3][2], kkc[2], muL[5][2];
    float lnwv, lnbv;
    float w0v, a0v, kav, rkv, v0v;
    bf16x8_t fw[2], fa[2], fg[4], fv;
    { const int tid = tid0, lane = tid & 63, wv = tid >> 6, l15 = lane & 15, q4 = lane >> 4, nt = wv & 3, cp = lane & 31, hj = h * 64 + lane, hc = h * 64 + 16 * nt + l15;
#pragma unroll
      for (int x = 0; x < 2; ++x) { const int c = h * 64 + 2 * cp + x; mu1[0][x] = a.mu[c]; mu1[1][x] = a.mu[1024 + c]; mu1[2][x] = a.mu[2048 + c]; kkc[x] = a.k_k[c];
#pragma unroll
          for (int e = 0; e < 4; ++e) muL[e][x] = a.mu[3072 + 64 * e + 2 * cp + x];
          muL[4][x] = (layer && cp < 16) ? a.mu_v[2 * cp + x] : 0.f; }
      lnwv = a.lnw[hj]; lnbv = a.lnb[hj];
      w0v = a.w0[hc]; a0v = a.a0[hc]; kav = a.k_a[hc]; rkv = a.r_k[hc]; v0v = layer ? a.v0[hc] : 0.f;
      bf16_t* T = (bf16_t*)(lds + O_R);
      for (int e = tid; e < 64 * 64; e += 512) { const int i = e >> 6, c = e & 63; T[c * 72 + i] = (bf16_t)f2bf(a.w2[(size_t)i * 1024 + h * 64 + c]); T[64 * 72 + c * 72 + i] = (bf16_t)f2bf(a.a2[(size_t)i * 1024 + h * 64 + c]); }
      for (int e = tid; e < 128 * 64; e += 512) { const int i = e >> 6, c = e & 63; T[2 * 64 * 72 + c * 136 + i] = (bf16_t)f2bf(a.g2[(size_t)i * 1024 + h * 64 + c]); }
      if (layer) for (int e = tid; e < 32 * 64; e += 512) { const int i = e >> 6, c = e & 63; T[2 * 64 * 72 + 64 * 136 + c * 40 + i] = (bf16_t)f2bf(a.v2[(size_t)i * 1024 + h * 64 + c]); }
      __syncthreads();
      const int cl = 16 * nt + l15;
#pragma unroll
      for (int ks = 0; ks < 2; ++ks) { fw[ks] = *(const bf16x8_t*)(T + cl * 72 + 8 * q4 + 32 * ks); fa[ks] = *(const bf16x8_t*)(T + 64 * 72 + cl * 72 + 8 * q4 + 32 * ks); }
#pragma unroll
      for (int ks = 0; ks < 4; ++ks) fg[ks] = *(const bf16x8_t*)(T + 2 * 64 * 72 + cl * 136 + 8 * q4 + 32 * ks);
      fv = layer ? *(const bf16x8_t*)(T + 2 * 64 * 72 + 64 * 136 + cl * 40 + 8 * q4) : fw[0];
      __syncthreads(); }
    f32x4 Hs[4];
#pragma unroll
    for (int c = 0; c < 4; ++c) Hs[c] = (f32x4){0.f, 0.f, 0.f, 0.f};
    bf16x8_t hb0 = (bf16x8_t){0, 0, 0, 0, 0, 0, 0, 0}, hb1 = hb0;
    auto dma = [&](int s0, int tid) {
        const int ln = tid & 63, wvu = __builtin_amdgcn_readfirstlane(tid >> 6); const size_t mb = (size_t)b * cf::SEQ + s0;
#pragma unroll
        for (int q = 0; q < 5; ++q) { const int j = wvu + 8 * q; if (j >= 34) continue;
            const bf16_t* src; int dst; bool on = true;
            if (j < 16) { src = a.ZC + (mb + 2 * j + (ln >> 5)) * 3328 + 3072 + (ln & 31) * 8; dst = O_IL + j * 1024; }
            else if (j < 28) { const int kd = (j - 16) >> 2, jj = (j - 16) & 3; src = a.ZC + (mb + 8 * jj + (ln >> 3)) * 3328 + kd * 1024 + h * 64 + (ln & 7) * 8; dst = O_IR + kd * 4224 + jj * 1024; }
            else if (j < 32) { const int jj = j - 28; src = a.VF + (mb + 8 * jj + (ln >> 3)) * 1024 + h * 64 + (ln & 7) * 8; dst = O_IF + jj * 1024; on = layer != 0; }
            else { const int jj = j - 32; src = a.ZV1 + (mb + 16 * jj + (ln >> 2)) * 32 + (ln & 3) * 8; dst = O_IZ + jj * 1024; on = layer != 0; }
            if (on) __builtin_amdgcn_global_load_lds((const unsigned*)src, (LAS unsigned*)((LAS unsigned char*)lds + dst), 16, 0, 0); }
    };
    auto piece_off = [&](int pc, int rw) { return pc < 24 ? O_IR + (pc >> 3) * 4224 + rw * 128 + (pc & 7) * 16 : (pc < 56 ? O_IL + rw * 512 + (pc - 24) * 16 : (pc < 60 ? O_IZ + rw * 64 + (pc - 56) * 16 : O_IF + rw * 128 + (pc - 60) * 16)); };
#define WK_BAR() do { asm volatile("s_waitcnt lgkmcnt(0)" ::: "memory"); __builtin_amdgcn_s_barrier(); asm volatile("" ::: "memory"); } while (0)
    dma(0, tid0);
    if (tid0 < 68) *(u32x4*)(lds + piece_off(tid0, 32)) = (u32x4){0u, 0u, 0u, 0u};
    asm volatile("s_waitcnt vmcnt(0)" ::: "memory"); __syncthreads();
#pragma unroll 1
    for (int ch = 0; ch < cf::SEQ / TC; ++ch) {
        const int s0 = ch * TC; const size_t m0 = (size_t)b * cf::SEQ + s0;
        int tid = tid0; asm volatile("" : "+v"(tid));
        const int lane = tid & 63, wv = tid >> 6, l15 = lane & 15, q4 = lane >> 4, hj = h * 64 + lane, mt = wv >> 2, nt = wv & 3;
        WREP(11) { const int cp = lane & 31, th = lane >> 5;
          const unsigned* IRw = (const unsigned*)(lds + O_IR); const unsigned* IKw = (const unsigned*)(lds + O_IK); const unsigned* IVw = (const unsigned*)(lds + O_IV); const unsigned* ILw = (const unsigned*)(lds + O_IL); const unsigned* IZw = (const unsigned*)(lds + O_IZ);
#pragma unroll
          for (int it = 0; it < 2; ++it) { const int tt = 4 * wv + 2 * it + th, pr = tt ? tt - 1 : 32;
              const unsigned r1 = IRw[tt * 32 + cp], r0 = IRw[pr * 32 + cp], k1 = IKw[tt * 32 + cp], k0 = IKw[pr * 32 + cp], v1 = IVw[tt * 32 + cp], v0_ = IVw[pr * 32 + cp];
              const float rs0 = bflo(r1) + (bflo(r0) - bflo(r1)) * mu1[0][0], rs1 = bfhi(r1) + (bfhi(r0) - bfhi(r1)) * mu1[0][1];
              const float ks0 = bflo(k1) + (bflo(k0) - bflo(k1)) * mu1[1][0], ks1 = bfhi(k1) + (bfhi(k0) - bfhi(k1)) * mu1[1][1];
              const float vs0 = bflo(v1) + (bflo(v0_) - bflo(v1)) * mu1[2][0], vs1 = bfhi(v1) + (bfhi(v0_) - bfhi(v1)) * mu1[2][1];
              const float kq0 = ks0 * kkc[0], kq1 = ks1 * kkc[1];
              const float sr = sum_row16(kq0 * kq0 + kq1 * kq1);
              const float slo = readlane_f(sr, 0) + readlane_f(sr, 16), shi = readlane_f(sr, 32) + readlane_f(sr, 48);
              const float rn = rsqrtf((th ? shi : slo) + 1e-12f);
              typedef float f32x2_ __attribute__((ext_vector_type(2)));
              *(f32x2_*)(R + tt * 64 + 2 * cp) = (f32x2_){rs0, rs1}; *(f32x2_*)(Kp + tt * 64 + 2 * cp) = (f32x2_){ks0, ks1}; *(f32x2_*)(Vv + tt * 64 + 2 * cp) = (f32x2_){vs0, vs1}; *(f32x2_*)(KK + tt * 64 + 2 * cp) = (f32x2_){kq0 * rn, kq1 * rn};
              if (layer == 0) *(unsigned*)(a.VF + (m0 + tt) * 1024 + h * 64 + 2 * cp) = pk2(vs0, vs1);
              { unsigned z1 = ILw[tt * 128 + cp], z0 = ILw[pr * 128 + cp];
                ((unsigned*)LW)[tt * 36 + cp] = pk2(tanhf_(bflo(z1) + (bflo(z0) - bflo(z1)) * muL[0][0]), tanhf_(bfhi(z1) + (bfhi(z0) - bfhi(z1)) * muL[0][1]));
                z1 = ILw[tt * 128 + 32 + cp]; z0 = ILw[pr * 128 + 32 + cp];
                ((unsigned*)LA)[tt * 36 + cp] = pk2(bflo(z1) + (bflo(z0) - bflo(z1)) * muL[1][0], bfhi(z1) + (bfhi(z0) - bfhi(z1)) * muL[1][1]);
                z1 = ILw[tt * 128 + 64 + cp]; z0 = ILw[pr * 128 + 64 + cp];
                ((unsigned*)LG)[tt * 68 + cp] = pk2(sigmoidf_(bflo(z1) + (bflo(z0) - bflo(z1)) * muL[2][0]), sigmoidf_(bfhi(z1) + (bfhi(z0) - bfhi(z1)) * muL[2][1]));
                z1 = ILw[tt * 128 + 96 + cp]; z0 = ILw[pr * 128 + 96 + cp];
                ((unsigned*)LG)[tt * 68 + 32 + cp] = pk2(sigmoidf_(bflo(z1) + (bflo(z0) - bflo(z1)) * muL[3][0]), sigmoidf_(bfhi(z1) + (bfhi(z0) - bfhi(z1)) * muL[3][1]));
                if (layer && cp < 16) { z1 = IZw[tt * 16 + cp]; z0 = IZw[pr * 16 + cp];
                    ((unsigned*)LV)[tt * 20 + cp] = pk2(bflo(z1) + (bflo(z0) - bflo(z1)) * muL[4][0], bfhi(z1) + (bfhi(z0) - bfhi(z1)) * muL[4][1]); } } } }
        __syncthreads();
        {
            f32x4 cw = (f32x4){0.f, 0.f, 0.f, 0.f}, ca = cw, cgt = cw, cv = cw;
            const int arow = 16 * mt + l15;
#pragma unroll
            for (int ks = 0; ks < 2; ++ks) { const bf16x8_t xw = *(const bf16x8_t*)(LW + arow * 72 + 8 * q4 + 32 * ks), xa = *(const bf16x8_t*)(LA + arow * 72 + 8 * q4 + 32 * ks);
                cw = __builtin_amdgcn_mfma_f32_16x16x32_bf16(xw, fw[ks], cw, 0, 0, 0); ca = __builtin_amdgcn_mfma_f32_16x16x32_bf16(xa, fa[ks], ca, 0, 0, 0); }
#pragma unroll
            for (int ks = 0; ks < 4; ++ks) { const bf16x8_t xg = *(const bf16x8_t*)(LG + arow * 136 + 8 * q4 + 32 * ks); cgt = __builtin_amdgcn_mfma_f32_16x16x32_bf16(xg, fg[ks], cgt, 0, 0, 0); }
            if (layer) { bf16x8_t xv = *(const bf16x8_t*)(LV + arow * 40 + 8 * q4); cv = __builtin_amdgcn_mfma_f32_16x16x32_bf16(xv, fv, cv, 0, 0, 0); }
            const int chn = 16 * nt + l15; const bf16_t* IF = (const bf16_t*)(lds + O_IF);
#pragma unroll
            for (int j = 0; j < 4; ++j) { const int tt = 16 * mt + 4 * q4 + j, e = tt * 64 + chn;
                const float lwd = -0.60653065971f * sigmoidf_(w0v + cw[j]);
                const float av = sigmoidf_(a0v + ca[j]);
                const float rv = R[e], kr = Kp[e], vr = Vv[e];
                float v = vr;
                if (layer) { const float vf = bf2f(IF[tt * 64 + chn]); v = vr + (vf - vr) * sigmoidf_(v0v + cv[j]); }
                const float kp = kr * (1.0f + (av - 1.0f) * kav);
                const float bd = sum_row16(rv * kp * rkv);
                Wd[e] = lwd; Kp[e] = kp; Vv[e] = v; BB[e] = KK[e] * av; G[e] = cgt[j];
                if (l15 == 0) BD[nt * 32 + tt] = bd; }
        }
        __syncthreads();
        if (tid < 68) *(u32x4*)(lds + piece_off(tid, 32)) = *(const u32x4*)(lds + piece_off(tid, 31));
        { float rv[4], lwv[4], kpv[4], kkv4[4], bbv[4], vv4[4]; float* WS = LDSF(O_WS);
#pragma unroll
          for (int q = 0; q < 4; ++q) { const int e = (4 * wv + q) * 64 + lane; rv[q] = R[e]; lwv[q] = Wd[e]; kpv[q] = Kp[e]; kkv4[q] = KK[e]; bbv[q] = BB[e]; vv4[q] = Vv[e]; }
          WS[wv * 64 + lane] = (lwv[0] + lwv[1]) + (lwv[2] + lwv[3]);
          WK_BAR();
          if (ch + 1 < cf::SEQ / TC) dma(s0 + TC, tid);
          float cprev = 0.f;
#pragma unroll
          for (int w2 = 0; w2 < 7; ++w2) { const float x_ = WS[w2 * 64 + lane]; cprev += (w2 < wv) ? x_ : 0.f; }
          bf16_t* PA = (bf16_t*)(lds + O_PA); bf16_t* PB = (bf16_t*)(lds + O_PB); bf16_t* PBT = (bf16_t*)(lds + O_PBT); bf16_t* VTl = (bf16_t*)(lds + O_VT);
          float ep = __expf(cprev), cl = cprev; float bt4[4], kt4[4];
#pragma unroll
          for (int q = 0; q < 4; ++q) { const int t = 4 * wv + q; cl += lwv[q]; const float e = __expf(cl), ei = __expf(-cl);
              PA[t * 72 + lane] = (bf16_t)f2bf(kkv4[q] * ep); PA[(32 + t) * 72 + lane] = (bf16_t)f2bf(rv[q] * e);
              bt4[q] = bbv[q] * ei; kt4[q] = kpv[q] * ei;
              PB[t * 72 + lane] = (bf16_t)f2bf(bt4[q]); PB[(32 + t) * 72 + lane] = (bf16_t)f2bf(kt4[q]);
              ep = e; }
          u32x2 w; w.x = pk2(bt4[0], bt4[1]); w.y = pk2(bt4[2], bt4[3]); *(u32x2*)(PBT + lane * 72 + 4 * wv) = w;
          w.x = pk2(kt4[0], kt4[1]); w.y = pk2(kt4[2], kt4[3]); *(u32x2*)(PBT + lane * 72 + 32 + 4 * wv) = w;
          w.x = pk2(vv4[0], vv4[1]); w.y = pk2(vv4[2], vv4[3]); *(u32x2*)(VTl + lane * 40 + 4 * wv) = w;
          if (wv == 7) LDSF(O_GAM)[lane] = ep; }
        WK_BAR();
        WREP(12) { const bf16_t* PA = (const bf16_t*)(lds + O_PA); const bf16_t* PB = (const bf16_t*)(lds + O_PB); bf16_t* AM = (bf16_t*)(lds + O_AM); float* AF = LDSF(O_AF);
          const int mtile = wv >> 1;
          const bf16x8_t a0 = *(const bf16x8_t*)(PA + (16 * mtile + l15) * 72 + 8 * q4), a1 = *(const bf16x8_t*)(PA + (16 * mtile + l15) * 72 + 8 * q4 + 32);
#pragma unroll
          for (int nn = 0; nn < 2; ++nn) { const int ntile = 2 * (wv & 1) + nn;
              const bf16x8_t b0 = *(const bf16x8_t*)(PB + (16 * ntile + l15) * 72 + 8 * q4), b1 = *(const bf16x8_t*)(PB + (16 * ntile + l15) * 72 + 8 * q4 + 32);
              f32x4 c = (f32x4){0.f, 0.f, 0.f, 0.f};
              c = __builtin_amdgcn_mfma_f32_16x16x32_bf16(a0, b0, c, 0, 0, 0); c = __builtin_amdgcn_mfma_f32_16x16x32_bf16(a1, b1, c, 0, 0, 0);
              const int sg = 16 * ntile + l15, s_ = sg & 31;
#pragma unroll
              for (int j = 0; j < 4; ++j) { const int rho = 16 * mtile + 4 * q4 + j, t_ = rho & 31; const bool keep = (rho < 32) ? (t_ > s_) : (t_ >= s_); const float val = keep ? c[j] : 0.f;
                  AM[rho * 72 + sg] = (bf16_t)f2bf(val); if (rho < 32 && sg < 32) AF[rho * 33 + sg] = val; } } }
        WK_BAR();
        WREP(13) { bf16_t* TT = (bf16_t*)(lds + O_TT); bf16_t* TDT = (bf16_t*)(lds + O_TDT);
          if (wv < 2 && lane < 16) { const float* AF = LDSF(O_AF) + (16 * wv) * 33 + 16 * wv; float x[16];
#pragma unroll
              for (int t = 0; t < 16; ++t) { float acc = (t == lane) ? 1.f : 0.f;
#pragma unroll
                  for (int s = 0; s < 16; ++s) if (s < t) acc -= AF[t * 33 + s] * x[s];
                  x[t] = acc; }
#pragma unroll
              for (int t = 0; t < 16; ++t) TT[(16 * wv + t) * 40 + 16 * wv + lane] = (bf16_t)f2bf(x[t]);
              u32x4 w0_, w1_; w0_.x = pk2(x[0], x[1]); w0_.y = pk2(x[2], x[3]); w0_.z = pk2(x[4], x[5]); w0_.w = pk2(x[6], x[7]); w1_.x = pk2(x[8], x[9]); w1_.y = pk2(x[10], x[11]); w1_.z = pk2(x[12], x[13]); w1_.w = pk2(x[14], x[15]);
              *(u32x4*)(TDT + (wv * 16 + lane) * 24) = w0_; *(u32x4*)(TDT + (wv * 16 + lane) * 24 + 8) = w1_; }
          if (wv == 2 && lane < 32) { const int rw = lane >> 1; *(u32x4*)(TT + rw * 40 + 16 + 8 * (lane & 1)) = (u32x4){0u, 0u, 0u, 0u}; }
        }
        WK_BAR();
        WREP(14) if (wv == 0) { const bf16_t* AM = (const bf16_t*)(lds + O_AM); bf16_t* TT = (bf16_t*)(lds + O_TT); const bf16_t* TDT = (const bf16_t*)(lds + O_TDT); bf16_t* M1T = (bf16_t*)(lds + O_M1T);
            const bf16x8_t zf = (bf16x8_t){0, 0, 0, 0, 0, 0, 0, 0};
            bf16x8_t af = zf, bf = zf;
            if (q4 < 2) { af = *(const bf16x8_t*)(AM + (16 + l15) * 72 + 8 * q4); bf = *(const bf16x8_t*)(TDT + l15 * 24 + 8 * q4); }
            f32x4 c = (f32x4){0.f, 0.f, 0.f, 0.f};
            c = __builtin_amdgcn_mfma_f32_16x16x32_bf16(af, bf, c, 0, 0, 0);
            u32x2 w; w.x = pk2(c[0], c[1]); w.y = pk2(c[2], c[3]); *(u32x2*)(M1T + l15 * 24 + 4 * q4) = w;
            __builtin_amdgcn_wave_barrier(); asm volatile("s_waitcnt lgkmcnt(0)" ::: "memory");
            af = zf; bf = zf;
            if (q4 < 2) { af = *(const bf16x8_t*)(TT + (16 + l15) * 40 + 16 + 8 * q4); bf = *(const bf16x8_t*)(M1T + l15 * 24 + 8 * q4); }
            c = (f32x4){0.f, 0.f, 0.f, 0.f};
            c = __builtin_amdgcn_mfma_f32_16x16x32_bf16(af, bf, c, 0, 0, 0);
#pragma unroll
            for (int j = 0; j < 4; ++j) TT[(16 + 4 * q4 + j) * 40 + l15] = (bf16_t)f2bf(-c[j]); }
        WK_BAR();
        if (wv < 4) {
            const unsigned char* pPA = lds + O_PA + l15 * 144 + 8 * q4;   const unsigned char* nAM = lds + O_AM + l15 * 144 + 16 * q4 + 64;
            const unsigned char* pAM = lds + O_AM + l15 * 144 + 8 * q4;   const unsigned char* pTT = lds + O_TT + l15 * 80 + 8 * q4;
            const unsigned char* pPBT = lds + O_PBT + l15 * 144 + 8 * q4; const unsigned char* nPBT = lds + O_PBT + l15 * 144 + 16 * q4 + 64;
            const bf16x8_t vfrag = *(const bf16x8_t*)(lds + O_VT + (16 * wv + l15) * 80 + 16 * q4);
            f32x4 x1[2];
#pragma unroll
            for (int m2 = 0; m2 < 2; ++m2) { f32x4 c = (f32x4){0.f, 0.f, 0.f, 0.f};
                c = __builtin_amdgcn_mfma_f32_16x16x32_bf16(*(const bf16x8_t*)(nAM + m2 * 2304), vfrag, c, 0, 0, 0);
                c = __builtin_amdgcn_mfma_f32_16x16x32_bf16(wk_perm(pPA + m2 * 2304), hb0, c, 0, 0, 0);
                c = __builtin_amdgcn_mfma_f32_16x16x32_bf16(wk_perm(pPA + m2 * 2304 + 64), hb1, c, 0, 0, 0);
                x1[m2] = -c; }
            const bf16x8_t xb = wk_pack(x1[0], x1[1]);
            f32x4 uu[2];
#pragma unroll
            for (int m2 = 0; m2 < 2; ++m2) { f32x4 c = (f32x4){0.f, 0.f, 0.f, 0.f}; uu[m2] = __builtin_amdgcn_mfma_f32_16x16x32_bf16(wk_perm(pTT + m2 * 1280), xb, c, 0, 0, 0); }
            const bf16x8_t ub = wk_pack(uu[0], uu[1]);
#pragma unroll
            for (int m2 = 0; m2 < 2; ++m2) { f32x4 c = (f32x4){0.f, 0.f, 0.f, 0.f};
                c = __builtin_amdgcn_mfma_f32_16x16x32_bf16(*(const bf16x8_t*)(nAM + (2 + m2) * 2304), vfrag, c, 0, 0, 0);
                c = __builtin_amdgcn_mfma_f32_16x16x32_bf16(wk_perm(pPA + (2 + m2) * 2304), hb0, c, 0, 0, 0);
                c = __builtin_amdgcn_mfma_f32_16x16x32_bf16(wk_perm(pPA + (2 + m2) * 2304 + 64), hb1, c, 0, 0, 0);
                c = __builtin_amdgcn_mfma_f32_16x16x32_bf16(wk_perm(pAM + (2 + m2) * 2304), ub, c, 0, 0, 0);
#pragma unroll
                for (int j = 0; j < 4; ++j) Y[(16 * m2 + 4 * q4 + j) * 64 + 16 * wv + l15] = c[j]; }
#pragma unroll
            for (int jm = 0; jm < 4; ++jm) {
                Hs[jm] = __builtin_amdgcn_mfma_f32_16x16x32_bf16(*(const bf16x8_t*)(nPBT + jm * 2304), vfrag, Hs[jm], 0, 0, 0);
                Hs[jm] = __builtin_amdgcn_mfma_f32_16x16x32_bf16(wk_perm(pPBT + jm * 2304), ub, Hs[jm], 0, 0, 0);
                const f32x4 gm = *(const f32x4*)(LDSF(O_GAM) + 16 * jm + 4 * q4); Hs[jm] = Hs[jm] * gm; }
            hb0 = wk_pack(Hs[0], Hs[1]); hb1 = wk_pack(Hs[2], Hs[3]);
        }
        WK_BAR();
        WREP(15)
#pragma unroll
        for (int q = 0; q < 4; ++q) { const int tt = 4 * wv + q;
            const float y = Y[tt * 64 + lane]; const float mu = wave_sum(y) * (1.f / 64.f); const float d = y - mu; const float var = wave_sum(d * d) * (1.f / 64.f);
            const float bd = (BD[tt] + BD[32 + tt]) + (BD[64 + tt] + BD[96 + tt]);
            const float o = (d * rsqrtf(var + cf::GN_EPS) * lnwv + lnbv + bd * Vv[tt * 64 + lane]) * G[tt * 64 + lane];
            a.YC[(m0 + tt) * (size_t)a.ldy + hj] = (bf16_t)f2bf(o); }
        asm volatile("s_waitcnt vmcnt(0)" ::: "memory");
        WK_BAR();
    }
#undef WK_BAR
}
#include <hip/hip_cooperative_groups.h>
namespace cg = cooperative_groups;
namespace wsmap {
using cf::MiB;
constexpr size_t CTL = 0, MOD = 1 * MiB, CS = MiB + MiB / 2, H = 3 * MiB, VF = 35 * MiB, W = 67 * MiB, AR = 84 * MiB;
constexpr size_t XA = AR, GA = AR + 32 * MiB, Q = AR + 64 * MiB, K = AR + 88 * MiB, V = AR + 112 * MiB, ZC = AR + 136 * MiB, ZV1 = AR + 240 * MiB, YB = AR + 241 * MiB;
constexpr size_t GT = Q, MG = AR + 96 * MiB, YO = AR + 128 * MiB;
constexpr size_t U = AR, SS = AR + 88 * MiB, YF = AR + 176 * MiB;
constexpr size_t W_G = W, W_PA = W + 6 * MiB, W_PB = W + 8 * MiB, W_PC = W + 8 * MiB + MiB / 2, W_O = W + 10 * MiB + MiB / 2;
constexpr size_t W_UP = W, W_DN = W + 11 * MiB;
}
#ifndef PROBE_ID
#define PROBE_ID 0
#endif
#define REP(id) _Pragma("unroll 1") for (int rep_ = 0; rep_ < ((PROBE_ID == (id)) ? 3 : 1); ++rep_)
constexpr int MEGA_LDS = 147456;
struct MegaArgs { const float* in[40]; float* out; unsigned char* ws; };

template <class Epi> __device__ __forceinline__ void run_gemm(unsigned char* lds, const bf16_t* A, int lda, const bf16_t* Bt, int M, int N, int K, const Epi& E) {
    pg8::Gemm g; g.A = A; g.Bt = Bt; g.M = M; g.N = N; g.K = K; g.lda = lda;
    pg8::StaticOrder S; S.init(M, N, (int)gridDim.x, (int)blockIdx.x);
    pg8::gemm_phase<Epi, pg8::StaticOrder, true, true>((PG8_LAS unsigned char*)lds, g, S, E);
}

__global__ __launch_bounds__(512, 2) void mega(MegaArgs A) {
    using namespace wsmap;
    cg::grid_group grid = cg::this_grid();
    extern __shared__ __attribute__((aligned(16))) unsigned char lds[];
#define KARG(i) (((const float* const volatile __attribute__((address_space(4)))*)__builtin_amdgcn_kernarg_segment_ptr())[i])
#define F(i) ((const float*)KARG(i))
#define P_WS ((unsigned char*)KARG(41))
    { volatile LAS unsigned* misc = (volatile LAS unsigned*)((LAS unsigned char*)lds + 131072 + 320); { const int t_ = opaque_tid(); if (t_ < 32) misc[t_] = 0u; } }
    __syncthreads();
    (void)xcd_barrier_post((unsigned*)(P_WS) + 4096, (volatile LAS unsigned*)((LAS unsigned char*)lds + 131072 + 320) + 8);
#define GSYNC() do { XcdBarrier xb_; xb_.bar = (unsigned*)(P_WS) + 4096; xb_.x = xb_xcc_id(); xb_.st = (volatile LAS unsigned*)((LAS unsigned char*)lds + 131072 + 320) + 8; xcd_barrier(xb_); } while (0)
#define P_X ((float*)KARG(40))
#define P_MOD ((float*)(P_WS + MOD))
#define P_CS ((float*)(P_WS + CS))
#define P_H ((bf16_t*)(P_WS + H))
#define P_VF ((bf16_t*)(P_WS + VF))
#define P_WINT ((bf16_t*)(P_WS + W))
    REP(8) ph_mod(lds, F(1), F(3), F(4), P_MOD);
    ph_rope((const int*)F(2), P_CS);
    __syncthreads();
    REP(7) ph_transpose(lds, F(5), 1024, 10752, 0, 7680, P_WINT, 0);
    __syncthreads(); grid.sync();
    ph_modulate(F(0), P_MOD, 0, 1024, P_H);
    GSYNC();
#pragma unroll 1
    for (int l = 0; l < 2; ++l) {
#define P_MODL (P_MOD + (size_t)l * 4 * 6144)
        { pg8::EpiIn E; E.XA = (bf16_t*)(P_WS + XA); E.GA = (bf16_t*)(P_WS + GA); E.Q = (bf16_t*)(P_WS + Q); E.K = (bf16_t*)(P_WS + K); E.V = (bf16_t*)(P_WS + V); E.ZC = (bf16_t*)(P_WS + ZC); E.ZV1 = (bf16_t*)(P_WS + ZV1); E.cs = P_CS;
          REP(1) run_gemm(lds, P_H, 1024, P_WINT, cf::M, (30 + l) * 256, 1024, E); }
        GSYNC();
        REP(7) ph_transpose(lds, F(5) + (size_t)l * 1024 * 10752, 1024, 10752, 7680, 3072, (bf16_t*)(P_WS + W_G), 0);
        REP(7) ph_transpose(lds, F(28) + (size_t)l * 1024 * 1024, 1024, 1024, 0, 1024, (bf16_t*)(P_WS + W_PA), 0);
        REP(7) ph_transpose(lds, F(29) + (size_t)l * 256 * 1024, 256, 1024, 0, 1024, (bf16_t*)(P_WS + W_PB), 0);
        REP(7) ph_transpose(lds, F(30) + (size_t)l * 1024 * 1024, 1024, 1024, 0, 1024, (bf16_t*)(P_WS + W_PC), 0);
        REP(7) ph_transpose(lds, F(31) + (size_t)l * 1024 * 1024, 1024, 1024, 0, 1024, (bf16_t*)(P_WS + W_O), 0);
        __syncthreads();
        if (blockIdx.x < 64) {
            LruArgs a; a.XA = (const bf16_t*)(P_WS + XA); a.GA = (bf16_t*)(P_WS + GA); a.cw = F(7) + l * 4096; a.cb = F(8) + l * 1024; a.wa = F(9) + l * 65536; a.ba = F(10) + l * 1024; a.wx = F(11) + l * 65536; a.bx = F(12) + l * 1024; a.lam = F(13) + l * 1024;
            ph_lru_item(lds, a, (int)blockIdx.x);
        } else if (blockIdx.x < 128) {
            WkvArgs a; a.ZC = (const bf16_t*)(P_WS + ZC); a.ZV1 = (const bf16_t*)(P_WS + ZV1); a.VF = P_VF; a.YC = (bf16_t*)(P_WS + ZC) + 2048; a.ldy = 3328;
            a.mu = F(14) + l * 3328; a.mu_v = F(15); a.w0 = F(16) + l * 1024; a.w2 = F(17) + l * 65536; a.a0 = F(18) + l * 1024; a.a2 = F(19) + l * 65536; a.g2 = F(20) + l * 131072; a.v0 = F(21); a.v2 = F(22);
            a.k_k = F(23) + l * 1024; a.k_a = F(24) + l * 1024; a.r_k = F(25) + l * 1024; a.lnw = F(26) + l * 1024; a.lnb = F(27) + l * 1024; a.layer = l;
            ph_wkv_item(lds, a, (int)blockIdx.x - 64);
        } else ph_attn((const bf16_t*)(P_WS + Q), (const bf16_t*)(P_WS + K), (const bf16_t*)(P_WS + V), (bf16_t*)(P_WS + YB), ((int)blockIdx.x - 128) * 8 + (opaque_tid() >> 6), ((int)gridDim.x - 128) * 8);
        GSYNC();
        REP(2)
#pragma unroll 1
        for (int br = 0; br < 3; ++br) {
            { pg8::EpiBf16<1> Eg; Eg.O = (bf16_t*)(P_WS + GT); Eg.ldc = 1024; Eg.pad_ = 0;
              run_gemm(lds, P_H, 1024, (const bf16_t*)(P_WS + W_G) + (size_t)br * 1024 * 1024, cf::M, 1024, 1024, Eg); }
            const bf16_t* Y = (br == 0) ? (const bf16_t*)(P_WS + GA) : ((br == 1) ? (const bf16_t*)(P_WS + YB) : (const bf16_t*)(P_WS + ZC) + 2048); const bf16_t* P = (const bf16_t*)(P_WS + (br == 0 ? W_PA : (br == 1 ? W_PB : W_PC))); const int Kb = (br == 1) ? 256 : 1024, ldY = (br == 2) ? 3328 : Kb;
            if (br == 0) { pg8::EpiMerge<0> Em; Em.MG = (bf16_t*)(P_WS + MG); Em.GT = (const bf16_t*)(P_WS + GT); Em.ldc = 1024; Em.pad_ = 0; run_gemm(lds, Y, ldY, P, cf::M, 1024, Kb, Em); }
            else { pg8::EpiMerge<1> Em; Em.MG = (bf16_t*)(P_WS + MG); Em.GT = (const bf16_t*)(P_WS + GT); Em.ldc = 1024; Em.pad_ = 0; run_gemm(lds, Y, ldY, P, cf::M, 1024, Kb, Em); }
        }
        GSYNC();
        { pg8::EpiF32 E; E.C = (float*)(P_WS + YO); E.ldc = 1024; E.pad_ = 0; REP(3) run_gemm(lds, (const bf16_t*)(P_WS + MG), 1024, (const bf16_t*)(P_WS + W_O), cf::M, 1024, 1024, E); }
        GSYNC();
        ph_ln(l == 0 ? F(0) : (const float*)P_X, (const float*)(P_WS + YO), 0, cf::M, P_MODL, 2048, F(32) + l * 1024, F(33) + l * 1024, P_X, P_MODL, 3072, 4096, P_H);
        REP(7) ph_transpose(lds, F(34) + (size_t)l * 1024 * 5632, 1024, 5632, 0, 5632, (bf16_t*)(P_WS + W_UP), 0);
        REP(7) ph_transpose(lds, F(37) + (size_t)l * 2816 * 1024, 2816, 1024, 0, 1024, (bf16_t*)(P_WS + W_DN), 0);
        GSYNC();
#pragma unroll 1
        for (int hf = 0; hf < 2; ++hf) {
            const int m0 = hf * 8192;
            { pg8::EpiBf16<0> E; E.O = (bf16_t*)(P_WS + U); E.ldc = 5632; E.pad_ = 0; REP(4) run_gemm(lds, P_H + (size_t)m0 * 1024, 1024, (const bf16_t*)(P_WS + W_UP), 8192, 5632, 1024, E); }
            GSYNC();
            REP(5) ph_convglu((const bf16_t*)(P_WS + U), 8192, F(35) + l * 3 * 5632, F(36) + l * 5632, (bf16_t*)(P_WS + SS) + (size_t)m0 * 2816);
            GSYNC();
        }
        { pg8::EpiF32 E; E.C = (float*)(P_WS + YF); E.ldc = 1024; E.pad_ = 0; REP(6) run_gemm(lds, (const bf16_t*)(P_WS + SS), 2816, (const bf16_t*)(P_WS + W_DN), cf::M, 1024, 2816, E); }
        GSYNC();
        ph_ln((const float*)P_X, (const float*)(P_WS + YF), 0, cf::M, P_MODL, 5120, F(38) + l * 1024, F(39) + l * 1024, P_X, P_MOD + 4 * 6144, 0, 1024, l == 0 ? P_H : (bf16_t*)nullptr);
        if (l == 0) {
            REP(7) ph_transpose(lds, F(5) + (size_t)1024 * 10752, 1024, 10752, 0, 7680, P_WINT, 0);
            REP(7) ph_transpose(lds, F(6), 1024, 32, 0, 32, P_WINT, 7680);
            ph_zero16((u32x4*)(P_WINT + (size_t)7712 * 1024), (size_t)224 * 1024 * 2 / 16);
            GSYNC();
        }
    }
#undef F
#undef GSYNC
#undef P_WS
#undef P_X
#undef P_MOD
#undef P_CS
#undef P_H
#undef P_VF
#undef P_WINT
#undef P_MODL
}

extern "C" void kernel_launch(void* const* d_in, const int* in_sizes, int n_in, void* d_out, int out_size, void* d_ws, size_t ws_size, hipStream_t stream) {
    static int grid = 0;
    if (grid == 0) {
        int dev = 0, cus = 0, per_cu = 0;
        (void)hipGetDevice(&dev); (void)hipDeviceGetAttribute(&cus, hipDeviceAttributeMultiprocessorCount, dev);
        (void)hipFuncSetAttribute((const void*)mega, hipFuncAttributeMaxDynamicSharedMemorySize, MEGA_LDS);
        (void)hipOccupancyMaxActiveBlocksPerMultiprocessor(&per_cu, (const void*)mega, 512, MEGA_LDS);
        if (per_cu < 1) { fprintf(stderr, "kernel_launch: occupancy query says %d workgroups per CU\n", per_cu); per_cu = 1; }
        grid = cus;
        if (grid != 256) fprintf(stderr, "kernel_launch: %d CUs (built for 256)\n", grid);
    }
    (void)hipMemsetAsync((char*)d_ws + wsmap::CTL, 0, cf::MiB, stream);
    MegaArgs a{};
    for (int i = 0; i < 40; ++i) a.in[i] = (const float*)d_in[i];
    a.out = (float*)d_out; a.ws = (unsigned char*)d_ws;
    void* args[] = {&a};
    hipError_t e = hipLaunchCooperativeKernel((const void*)mega, dim3(grid), dim3(512), args, MEGA_LDS, stream);
    if (e != hipSuccess) fprintf(stderr, "cooperative launch failed: %s (grid %d)\n", hipGetErrorString(e), grid);
}
```

```cpp
#include <hip/hip_runtime.h>
#include <cstdio>
#include <cstdint>
namespace pg8 {
#define PG8_LAS __attribute__((address_space(3)))
typedef unsigned short bf16_t;
typedef short bf16x8 __attribute__((ext_vector_type(8)));
typedef float f32x4 __attribute__((ext_vector_type(4)));
typedef unsigned u32x4 __attribute__((ext_vector_type(4)));
typedef unsigned u32x2 __attribute__((ext_vector_type(2)));
constexpr int BM = 256, BK = 64, HALF = 128, HTB = HALF * BK * 2, STAGE_BYTES = 8 * HTB, NXCD = 8, WGM = 8;

__host__ __device__ __forceinline__ int lds_byte(int r, int c) { const int st = (r >> 4) * 2 + (c >> 5), rr = r & 15, cc = c & 31, ob = rr * 64 + cc * 2; return st * 1024 + (ob ^ (((ob >> 9) & 1) << 5)); }
__host__ __device__ __forceinline__ void stage_rc(int b, int& R, int& C) { const int st = b / 1024, sb = b % 1024, swz = sb ^ (((sb >> 9) & 1) << 5); R = (st >> 1) * 16 + swz / 64; C = (st & 1) * 32 + (swz % 64) / 2; }
__host__ __device__ __forceinline__ int perm32(int rho) { const int n = rho >> 4, i = rho & 15; return 8 * (i >> 2) + 4 * n + (i & 3); }

struct Unit { int pm, pn; };
struct Gemm { const bf16_t* A; const bf16_t* Bt; int M, N, K, lda; };

struct StaticOrder {
    int nM, nN, nwg, G, c;
    __host__ __device__ void init(int M, int N, int G_, int c_) { nM = M / BM; nN = N / BM; nwg = nM * nN; G = G_; c = c_; }
    __host__ __device__ bool next(int i, Unit& u) const {
        const long L = (long)i * G + c; if (L >= nwg) return false;
        int wgid = (int)L; { const int q = nwg / NXCD, r = nwg % NXCD, xcd = wgid % NXCD, off = wgid / NXCD; wgid = (xcd < r ? xcd * (q + 1) : r * (q + 1) + (xcd - r) * q) + off; }
        const int nig = WGM * nN, gid = wgid / nig, fm = gid * WGM, gsz = (nM - fm) < WGM ? (nM - fm) : WGM;
        u.pm = fm + ((wgid % nig) % gsz); u.pn = (wgid % nig) / gsz; return true;
    }
    __device__ __forceinline__ void a_ready(const Unit&) const {}
    __device__ __forceinline__ void done(const Unit&) const {}
};

typedef float f32x2_cv __attribute__((ext_vector_type(2)));
typedef __bf16 bf16x2_cv __attribute__((ext_vector_type(2)));
__device__ __forceinline__ unsigned cvt_pk_bf16(float lo, float hi) { const f32x2_cv f = {lo, hi}; const bf16x2_cv r = __builtin_convertvector(f, bf16x2_cv); return __builtin_bit_cast(unsigned, r); }

template <class Epi, class Sched, bool ALIGN_EPI = false, bool SP2 = false>
__device__ __forceinline__ void gemm_phase(PG8_LAS unsigned char* lds, const Gemm g, const Sched& S, const Epi& E) {
    int tid = threadIdx.x; asm volatile("" : "+v"(tid));
    const int wid = __builtin_amdgcn_readfirstlane(tid >> 6), lane = tid & 63, wr = wid >> 2, wc = wid & 3, fr = lane & 15, fq = lane >> 4;
    const int K = g.K, nt = K / BK, lda = g.lda;
    unsigned voffA[2], voffB[2];
#pragma unroll
    for (int i = 0; i < 2; ++i) { int R, C; stage_rc(tid * 16 + i * 8192, R, C); const int Rb = Epi::PERM ? ((R & ~31) + perm32(R & 31)) : R;
        voffA[i] = (unsigned)(R * lda + C) * 2u; voffB[i] = (unsigned)(Rb * K + C) * 2u; }
    const size_t kstep = (size_t)(BK * 2);
    const size_t hstepA = (size_t)HALF * lda * 2, hstepB = (size_t)HALF * K * 2;
    const size_t tstepA = 2 * hstepA, tstepB = 2 * hstepB;
    const unsigned ldsw = (unsigned)wid * 1024u;
    const int aoff = lds_byte(wr * 64 + fr, fq * 8), boff = lds_byte(wc * 32 + fr, fq * 8);
#define PG8_SA(b, h) (((b) * 2 + (h)) * HTB)
#define PG8_SB(b, h) ((4 + (b) * 2 + (h)) * HTB)
#define PG8_STAGE(bufoff, gbase, voff) do { _Pragma("unroll") for (int _i = 0; _i < 2; ++_i) \
        __builtin_amdgcn_global_load_lds((const unsigned*)((const char*)(gbase) + (voff)[_i]), (PG8_LAS unsigned*)(lds + (bufoff) + ldsw + _i * 8192), 16, 0, 0); } while (0)
#define PG8_LDA(dst, b, h) do { _Pragma("unroll") for (int m = 0; m < 4; ++m) _Pragma("unroll") for (int k = 0; k < 2; ++k) dst[m][k] = *(const PG8_LAS bf16x8*)(lds + PG8_SA(b, h) + aoff + m * 2048 + k * 1024); } while (0)
#define PG8_LDB(dst, b, h) do { _Pragma("unroll") for (int n = 0; n < 2; ++n) _Pragma("unroll") for (int k = 0; k < 2; ++k) dst[n][k] = *(const PG8_LAS bf16x8*)(lds + PG8_SB(b, h) + boff + n * 2048 + k * 1024); } while (0)
#define PG8_MMA(ai, bj, At, Bt) do { __builtin_amdgcn_s_setprio(1); _Pragma("unroll") for (int m = 0; m < 4; ++m) _Pragma("unroll") for (int n = 0; n < 2; ++n) _Pragma("unroll") for (int k = 0; k < 2; ++k) \
        acc[ai][bj][m][n] = __builtin_amdgcn_mfma_f32_16x16x32_bf16(Bt[n][k], At[m][k], acc[ai][bj][m][n], 0, 0, 0); __builtin_amdgcn_s_setprio(0); } while (0)
#define PG8_WAIT_V(n) asm volatile("s_waitcnt vmcnt(" #n ")" ::: "memory")
#define PG8_WAIT_L(n) asm volatile("s_waitcnt lgkmcnt(" #n ")" ::: "memory")
#define PG8_BAR __builtin_amdgcn_s_barrier()
#define PG8_SCHED __builtin_amdgcn_sched_barrier(0)
    Unit cur, nxt; int ui = 0;
    if (!S.next(0, cur)) return;
    f32x4 acc[2][2][4][2];
#pragma unroll
    for (int a = 0; a < 2; ++a)
#pragma unroll
        for (int b = 0; b < 2; ++b)
#pragma unroll
            for (int m = 0; m < 4; ++m)
#pragma unroll
                for (int n = 0; n < 2; ++n) acc[a][b][m][n] = (f32x4){0.f, 0.f, 0.f, 0.f};
    bf16x8 At[4][2], B0[2][2], B1[2][2];
    const char* cA = (const char*)g.A + (size_t)cur.pm * tstepA; const char* cB = (const char*)g.Bt + (size_t)cur.pn * tstepB;
    S.a_ready(cur);
    if constexpr (SP2) {
        PG8_STAGE(PG8_SB(0, 0), cB, voffB); PG8_STAGE(PG8_SB(0, 1), cB + hstepB, voffB); PG8_STAGE(PG8_SA(0, 0), cA, voffA); PG8_STAGE(PG8_SA(0, 1), cA + hstepA, voffA);
        if (wr == 1) PG8_BAR;
        PG8_WAIT_V(2); PG8_BAR;
        PG8_STAGE(PG8_SB(1, 0), cB + kstep, voffB); PG8_STAGE(PG8_SA(1, 0), cA + kstep, voffA); PG8_STAGE(PG8_SB(1, 1), cB + hstepB + kstep, voffB);
        PG8_WAIT_V(6); PG8_BAR;
    } else {
        PG8_STAGE(PG8_SB(0, 0), cB, voffB); PG8_STAGE(PG8_SA(0, 0), cA, voffA); PG8_STAGE(PG8_SB(0, 1), cB + hstepB, voffB); PG8_STAGE(PG8_SA(0, 1), cA + hstepA, voffA);
        if (wr == 1) PG8_BAR;
        PG8_WAIT_V(4); PG8_BAR;
        PG8_STAGE(PG8_SB(1, 0), cB + kstep, voffB); PG8_STAGE(PG8_SA(1, 0), cA + kstep, voffA); PG8_STAGE(PG8_SB(1, 1), cB + hstepB + kstep, voffB);
        PG8_WAIT_V(6); PG8_BAR;
    }
    for (;;) {
        const bool has_next = S.next(ui + 1, nxt);
        const char* nA = has_next ? (const char*)g.A + (size_t)nxt.pm * tstepA : cA; const char* nB = has_next ? (const char*)g.Bt + (size_t)nxt.pn * tstepB : cB;
        for (int t = 0; t < nt; t += 2) {
            const bool last = (t == nt - 2);
            const char* a1 = cA + (size_t)(t + 1) * kstep;
            const char* a2 = last ? nA : cA + (size_t)(t + 2) * kstep; const char* b2 = last ? nB : cB + (size_t)(t + 2) * kstep;
            const char* a3 = a2 + kstep; const char* b3 = b2 + kstep;
            if (last && has_next) S.a_ready(nxt);
            if constexpr (SP2) {
            PG8_LDB(B0, 0, 0); PG8_LDB(B1, 0, 1); PG8_SCHED; PG8_LDA(At, 0, 0); PG8_STAGE(PG8_SA(1, 1), a1 + hstepA, voffA);
            PG8_WAIT_V(8); PG8_WAIT_L(0); PG8_BAR; PG8_MMA(0, 0, At, B0); PG8_MMA(0, 1, At, B1); PG8_BAR; PG8_SCHED;
            PG8_LDA(At, 0, 1); PG8_STAGE(PG8_SB(0, 0), b2, voffB); PG8_STAGE(PG8_SB(0, 1), b2 + hstepB, voffB); PG8_STAGE(PG8_SA(0, 0), a2, voffA);
            PG8_WAIT_V(8); PG8_WAIT_L(0); PG8_BAR; PG8_MMA(1, 0, At, B0); PG8_MMA(1, 1, At, B1); PG8_BAR; PG8_SCHED;
            PG8_LDB(B0, 1, 0); PG8_LDB(B1, 1, 1); PG8_SCHED; PG8_LDA(At, 1, 0); PG8_STAGE(PG8_SA(0, 1), a2 + hstepA, voffA);
            PG8_WAIT_V(8); PG8_WAIT_L(0); PG8_BAR; PG8_MMA(0, 0, At, B0); PG8_MMA(0, 1, At, B1); PG8_BAR; PG8_SCHED;
            PG8_LDA(At, 1, 1); PG8_STAGE(PG8_SB(1, 0), b3, voffB); PG8_STAGE(PG8_SB(1, 1), b3 + hstepB, voffB); PG8_STAGE(PG8_SA(1, 0), a3, voffA);
            PG8_WAIT_V(8); PG8_WAIT_L(0); PG8_BAR; PG8_MMA(1, 0, At, B0); PG8_MMA(1, 1, At, B1); PG8_BAR; PG8_SCHED;
            } else {
            PG8_LDB(B0, 0, 0); PG8_SCHED; PG8_LDA(At, 0, 0); PG8_STAGE(PG8_SA(1, 1), a1 + hstepA, voffA);
            PG8_WAIT_L(8); PG8_BAR; PG8_WAIT_L(0); PG8_MMA(0, 0, At, B0); PG8_BAR; PG8_SCHED;
            PG8_LDB(B1, 0, 1); PG8_STAGE(PG8_SB(0, 0), b2, voffB);
            PG8_BAR; PG8_WAIT_L(0); PG8_MMA(0, 1, At, B1); PG8_BAR;
            PG8_LDA(At, 0, 1); PG8_STAGE(PG8_SA(0, 0), a2, voffA);
            PG8_BAR; PG8_WAIT_L(0); PG8_MMA(1, 0, At, B0); PG8_BAR; PG8_SCHED;
            PG8_STAGE(PG8_SB(0, 1), b2 + hstepB, voffB);
            PG8_WAIT_V(6); PG8_BAR; PG8_MMA(1, 1, At, B1); PG8_BAR;
            PG8_LDB(B0, 1, 0); PG8_SCHED; PG8_LDA(At, 1, 0); PG8_STAGE(PG8_SA(0, 1), a2 + hstepA, voffA);
            PG8_WAIT_L(8); PG8_BAR; PG8_WAIT_L(0); PG8_MMA(0, 0, At, B0); PG8_BAR; PG8_SCHED;
            PG8_LDB(B1, 1, 1); PG8_STAGE(PG8_SB(1, 0), b3, voffB);
            PG8_BAR; PG8_WAIT_L(0); PG8_MMA(0, 1, At, B1); PG8_BAR;
            PG8_LDA(At, 1, 1); PG8_STAGE(PG8_SA(1, 0), a3, voffA);
            PG8_BAR; PG8_WAIT_L(0); PG8_MMA(1, 0, At, B0); PG8_BAR; PG8_SCHED;
            PG8_STAGE(PG8_SB(1, 1), b3 + hstepB, voffB);
            PG8_WAIT_V(6); PG8_BAR; PG8_MMA(1, 1, At, B1); PG8_BAR;
            }
        }
        if constexpr (ALIGN_EPI) { if (wr == 0) PG8_BAR; }
        if constexpr (!Epi::AFTER_DRAIN) { E(acc, cur, wr, wc, fr, fq); S.done(cur); }
        if (!has_next) break;
#pragma unroll
        for (int a = 0; a < 2; ++a)
#pragma unroll
            for (int b = 0; b < 2; ++b)
#pragma unroll
                for (int m = 0; m < 4; ++m)
#pragma unroll
                    for (int n = 0; n < 2; ++n) acc[a][b][m][n] = (f32x4){0.f, 0.f, 0.f, 0.f};
        cur = nxt; cA = nA; cB = nB; ++ui;
        if constexpr (ALIGN_EPI) { if (wr == 1) PG8_BAR; }
    }
    PG8_WAIT_V(0);
    if constexpr (!ALIGN_EPI) { if (wr == 0) PG8_BAR; }
    PG8_BAR;
    if constexpr (Epi::AFTER_DRAIN) { E.fused(acc, cur, wr, wc, fr, fq, lds, wid, lane); S.done(cur); }
#undef PG8_SA
#undef PG8_SB
#undef PG8_STAGE
#undef PG8_LDA
#undef PG8_LDB
#undef PG8_MMA
#undef PG8_WAIT_V
#undef PG8_WAIT_L
#undef PG8_BAR
#undef PG8_SCHED
}
}
namespace cf {
constexpr int D = 1024, NB = 4, SEQ = 4096, M = NB * SEQ;
constexpr int DFF = 2816, NSHIFT = 3328;
constexpr float ALPHA = 1.41421356237309515f;
constexpr float LN_EPS = 1e-5f, GN_EPS = 64e-5f;
constexpr size_t MiB = 1u << 20;
}
typedef unsigned short bf16_t;
typedef float f32x4 __attribute__((ext_vector_type(4)));
typedef unsigned u32x4 __attribute__((ext_vector_type(4)));
typedef unsigned u32x2 __attribute__((ext_vector_type(2)));

__device__ __forceinline__ unsigned f2bf(float f) { return pg8::cvt_pk_bf16(f, 0.f) & 0xffffu; }
__device__ __forceinline__ unsigned pk2(float lo, float hi) { return pg8::cvt_pk_bf16(lo, hi); }
__device__ __forceinline__ float bf2f(unsigned short b) { return __builtin_bit_cast(float, ((unsigned)b) << 16); }
__device__ __forceinline__ float bflo(unsigned w) { return __builtin_bit_cast(float, w << 16); }
__device__ __forceinline__ float bfhi(unsigned w) { return __builtin_bit_cast(float, w & 0xffff0000u); }
__device__ __forceinline__ float rcpf_(float x) { return __builtin_amdgcn_rcpf(x); }
__device__ __forceinline__ float sigmoidf_(float x) { return rcpf_(1.0f + __expf(-x)); }
__device__ __forceinline__ float tanhf_(float x) { const float e = __expf(2.0f * x); return 1.0f - 2.0f * rcpf_(e + 1.0f); }
__device__ __forceinline__ float gelu_tanh(float x) { const float u = 0.7978845608028654f * (x + 0.044715f * x * x * x); return 0.5f * x * (1.0f + tanhf_(u)); }
__device__ __forceinline__ float silu_(float x) { return x * rcpf_(1.0f + __expf(-x)); }
template <int CTRL> __device__ __forceinline__ float dpp_mov(float v) { return __builtin_bit_cast(float, __builtin_amdgcn_update_dpp(0, __builtin_bit_cast(int, v), CTRL, 0xf, 0xf, true)); }
__device__ __forceinline__ float sum_quad(float v) { v += dpp_mov<0xB1>(v); v += dpp_mov<0x4E>(v); return v; }
__device__ __forceinline__ float sum_oct(float v) { v = sum_quad(v); v += dpp_mov<0x141>(v); return v; }
__device__ __forceinline__ float sum_row16(float v) { v = sum_oct(v); v += dpp_mov<0x140>(v); return v; }
__device__ __forceinline__ float readlane_f(float v, int l) { return __builtin_bit_cast(float, __builtin_amdgcn_readlane(__builtin_bit_cast(int, v), l)); }
__device__ __forceinline__ float wave_sum(float v) { v = sum_row16(v); return (readlane_f(v, 0) + readlane_f(v, 16)) + (readlane_f(v, 32) + readlane_f(v, 48)); }
__device__ __forceinline__ float wave_max(float v) {
#pragma unroll
    for (int o = 1; o < 64; o <<= 1) v = fmaxf(v, __shfl_xor(v, o));
    return v;
}

namespace pg8 {
struct EpiIn {
    static constexpr bool PERM = true, AFTER_DRAIN = false;
    bf16_t *XA, *GA, *Q, *K, *V, *ZC, *ZV1; const float* cs;
    __device__ __forceinline__ void operator()(const f32x4 (&acc)[2][2][4][2], const Unit& u, int wr, int wc, int fr, int fq) const {
        const int pn = u.pn; bf16_t* dst; int ldc, colt, mode;
        if (pn < 4) { dst = XA; ldc = 1024; colt = pn * 256; mode = 0; }
        else if (pn < 8) { dst = GA; ldc = 1024; colt = (pn - 4) * 256; mode = 1; }
        else if (pn < 11) { dst = Q; ldc = 768; colt = (pn - 8) * 256; mode = 2; }
        else if (pn < 14) { dst = K; ldc = 768; colt = (pn - 11) * 256; mode = 3; }
        else if (pn < 17) { dst = V; ldc = 768; colt = (pn - 14) * 256; mode = 5; }
        else if (pn < 30) { dst = ZC; ldc = 3328; colt = (pn - 17) * 256; mode = 0; }
        else { dst = ZV1; ldc = 32; colt = 0; mode = 4; }
        const int row0 = u.pm * BM + wr * 64 + fr;
        const bool rot = (mode == 2 || mode == 3) && ((wc & 1) == 0);
        const float sgn = (fq == 0) ? -1.0f : 1.0f; const bool rl = fq < 2;
#pragma unroll
        for (int ai = 0; ai < 2; ++ai)
#pragma unroll
            for (int m = 0; m < 4; ++m) {
                const int row = row0 + ai * HALF + m * 16;
                f32x4 c0 = {1.f, 1.f, 1.f, 1.f}, c1 = c0, s0 = {0.f, 0.f, 0.f, 0.f}, s1 = s0;
                if (rot) { const f32x4* p = (const f32x4*)(cs + (size_t)row * 16); c0 = p[0]; c1 = p[1]; s0 = p[2]; s1 = p[3]; }
#pragma unroll
                for (int bj = 0; bj < 2; ++bj) {
                    f32x4 v0 = acc[ai][bj][m][0], v1 = acc[ai][bj][m][1];
                    if (mode == 1) {
#pragma unroll
                        for (int j = 0; j < 4; ++j) { v0[j] = gelu_tanh(v0[j]); v1[j] = gelu_tanh(v1[j]); }
                    }
                    if (rot) {
                        f32x4 p0, p1;
#pragma unroll
                        for (int j = 0; j < 4; ++j) { p0[j] = __shfl_xor(v0[j], 16); p1[j] = __shfl_xor(v1[j], 16); }
                        if (rl) { v0 = v0 * c0 + (p0 * s0) * sgn; v1 = v1 * c1 + (p1 * s1) * sgn; }
                    }
                    if (mode == 2) { v0 = v0 * 0.125f; v1 = v1 * 0.125f; }
                    u32x4 w; w.x = cvt_pk_bf16(v0[0], v0[1]); w.y = cvt_pk_bf16(v0[2], v0[3]); w.z = cvt_pk_bf16(v1[0], v1[1]); w.w = cvt_pk_bf16(v1[2], v1[3]);
                    const int col = colt + bj * HALF + wc * 32 + 8 * fq;
                    if (mode == 5) {
                        const int head = col >> 6, dim0 = col & 63, lg = (head >> 2) * 2, bb = row >> 12, ss = row & 4095;
                        const int perm = ((ss & ((1 << lg) - 1)) << (12 - lg)) + (ss >> lg);
                        bf16_t* vp = dst + ((size_t)(bb * 12 + head) * 64 + dim0) * 4096 + perm;
                        vp[0] = (bf16_t)(w.x & 0xffffu); vp[4096] = (bf16_t)(w.x >> 16); vp[2 * 4096] = (bf16_t)(w.y & 0xffffu); vp[3 * 4096] = (bf16_t)(w.y >> 16);
                        vp[4 * 4096] = (bf16_t)(w.z & 0xffffu); vp[5 * 4096] = (bf16_t)(w.z >> 16); vp[6 * 4096] = (bf16_t)(w.w & 0xffffu); vp[7 * 4096] = (bf16_t)(w.w >> 16);
                    } else if (mode != 4 || (bj == 0 && wc == 0)) *(u32x4*)(dst + (size_t)row * ldc + col) = w;
                }
            }
    }
};
template <int ACT  > struct EpiBf16 {
    static constexpr bool PERM = true, AFTER_DRAIN = false;
    bf16_t* O; int ldc; int pad_;
    __device__ __forceinline__ void operator()(const f32x4 (&acc)[2][2][4][2], const Unit& u, int wr, int wc, int fr, int fq) const {
        const int row0 = u.pm * BM + wr * 64 + fr, col0 = u.pn * BM + wc * 32 + 8 * fq;
#pragma unroll
        for (int ai = 0; ai < 2; ++ai)
#pragma unroll
            for (int m = 0; m < 4; ++m) { bf16_t* rowp = O + (size_t)(row0 + ai * HALF + m * 16) * ldc + col0;
#pragma unroll
                for (int bj = 0; bj < 2; ++bj) { f32x4 v0 = acc[ai][bj][m][0], v1 = acc[ai][bj][m][1];
                    if (ACT == 1) {
#pragma unroll
                        for (int j = 0; j < 4; ++j) { v0[j] = sigmoidf_(v0[j]); v1[j] = sigmoidf_(v1[j]); }
                    }
                    u32x4 w; w.x = cvt_pk_bf16(v0[0], v0[1]); w.y = cvt_pk_bf16(v0[2], v0[3]); w.z = cvt_pk_bf16(v1[0], v1[1]); w.w = cvt_pk_bf16(v1[2], v1[3]);
                    *(u32x4*)(rowp + bj * HALF) = w; } }
    }
};
struct EpiF32 {
    static constexpr bool PERM = false, AFTER_DRAIN = false;
    float* C; int ldc; int pad_;
    __device__ __forceinline__ void operator()(const f32x4 (&acc)[2][2][4][2], const Unit& u, int wr, int wc, int fr, int fq) const {
        const int row0 = u.pm * BM + wr * 64 + fr, col0 = u.pn * BM + wc * 32 + 4 * fq;
#pragma unroll
        for (int ai = 0; ai < 2; ++ai)
#pragma unroll
            for (int m = 0; m < 4; ++m) { float* rowp = C + (size_t)(row0 + ai * HALF + m * 16) * ldc + col0;
#pragma unroll
                for (int bj = 0; bj < 2; ++bj)
#pragma unroll
                    for (int n = 0; n < 2; ++n) *(f32x4*)(rowp + bj * HALF + n * 16) = acc[ai][bj][m][n]; }
    }
};
template <int ADD> struct EpiMerge {
    static constexpr bool PERM = true, AFTER_DRAIN = false;
    bf16_t* MG; const bf16_t* GT; int ldc; int pad_;
    __device__ __forceinline__ void operator()(const f32x4 (&acc)[2][2][4][2], const Unit& u, int wr, int wc, int fr, int fq) const {
        const int row0 = u.pm * BM + wr * 64 + fr, col0 = u.pn * BM + wc * 32 + 8 * fq;
#pragma unroll
        for (int ai = 0; ai < 2; ++ai)
#pragma unroll
            for (int m = 0; m < 4; ++m) { const size_t off = (size_t)(row0 + ai * HALF + m * 16) * ldc + col0;
#pragma unroll
                for (int bj = 0; bj < 2; ++bj) { f32x4 v0 = acc[ai][bj][m][0], v1 = acc[ai][bj][m][1];
                    const u32x4 gw = *(const u32x4*)(GT + off + bj * HALF);
                    v0[0] *= bflo(gw.x); v0[1] *= bfhi(gw.x); v0[2] *= bflo(gw.y); v0[3] *= bfhi(gw.y);
                    v1[0] *= bflo(gw.z); v1[1] *= bfhi(gw.z); v1[2] *= bflo(gw.w); v1[3] *= bfhi(gw.w);
                    if (ADD) { const u32x4 mw = *(const u32x4*)(MG + off + bj * HALF);
                        v0[0] += bflo(mw.x); v0[1] += bfhi(mw.x); v0[2] += bflo(mw.y); v0[3] += bfhi(mw.y);
                        v1[0] += bflo(mw.z); v1[1] += bfhi(mw.z); v1[2] += bflo(mw.w); v1[3] += bfhi(mw.w); }
                    u32x4 w; w.x = cvt_pk_bf16(v0[0], v0[1]); w.y = cvt_pk_bf16(v0[2], v0[3]); w.z = cvt_pk_bf16(v1[0], v1[1]); w.w = cvt_pk_bf16(v1[2], v1[3]);
                    *(u32x4*)(MG + off + bj * HALF) = w; } }
    }
};
}

constexpr int GEMM_LDS = 147456;
template <class Epi> __global__ __launch_bounds__(512, 2) void k_gemm(pg8::Gemm g, Epi E) {
    extern __shared__ __attribute__((aligned(16))) unsigned char shm[];
    pg8::StaticOrder S; S.init(g.M, g.N, (int)gridDim.x, (int)blockIdx.x);
    pg8::gemm_phase<Epi, pg8::StaticOrder, true, true>((PG8_LAS unsigned char*)shm, g, S, E);
}
#define LAS __attribute__((address_space(3)))
#define XB_TMO      128
#define XB_XCNT(j)  (256  + 64 * (j))
#define XB_XSUB(j)  (1280 + 64 * (j))
#define XB_XGEN(j)  (2304 + 64 * (j))
#define XB_TOP      3328
#define XB_TOPGEN   3392
#define XCD_BAR_WORDS 3456
#define XB_SPIN_CAP (1u << 18)
__device__ __forceinline__ unsigned xb_ld(unsigned* p)              { return __hip_atomic_load(p, __ATOMIC_RELAXED, __HIP_MEMORY_SCOPE_AGENT); }
__device__ __forceinline__ unsigned xb_add(unsigned* p, unsigned v) { return __hip_atomic_fetch_add(p, v, __ATOMIC_RELAXED, __HIP_MEMORY_SCOPE_AGENT); }
__device__ __forceinline__ unsigned xb_xcc_id() { return (unsigned)__builtin_amdgcn_s_getreg((3 << 11) | 20) & 0xFu; }
#define XB_SPIN(cond, bar) do { unsigned _sp = 0; while (cond) { __builtin_amdgcn_s_sleep(1); \
    if ((++_sp & 255u) == 0u) { if (xb_ld(&(bar)[XB_TMO])) break; if (_sp > XB_SPIN_CAP) { atomicAdd(&(bar)[XB_TMO], 1u); break; } } } } while (0)
struct XcdBarrier { unsigned* bar; unsigned x; volatile LAS unsigned* st; };
__device__ __forceinline__ XcdBarrier xcd_barrier_post(unsigned* bar, volatile LAS unsigned* st) {
    XcdBarrier b; b.bar = bar; b.x = xb_xcc_id(); b.st = st;
    if (threadIdx.x == 0) (void)xb_add(&bar[XB_XCNT(b.x)], 1u);
    return b;
}
__device__ __forceinline__ void xcd_barrier_complete(unsigned* bar, unsigned x, unsigned& nloc, unsigned& nx) {
    const unsigned G = gridDim.x * gridDim.y * gridDim.z;
    unsigned sum, cnt, mine, sp = 0u;
    for (;;) {
        sum = 0u; cnt = 0u; mine = 0u;
#pragma unroll
        for (unsigned j = 0; j < 16; ++j) { const unsigned c = xb_ld(&bar[XB_XCNT(j)]); sum += c; cnt += (c > 0u) ? 1u : 0u; mine = (j == x) ? c : mine; }
        if (sum == G) break;
        __builtin_amdgcn_s_sleep(1);
        if ((++sp & 255u) == 0u) { if (xb_ld(&bar[XB_TMO])) break; if (sp > XB_SPIN_CAP) { atomicAdd(&bar[XB_TMO], 1u); break; } }
    }
    nloc = mine > 0u ? mine : 1u; nx = cnt > 0u ? cnt : 1u;
}
__device__ __forceinline__ void xcd_barrier(const XcdBarrier& b) {
    asm volatile("s_waitcnt vmcnt(0)" ::: "memory");
    __syncthreads();
    if (threadIdx.x == 0) {
        unsigned* bar = b.bar;
        __builtin_amdgcn_s_waitcnt(0);
        unsigned nloc = b.st[0], nx = b.st[1];
        if (nloc == 0u) { xcd_barrier_complete(bar, b.x, nloc, nx); b.st[0] = nloc; b.st[1] = nx; }
        const unsigned old = xb_add(&bar[XB_XSUB(b.x)], 1u);
        const unsigned gen = old / nloc;
        if (old + 1u == (gen + 1u) * nloc) {
            __builtin_amdgcn_fence(__ATOMIC_RELEASE, "agent");
            asm volatile("s_waitcnt vmcnt(0)" ::: "memory");
            const unsigned og = xb_add(&bar[XB_TOP], 1u);
            const unsigned tg = og / nx;
            if (og + 1u == (tg + 1u) * nx) xb_add(&bar[XB_TOPGEN], 1u);
            else XB_SPIN(xb_ld(&bar[XB_TOPGEN]) == tg, bar);
            __builtin_amdgcn_fence(__ATOMIC_ACQUIRE, "agent");
            xb_add(&bar[XB_XGEN(b.x)], 1u);
            asm volatile("s_waitcnt vmcnt(0)" ::: "memory");
        } else {
            XB_SPIN(xb_ld(&bar[XB_XGEN(b.x)]) == gen, bar);
            __builtin_amdgcn_fence(__ATOMIC_ACQUIRE, "agent");
            asm volatile("s_waitcnt vmcnt(0)" ::: "memory");
        }
    }
    __syncthreads();
}
#define LDSF(off) ((float*)(lds + (off)))
typedef short bf16x8_t __attribute__((ext_vector_type(8)));
__device__ __forceinline__ int opaque_tid() { int t = threadIdx.x; asm volatile("" : "+v"(t)); return t; }
__device__ __forceinline__ void ph_mod(unsigned char* lds, const float* __restrict__ c, const float* __restrict__ mod_w, const float* __restrict__ mod_b, float* __restrict__ mod) {
    float* sc = LDSF(0); float* red = LDSF(16384);
    const int tid = opaque_tid(), col = tid & 63, ks = tid >> 6;
    for (int i = tid; i < 4096; i += 512) sc[i] = silu_(c[i]);
    __syncthreads();
    for (int it = blockIdx.x; it < 192; it += gridDim.x) {
        const int l = it / 96, n = (it % 96) * 64 + col;
        const float* W = mod_w + (size_t)l * 1024 * 6144 + n;
        float a0 = 0.f, a1 = 0.f, a2 = 0.f, a3 = 0.f;
        for (int k = ks * 128; k < ks * 128 + 128; ++k) { const float w = W[(size_t)k * 6144]; a0 += sc[k] * w; a1 += sc[1024 + k] * w; a2 += sc[2048 + k] * w; a3 += sc[3072 + k] * w; }
        red[(ks * 4 + 0) * 64 + col] = a0; red[(ks * 4 + 1) * 64 + col] = a1; red[(ks * 4 + 2) * 64 + col] = a2; red[(ks * 4 + 3) * 64 + col] = a3;
        __syncthreads();
        if (tid < 256) { const int b = tid >> 6; float s = mod_b[l * 6144 + n];
#pragma unroll
            for (int q = 0; q < 8; ++q) s += red[(q * 4 + b) * 64 + col];
            mod[((size_t)l * 4 + b) * 6144 + n] = s; }
        __syncthreads();
    }
}
__device__ __forceinline__ void ph_rope(const int* __restrict__ pos, float* __restrict__ cs) {
    for (int e = blockIdx.x * 512 + opaque_tid(); e < cf::M * 8; e += gridDim.x * 512) {
        const int m = e >> 3, i = e & 7;
        const float inv = powf(500000.0f, -(float)i / 8.0f);
        const float ang = (float)pos[m] * inv;
        cs[m * 16 + i] = cosf(ang); cs[m * 16 + 8 + i] = sinf(ang); }
}
__device__ __forceinline__ void ph_transpose(unsigned char* lds, const float* __restrict__ W, int K, int Nsrc, int c0, int nc, bf16_t* __restrict__ WT, int r0) {
    const int tid_ = opaque_tid(); const int lane = tid_ & 63, wave = tid_ >> 6;
    float* scr = LDSF(wave * 64 * 33 * 4);
    const int nblk = nc / 32, nitems = (K / 64) * nblk;
    for (int item = blockIdx.x * 8 + wave; item < nitems; item += gridDim.x * 8) {
        const int kb = item / nblk, nb = item % nblk, k0 = 64 * kb, n0 = 32 * nb;
#pragma unroll 8
        for (int i = 0; i < 32; ++i) { const int kk = 2 * i + (lane >> 5); scr[kk * 33 + (lane & 31)] = W[(size_t)(k0 + kk) * Nsrc + c0 + n0 + (lane & 31)]; }
        __builtin_amdgcn_wave_barrier(); asm volatile("s_waitcnt lgkmcnt(0)" ::: "memory");
        const int c = lane & 7;
#pragma unroll
        for (int j = 0; j < 4; ++j) { const int n = (lane >> 3) + 8 * j; const float* s = scr + (8 * c) * 33 + n;
            u32x4 o; o.x = pk2(s[0 * 33], s[1 * 33]); o.y = pk2(s[2 * 33], s[3 * 33]); o.z = pk2(s[4 * 33], s[5 * 33]); o.w = pk2(s[6 * 33], s[7 * 33]);
            *(u32x4*)(WT + (size_t)(r0 + n0 + n) * K + k0 + 8 * c) = o; }
        __builtin_amdgcn_wave_barrier(); asm volatile("s_waitcnt lgkmcnt(0)" ::: "memory");
    }
}
__device__ __forceinline__ void ph_zero16(u32x4* p, size_t n16) { for (size_t i = (size_t)blockIdx.x * 512 + opaque_tid(); i < n16; i += (size_t)gridDim.x * 512) p[i] = (u32x4){0u, 0u, 0u, 0u}; }
__device__ __forceinline__ void ph_modulate(const float* __restrict__ x, const float* __restrict__ modl, int sh_off, int sc_off, bf16_t* __restrict__ h) {
    for (size_t e4 = (size_t)blockIdx.x * 512 + opaque_tid(); e4 < (size_t)cf::M * 256; e4 += (size_t)gridDim.x * 512) {
        const int m = (int)(e4 >> 8), c = (int)(e4 & 255) * 4, b = m / cf::SEQ;
        const f32x4 xv = *(const f32x4*)(x + (size_t)m * 1024 + c);
        const f32x4 sh = *(const f32x4*)(modl + b * 6144 + sh_off + c), sc = *(const f32x4*)(modl + b * 6144 + sc_off + c);
        const f32x4 o = xv * (sc + 1.0f) + sh;
        u32x2 w; w.x = pk2(o[0], o[1]); w.y = pk2(o[2], o[3]);
        *(u32x2*)(h + (size_t)m * 1024 + c) = w; }
}
__device__ __forceinline__ void ph_ln(const float* __restrict__ xin, const float* __restrict__ y, int m0, int nrows, const float* __restrict__ modl, int gt_off,
                                      const float* __restrict__ lw, const float* __restrict__ lb, float* __restrict__ xo,
                                      const float* __restrict__ modn, int shn_off, int scn_off, bf16_t* __restrict__ hn) {
    const int tid_ = opaque_tid(); const int lane = tid_ & 63;
    for (int r = (blockIdx.x * 8 + (tid_ >> 6)) * 2; r < nrows; r += gridDim.x * 16) {
        f32x4 v[2][4]; float s[2] = {0.f, 0.f};
#pragma unroll
        for (int u = 0; u < 2; ++u) { const int m = m0 + r + u, b = m / cf::SEQ;
#pragma unroll
            for (int j = 0; j < 4; ++j) { const int c = 4 * lane + 256 * j;
                const f32x4 xv = *(const f32x4*)(xin + (size_t)m * 1024 + c), yv = *(const f32x4*)(y + (size_t)(r + u) * 1024 + c), g = *(const f32x4*)(modl + b * 6144 + gt_off + c);
                v[u][j] = xv * cf::ALPHA + (g + 1.0f) * yv; s[u] += (v[u][j][0] + v[u][j][1]) + (v[u][j][2] + v[u][j][3]); } }
#pragma unroll
        for (int u = 0; u < 2; ++u) { const int m = m0 + r + u, b = m / cf::SEQ;
            const float mean = wave_sum(s[u]) * (1.f / 1024.f); float s2 = 0.f;
#pragma unroll
            for (int j = 0; j < 4; ++j) { v[u][j] = v[u][j] - mean; s2 += (v[u][j][0] * v[u][j][0] + v[u][j][1] * v[u][j][1]) + (v[u][j][2] * v[u][j][2] + v[u][j][3] * v[u][j][3]); }
            const float rstd = rsqrtf(wave_sum(s2) * (1.f / 1024.f) + cf::LN_EPS);
#pragma unroll
            for (int j = 0; j < 4; ++j) { const int c = 4 * lane + 256 * j;
                const f32x4 o = v[u][j] * rstd * *(const f32x4*)(lw + c) + *(const f32x4*)(lb + c);
                *(f32x4*)(xo + (size_t)m * 1024 + c) = o;
                if (hn) { const f32x4 sh = *(const f32x4*)(modn + b * 6144 + shn_off + c), sc = *(const f32x4*)(modn + b * 6144 + scn_off + c);
                    const f32x4 hv = o * (sc + 1.0f) + sh; u32x2 w; w.x = pk2(hv[0], hv[1]); w.y = pk2(hv[2], hv[3]); *(u32x2*)(hn + (size_t)m * 1024 + c) = w; } } }
    }
}
__device__ __forceinline__ void ph_convglu(const bf16_t* __restrict__ U, int nrows, const float* __restrict__ cw, const float* __restrict__ cb, bf16_t* __restrict__ S) {
    const int nitems = (nrows / 16) * 704;
    for (int item = blockIdx.x * 512 + opaque_tid(); item < nitems; item += gridDim.x * 512) {
        const int rb = item / 704, c = (item - rb * 704) * 4, r0 = rb * 16; const bool seq0 = (r0 % cf::SEQ) == 0;
        u32x2 ug[18], uv[18];
#pragma unroll
        for (int j = 0; j < 18; ++j) { const int r = r0 - 2 + j;
            if (j >= 2 || !seq0) { ug[j] = *(const u32x2*)(U + (size_t)r * 5632 + c); uv[j] = *(const u32x2*)(U + (size_t)r * 5632 + 2816 + c); }
            else { ug[j] = (u32x2){0u, 0u}; uv[j] = ug[j]; } }
        f32x4 wg[3], wv[3];
#pragma unroll
        for (int j = 0; j < 3; ++j) { wg[j] = *(const f32x4*)(cw + j * 5632 + c); wv[j] = *(const f32x4*)(cw + j * 5632 + 2816 + c); }
        const f32x4 bg = *(const f32x4*)(cb + c), bv = *(const f32x4*)(cb + 2816 + c);
#pragma unroll
        for (int j = 0; j < 16; ++j) { f32x4 g = bg, v = bv;
#pragma unroll
            for (int q = 0; q < 3; ++q) { const u32x2 a = ug[j + 2 - q], d = uv[j + 2 - q];
                g[0] += wg[q][0] * bflo(a.x); g[1] += wg[q][1] * bfhi(a.x); g[2] += wg[q][2] * bflo(a.y); g[3] += wg[q][3] * bfhi(a.y);
                v[0] += wv[q][0] * bflo(d.x); v[1] += wv[q][1] * bfhi(d.x); v[2] += wv[q][2] * bflo(d.y); v[3] += wv[q][3] * bfhi(d.y); }
            u32x2 w; w.x = pk2(silu_(g[0]) * v[0], silu_(g[1]) * v[1]); w.y = pk2(silu_(g[2]) * v[2], silu_(g[3]) * v[3]);
            *(u32x2*)(S + (size_t)(r0 + j) * 2816 + c) = w; }
    }
}

struct LruArgs { const bf16_t* XA; bf16_t* GA  ; const float *cw, *cb, *wa, *ba, *wx, *bx, *lam; };
namespace lr {
constexpr int O_RX = 0;
constexpr int O_RG = 8704;
constexpr int O_XC = O_RG + 8192;
constexpr int O_XB = O_XC + 16384;
constexpr int O_A = O_XB + 9216;
constexpr int O_B = O_A + 16384;
constexpr int O_SUM = O_B + 16384;
constexpr int O_HS = O_SUM + 4096;
constexpr int O_END = O_HS + 256;
}
__device__ __forceinline__ void ph_lru_item(unsigned char* lds, const LruArgs& a, int item) {
    using namespace lr;
    bf16_t* RX = (bf16_t*)(lds + O_RX); bf16_t* RG = (bf16_t*)(lds + O_RG); float* XC = LDSF(O_XC); bf16_t* XB = (bf16_t*)(lds + O_XB); float* Aa = LDSF(O_A); float* Bb = LDSF(O_B); float* SUM = LDSF(O_SUM); float* HS = LDSF(O_HS);
    const int b = item >> 4, g = item & 15, tid0 = opaque_tid();
    bf16x8_t fr_[2][2], fi_[2][2];
    float c8v[2], bav[2], bxv[2];
    float cbv, cwv[4];
    { const int tid = tid0, lane = tid & 63, wv = tid >> 6, l15 = lane & 15, q4 = lane >> 4, hh = wv >> 2;
      bf16_t* T = (bf16_t*)(lds + O_A);
      for (int e = tid; e < 64 * 64; e += 512) { const int i = e >> 6, c = e & 63; T[c * 72 + i] = (bf16_t)f2bf(a.wa[(size_t)g * 4096 + e]); T[64 * 72 + c * 72 + i] = (bf16_t)f2bf(a.wx[(size_t)g * 4096 + e]); }
      if (tid < 64) HS[tid] = 0.f;
      __syncthreads();
#pragma unroll
      for (int nn = 0; nn < 2; ++nn) { const int cl = 32 * hh + 16 * nn + l15, gc = g * 64 + cl;
#pragma unroll
          for (int ks = 0; ks < 2; ++ks) { fr_[nn][ks] = *(const bf16x8_t*)(T + cl * 72 + 8 * q4 + 32 * ks); fi_[nn][ks] = *(const bf16x8_t*)(T + 64 * 72 + cl * 72 + 8 * q4 + 32 * ks); }
          const float lamv = a.lam[gc]; c8v[nn] = 8.0f * (fmaxf(-lamv, 0.f) + log1pf(expf(-fabsf(lamv)))); bav[nn] = a.ba[gc]; bxv[nn] = a.bx[gc]; }
      cbv = a.cb[g * 64 + lane];
#pragma unroll
      for (int q = 0; q < 4; ++q) cwv[q] = a.cw[q * 1024 + g * 64 + lane];
      __syncthreads(); }
    u32x4 pre[3];
    auto issue = [&](int s0, int tid) {
#pragma unroll
        for (int q = 0; q < 3; ++q) { const int pc = tid + 512 * q; u32x4 v = (u32x4){0u, 0u, 0u, 0u};
            if (pc < 536) { const int rw = pc >> 3, s = s0 - 3 + rw; if (s >= 0) v = *(const u32x4*)(a.XA + ((size_t)b * cf::SEQ + s) * 1024 + g * 64 + (pc & 7) * 8); }
            else if (pc < 1048) { const int p2 = pc - 536; v = *(const u32x4*)(a.GA + ((size_t)b * cf::SEQ + s0 + (p2 >> 3)) * 1024 + g * 64 + (p2 & 7) * 8); }
            pre[q] = v; }
    };
    auto commit = [&](int tid) {
#pragma unroll
        for (int q = 0; q < 3; ++q) { const int pc = tid + 512 * q;
            if (pc < 536) *(u32x4*)(RX + pc * 8) = pre[q]; else if (pc < 1048) *(u32x4*)(RG + (pc - 536) * 8) = pre[q]; }
    };
    issue(0, tid0); commit(tid0);
    __syncthreads();
#pragma unroll 1
    for (int ch = 0; ch < cf::SEQ / 64; ++ch) {
        const int s0 = ch * 64; const size_t m0 = (size_t)b * cf::SEQ + s0;
        int tid = tid0; asm volatile("" : "+v"(tid));
        const int lane = tid & 63, wv = tid >> 6, l15 = lane & 15, q4 = lane >> 4, mt = wv & 3, hh = wv >> 2;
        if (ch + 1 < cf::SEQ / 64) issue(s0 + 64, tid);
        { float xw[11];
#pragma unroll
          for (int q = 0; q < 11; ++q) xw[q] = bf2f(RX[(8 * wv + q) * 64 + lane]);
#pragma unroll
          for (int q = 0; q < 8; ++q) { const int tt = 8 * wv + q; const float xcv = cbv + cwv[0] * xw[q + 3] + cwv[1] * xw[q + 2] + cwv[2] * xw[q + 1] + cwv[3] * xw[q];
              XC[tt * 64 + lane] = xcv; XB[tt * 72 + lane] = (bf16_t)f2bf(xcv); } }
        __syncthreads();
        { const bf16x8_t xa0 = *(const bf16x8_t*)(XB + (16 * mt + l15) * 72 + 8 * q4), xa1 = *(const bf16x8_t*)(XB + (16 * mt + l15) * 72 + 8 * q4 + 32);
#pragma unroll
          for (int nn = 0; nn < 2; ++nn) { f32x4 cr = (f32x4){0.f, 0.f, 0.f, 0.f}, ci = cr;
              cr = __builtin_amdgcn_mfma_f32_16x16x32_bf16(xa0, fr_[nn][0], cr, 0, 0, 0); cr = __builtin_amdgcn_mfma_f32_16x16x32_bf16(xa1, fr_[nn][1], cr, 0, 0, 0);
              ci = __builtin_amdgcn_mfma_f32_16x16x32_bf16(xa0, fi_[nn][0], ci, 0, 0, 0); ci = __builtin_amdgcn_mfma_f32_16x16x32_bf16(xa1, fi_[nn][1], ci, 0, 0, 0);
              const int cl = 32 * hh + 16 * nn + l15;
#pragma unroll
              for (int j = 0; j < 4; ++j) { const int e = (16 * mt + 4 * q4 + j) * 64 + cl;
                  const float r = sigmoidf_(cr[j] + bav[nn]), ig = sigmoidf_(ci[j] + bxv[nn]), av = __expf(-c8v[nn] * r);
                  Aa[e] = av; Bb[e] = __builtin_amdgcn_sqrtf(fmaxf(1.0f - av * av, 0.f)) * (ig * XC[e]); } } }
        __syncthreads();
        { float hl[8], pp[8]; float h = 0.f, pr = 1.f;
#pragma unroll
          for (int q = 0; q < 8; ++q) { const int e = (8 * wv + q) * 64 + lane; const float av = Aa[e]; h = av * h + Bb[e]; pr *= av; hl[q] = h; pp[q] = pr; }
          SUM[(wv * 2 + 0) * 64 + lane] = pr; SUM[(wv * 2 + 1) * 64 + lane] = h;
          __syncthreads();
          float c = HS[lane];
          for (int w2 = 0; w2 < wv; ++w2) c = SUM[(w2 * 2 + 0) * 64 + lane] * c + SUM[(w2 * 2 + 1) * 64 + lane];
#pragma unroll
          for (int q = 0; q < 8; ++q) { const int tt = 8 * wv + q; const float hv = hl[q] + pp[q] * c;
              a.GA[(m0 + tt) * 1024 + g * 64 + lane] = (bf16_t)f2bf(hv * bf2f(RG[tt * 64 + lane])); }
          __syncthreads();
          if (wv == 7) HS[lane] = pr * c + h; }
        if (ch + 1 < cf::SEQ / 64) commit(tid);
        __syncthreads();
    }
}

__device__ __forceinline__ void ph_attn(const bf16_t* __restrict__ Q, const bf16_t* __restrict__ K, const bf16_t* __restrict__ VT, bf16_t* __restrict__ YB, int w0, int wstride) {
    const int tid_ = opaque_tid(); const int lane = tid_ & 63, l15 = lane & 15, q4 = lane >> 4;
    for (int w = w0; w < 4096; w += wstride) {
        const int r = w & 15, tile = (w >> 4) & 15, hs = (w >> 8) & 3, b = w >> 10, T0 = tile * 256;
        f32x4 O[4];
#pragma unroll
        for (int nt = 0; nt < 4; ++nt) O[nt] = (f32x4){0.f, 0.f, 0.f, 0.f};
        float m_used = -1e30f, l_part = 0.f;
#pragma unroll
        for (int g = 0; g < 3; ++g) {
            const int lg = 2 * g, d = 1 << lg, qs = 16 >> lg, ucls = 4096 >> lg, head = 4 * g + hs;
            const int c = r & (d - 1), u0 = (T0 + r - c) >> lg, uq = u0 + qs * l15;
            const bf16_t* qp = Q + (size_t)(b * 4096 + T0 + r + 16 * l15) * 768 + head * 64 + 8 * q4;
            const bf16x8_t bq0 = *(const bf16x8_t*)qp, bq1 = *(const bf16x8_t*)(qp + 32);
            const int ua = ((u0 - 128) >> 5) << 5, uend = u0 + 15 * qs, np = ((uend - ua) >> 5) + 1;
            const bf16_t* kbase = K + (size_t)b * 4096 * 768 + head * 64 + 8 * q4;
            const bf16_t* vbase = VT + ((size_t)(b * 12 + head) * 64 + l15) * 4096 + c * ucls;
            const int kidxA = 8 * (l15 >> 2) + (l15 & 3);
            for (int p = 0; p < np; ++p) {
                const int ub = ua + 32 * p;
                const int uA = min(max(ub + kidxA, 0), ucls - 1), uB = min(max(ub + kidxA + 4, 0), ucls - 1);
                const bf16_t* ka = kbase + (size_t)(c + d * uA) * 768; const bf16_t* kb = kbase + (size_t)(c + d * uB) * 768;
                const bf16x8_t a0 = *(const bf16x8_t*)ka, a1 = *(const bf16x8_t*)(ka + 32), b0 = *(const bf16x8_t*)kb, b1 = *(const bf16x8_t*)(kb + 32);
                const int uv = min(max(ub + 8 * q4, 0), ucls - 8);
                bf16x8_t vf[4];
#pragma unroll
                for (int nt = 0; nt < 4; ++nt) vf[nt] = *(const bf16x8_t*)(vbase + (size_t)nt * 16 * 4096 + uv);
                f32x4 sA = (f32x4){0.f, 0.f, 0.f, 0.f}, sB = sA;
                sA = __builtin_amdgcn_mfma_f32_16x16x32_bf16(a0, bq0, sA, 0, 0, 0); sA = __builtin_amdgcn_mfma_f32_16x16x32_bf16(a1, bq1, sA, 0, 0, 0);
                sB = __builtin_amdgcn_mfma_f32_16x16x32_bf16(b0, bq0, sB, 0, 0, 0); sB = __builtin_amdgcn_mfma_f32_16x16x32_bf16(b1, bq1, sB, 0, 0, 0);
                float s[8]; bool ok[8]; float pm = -1e30f;
#pragma unroll
                for (int j = 0; j < 8; ++j) { const int u = ub + 8 * q4 + j, dl = uq - u; ok[j] = (u >= 0) && (dl >= 0) && (dl <= 128); s[j] = ok[j] ? (j < 4 ? sA[j] : sB[j - 4]) : -1e30f; pm = fmaxf(pm, s[j]); }
                pm = fmaxf(pm, __shfl_xor(pm, 16)); pm = fmaxf(pm, __shfl_xor(pm, 32));
                if (__any(pm > m_used + 8.0f)) {
                    const float m_new = fmaxf(m_used, pm), alpha = __expf(m_used - m_new);
                    l_part *= alpha;
#pragma unroll
                    for (int j = 0; j < 4; ++j) { const float aB = __shfl(alpha, 4 * q4 + j);
#pragma unroll
                        for (int nt = 0; nt < 4; ++nt) O[nt][j] *= aB; }
                    m_used = m_new;
                }
                float pr[8];
#pragma unroll
                for (int j = 0; j < 8; ++j) { pr[j] = ok[j] ? __expf(s[j] - m_used) : 0.f; l_part += pr[j]; }
                u32x4 pw; pw.x = pg8::cvt_pk_bf16(pr[0], pr[1]); pw.y = pg8::cvt_pk_bf16(pr[2], pr[3]); pw.z = pg8::cvt_pk_bf16(pr[4], pr[5]); pw.w = pg8::cvt_pk_bf16(pr[6], pr[7]);
                const bf16x8_t pa = __builtin_bit_cast(bf16x8_t, pw);
#pragma unroll
                for (int nt = 0; nt < 4; ++nt) O[nt] = __builtin_amdgcn_mfma_f32_16x16x32_bf16(pa, vf[nt], O[nt], 0, 0, 0);
            }
        }
        float l = l_part; l += __shfl_xor(l, 16); l += __shfl_xor(l, 32);
#pragma unroll
        for (int j = 0; j < 4; ++j) { const float inv = rcpf_(__shfl(l, 4 * q4 + j));
            bf16_t* yp = YB + (size_t)(b * 4096 + T0 + r + 16 * (4 * q4 + j)) * 256 + hs * 64 + l15;
#pragma unroll
            for (int nt = 0; nt < 4; ++nt) yp[16 * nt] = (bf16_t)f2bf(O[nt][j] * inv); }
    }
}

struct WkvArgs {
    const bf16_t* ZC; const bf16_t* ZV1; bf16_t* VF; bf16_t* YC;
    const float *mu, *mu_v, *w0, *w2, *a0, *a2, *g2, *v0, *v2, *k_k, *k_a, *r_k, *lnw, *lnb;
    int layer; int ldy;
};
namespace wk {
constexpr int TC = 32;
constexpr int O_IR = 0, O_IK = 4224, O_IV = 8448, O_IL = 12672, O_IZ = O_IL + 16896, O_IF = O_IZ + 2112;
constexpr int O_R = 35904, O_W = O_R + 8192, O_KP = O_W + 8192, O_V = O_KP + 8192, O_KK = O_V + 8192, O_BB = O_KK + 8192, O_G = O_BB + 8192, O_Y = O_G + 8192;
static_assert(O_IF + 4224 == O_R, "wkv LDS map 0");
constexpr int O_LW = O_Y + 8192, O_LA = O_LW + 32 * 72 * 2, O_LG = O_LA + 32 * 72 * 2, O_LV = O_LG + 32 * 136 * 2, O_BD = O_LV + 32 * 40 * 2, O_END = O_BD + 4 * 32 * 4;
static_assert(O_END <= 131072, "wkv LDS map");
constexpr int O_PA = O_R;
constexpr int O_PB = O_PA + 9216;
constexpr int O_VT = O_PB + 9216;
static_assert(O_VT + 5120 <= O_V, "wkv LDS map 2");
constexpr int O_PBT = O_KK;
constexpr int O_AF = O_PBT + 9216;
constexpr int O_GAM = O_AF + 4224;
static_assert(O_GAM + 256 <= O_G, "wkv LDS map 3");
constexpr int O_AM = O_LW;
constexpr int O_TT = O_AM + 9216;
constexpr int O_TDT = O_TT + 2560;
constexpr int O_M1T = O_TDT + 1536;
constexpr int O_WS = O_M1T + 768;
static_assert(O_WS + 2048 <= O_BD, "wkv LDS map 4");
}
__device__ __forceinline__ bf16x8_t wk_perm(const unsigned char* p) { u32x4 w; const u32x2 lo = *(const u32x2*)p, hi = *(const u32x2*)(p + 32); w.x = lo.x; w.y = lo.y; w.z = hi.x; w.w = hi.y; return __builtin_bit_cast(bf16x8_t, w); }
__device__ __forceinline__ bf16x8_t wk_pack(const f32x4& x0, const f32x4& x1) { u32x4 w; w.x = pg8::cvt_pk_bf16(x0[0], x0[1]); w.y = pg8::cvt_pk_bf16(x0[2], x0[3]); w.z = pg8::cvt_pk_bf16(x1[0], x1[1]); w.w = pg8::cvt_pk_bf16(x1[2], x1[3]); return __builtin_bit_cast(bf16x8_t, w); }
#ifndef PROBE_ID
#define PROBE_ID 0
#endif
#define WREP(id) _Pragma("unroll 1") for (int wrep_ = 0; wrep_ < ((PROBE_ID == (id)) ? 3 : 1); ++wrep_)
__device__ __forceinline__ void ph_wkv_item(unsigned char* lds, const WkvArgs& a, int item) {
    using namespace wk;
    float* R = LDSF(O_R); float* Wd = LDSF(O_W); float* Kp = LDSF(O_KP); float* Vv = LDSF(O_V); float* KK = LDSF(O_KK); float* BB = LDSF(O_BB); float* G = LDSF(O_G); float* Y = LDSF(O_Y);
    bf16_t* LW = (bf16_t*)(lds + O_LW); bf16_t* LA = (bf16_t*)(lds + O_LA); bf16_t* LG = (bf16_t*)(lds + O_LG); bf16_t* LV = (bf16_t*)(lds + O_LV); float* BD = LDSF(O_BD);
    const int b = item >> 4, h = item & 15, tid0 = opaque_tid();
    const int layer = a.layer;
    float mu1[3][2], kkc[2], muL[5][2];
    float lnwv, lnbv;
    float w0v, a0v, kav, rkv, v0v;
    bf16x8_t fw[2], fa[2], fg[4], fv;
    { const int tid = tid0, lane = tid & 63, wv = tid >> 6, l15 = lane & 15, q4 = lane >> 4, nt = wv & 3, cp = lane & 31, hj = h * 64 + lane, hc = h * 64 + 16 * nt + l15;
#pragma unroll
      for (int x = 0; x < 2; ++x) { const int c = h * 64 + 2 * cp + x; mu1[0][x] = a.mu[c]; mu1[1][x] = a.mu[1024 + c]; mu1[2][x] = a.mu[2048 + c]; kkc[x] = a.k_k[c];
#pragma unroll
          for (int e = 0; e < 4; ++e) muL[e][x] = a.mu[3072 + 64 * e + 2 * cp + x];
          muL[4][x] = (layer && cp < 16) ? a.mu_v[2 * cp + x] : 0.f; }
      lnwv = a.lnw[hj]; lnbv = a.lnb[hj];
      w0v = a.w0[hc]; a0v = a.a0[hc]; kav = a.k_a[hc]; rkv = a.r_k[hc]; v0v = layer ? a.v0[hc] : 0.f;
      bf16_t* T = (bf16_t*)(lds + O_R);
      for (int e = tid; e < 64 * 64; e += 512) { const int i = e >> 6, c = e & 63; T[c * 72 + i] = (bf16_t)f2bf(a.w2[(size_t)i * 1024 + h * 64 + c]); T[64 * 72 + c * 72 + i] = (bf16_t)f2bf(a.a2[(size_t)i * 1024 + h * 64 + c]); }
      for (int e = tid; e < 128 * 64; e += 512) { const int i = e >> 6, c = e & 63; T[2 * 64 * 72 + c * 136 + i] = (bf16_t)f2bf(a.g2[(size_t)i * 1024 + h * 64 + c]); }
      if (layer) for (int e = tid; e < 32 * 64; e += 512) { const int i = e >> 6, c = e & 63; T[2 * 64 * 72 + 64 * 136 + c * 40 + i] = (bf16_t)f2bf(a.v2[(size_t)i * 1024 + h * 64 + c]); }
      __syncthreads();
      const int cl = 16 * nt + l15;
#pragma unroll
      for (int ks = 0; ks < 2; ++ks) { fw[ks] = *(const bf16x8_t*)(T + cl * 72 + 8 * q4 + 32 * ks); fa[ks] = *(const bf16x8_t*)(T + 64 * 72 + cl * 72 + 8 * q4 + 32 * ks); }
#pragma unroll
      for (int ks = 0; ks < 4; ++ks) fg[ks] = *(const bf16x8_t*)(T + 2 * 64 * 72 + cl * 136 + 8 * q4 + 32 * ks);
      fv = layer ? *(const bf16x8_t*)(T + 2 * 64 * 72 + 64 * 136 + cl * 40 + 8 * q4) : fw[0];
      __syncthreads(); }
    f32x4 Hs[4];
#pragma unroll
    for (int c = 0; c < 4; ++c) Hs[c] = (f32x4){0.f, 0.f, 0.f, 0.f};
    bf16x8_t hb0 = (bf16x8_t){0, 0, 0, 0, 0, 0, 0, 0}, hb1 = hb0;
    auto dma = [&](int s0, int tid) {
        const int ln = tid & 63, wvu = __builtin_amdgcn_readfirstlane(tid >> 6); const size_t mb = (size_t)b * cf::SEQ + s0;
#pragma unroll
        for (int q = 0; q < 5; ++q) { const int j = wvu + 8 * q; if (j >= 34) continue;
            const bf16_t* src; int dst; bool on = true;
            if (j < 16) { src = a.ZC + (mb + 2 * j + (ln >> 5)) * 3328 + 3072 + (ln & 31) * 8; dst = O_IL + j * 1024; }
            else if (j < 28) { const int kd = (j - 16) >> 2, jj = (j - 16) & 3; src = a.ZC + (mb + 8 * jj + (ln >> 3)) * 3328 + kd * 1024 + h * 64 + (ln & 7) * 8; dst = O_IR + kd * 4224 + jj * 1024; }
            else if (j < 32) { const int jj = j - 28; src = a.VF + (mb + 8 * jj + (ln >> 3)) * 1024 + h * 64 + (ln & 7) * 8; dst = O_IF + jj * 1024; on = layer != 0; }
            else { const int jj = j - 32; src = a.ZV1 + (mb + 16 * jj + (ln >> 2)) * 32 + (ln & 3) * 8; dst = O_IZ + jj * 1024; on = layer != 0; }
            if (on) __builtin_amdgcn_global_load_lds((const unsigned*)src, (LAS unsigned*)((LAS unsigned char*)lds + dst), 16, 0, 0); }
    };
    auto piece_off = [&](int pc, int rw) { return pc < 24 ? O_IR + (pc >> 3) * 4224 + rw * 128 + (pc & 7) * 16 : (pc < 56 ? O_IL + rw * 512 + (pc - 24) * 16 : (pc < 60 ? O_IZ + rw * 64 + (pc - 56) * 16 : O_IF + rw * 128 + (pc - 60) * 16)); };
#define WK_BAR() do { asm volatile("s_waitcnt lgkmcnt(0)" ::: "memory"); __builtin_amdgcn_s_barrier(); asm volatile("" ::: "memory"); } while (0)
    dma(0, tid0);
    if (tid0 < 68) *(u32x4*)(lds + piece_off(tid0, 32)) = (u32x4){0u, 0u, 0u, 0u};
    asm volatile("s_waitcnt vmcnt(0)" ::: "memory"); __syncthreads();
#pragma unroll 1
    for (int ch = 0; ch < cf::SEQ / TC; ++ch) {
        const int s0 = ch * TC; const size_t m0 = (size_t)b * cf::SEQ + s0;
        int tid = tid0; asm volatile("" : "+v"(tid));
        const int lane = tid & 63, wv = tid >> 6, l15 = lane & 15, q4 = lane >> 4, hj = h * 64 + lane, mt = wv >> 2, nt = wv & 3;
        WREP(11) { const int cp = lane & 31, th = lane >> 5;
          const unsigned* IRw = (const unsigned*)(lds + O_IR); const unsigned* IKw = (const unsigned*)(lds + O_IK); const unsigned* IVw = (const unsigned*)(lds + O_IV); const unsigned* ILw = (const unsigned*)(lds + O_IL); const unsigned* IZw = (const unsigned*)(lds + O_IZ);
#pragma unroll
          for (int it = 0; it < 2; ++it) { const int tt = 4 * wv + 2 * it + th, pr = tt ? tt - 1 : 32;
              const unsigned r1 = IRw[tt * 32 + cp], r0 = IRw[pr * 32 + cp], k1 = IKw[tt * 32 + cp], k0 = IKw[pr * 32 + cp], v1 = IVw[tt * 32 + cp], v0_ = IVw[pr * 32 + cp];
              const float rs0 = bflo(r1) + (bflo(r0) - bflo(r1)) * mu1[0][0], rs1 = bfhi(r1) + (bfhi(r0) - bfhi(r1)) * mu1[0][1];
              const float ks0 = bflo(k1) + (bflo(k0) - bflo(k1)) * mu1[1][0], ks1 = bfhi(k1) + (bfhi(k0) - bfhi(k1)) * mu1[1][1];
              const float vs0 = bflo(v1) + (bflo(v0_) - bflo(v1)) * mu1[2][0], vs1 = bfhi(v1) + (bfhi(v0_) - bfhi(v1)) * mu1[2][1];
              const float kq0 = ks0 * kkc[0], kq1 = ks1 * kkc[1];
              const float sr = sum_row16(kq0 * kq0 + kq1 * kq1);
              const float slo = readlane_f(sr, 0) + readlane_f(sr, 16), shi = readlane_f(sr, 32) + readlane_f(sr, 48);
              const float rn = rsqrtf((th ? shi : slo) + 1e-12f);
              typedef float f32x2_ __attribute__((ext_vector_type(2)));
              *(f32x2_*)(R + tt * 64 + 2 * cp) = (f32x2_){rs0, rs1}; *(f32x2_*)(Kp + tt * 64 + 2 * cp) = (f32x2_){ks0, ks1}; *(f32x2_*)(Vv + tt * 64 + 2 * cp) = (f32x2_){vs0, vs1}; *(f32x2_*)(KK + tt * 64 + 2 * cp) = (f32x2_){kq0 * rn, kq1 * rn};
              if (layer == 0) *(unsigned*)(a.VF + (m0 + tt) * 1024 + h * 64 + 2 * cp) = pk2(vs0, vs1);
              { unsigned z1 = ILw[tt * 128 + cp], z0 = ILw[pr * 128 + cp];
                ((unsigned*)LW)[tt * 36 + cp] = pk2(tanhf_(bflo(z1) + (bflo(z0) - bflo(z1)) * muL[0][0]), tanhf_(bfhi(z1) + (bfhi(z0) - bfhi(z1)) * muL[0][1]));
                z1 = ILw[tt * 128 + 32 + cp]; z0 = ILw[pr * 128 + 32 + cp];
                ((unsigned*)LA)[tt * 36 + cp] = pk2(bflo(z1) + (bflo(z0) - bflo(z1)) * muL[1][0], bfhi(z1) + (bfhi(z0) - bfhi(z1)) * muL[1][1]);
                z1 = ILw[tt * 128 + 64 + cp]; z0 = ILw[pr * 128 + 64 + cp];
                ((unsigned*)LG)[tt * 68 + cp] = pk2(sigmoidf_(bflo(z1) + (bflo(z0) - bflo(z1)) * muL[2][0]), sigmoidf_(bfhi(z1) + (bfhi(z0) - bfhi(z1)) * muL[2][1]));
                z1 = ILw[tt * 128 + 96 + cp]; z0 = ILw[pr * 128 + 96 + cp];
                ((unsigned*)LG)[tt * 68 + 32 + cp] = pk2(sigmoidf_(bflo(z1) + (bflo(z0) - bflo(z1)) * muL[3][0]), sigmoidf_(bfhi(z1) + (bfhi(z0) - bfhi(z1)) * muL[3][1]));
                if (layer && cp < 16) { z1 = IZw[tt * 16 + cp]; z0 = IZw[pr * 16 + cp];
                    ((unsigned*)LV)[tt * 20 + cp] = pk2(bflo(z1) + (bflo(z0) - bflo(z1)) * muL[4][0], bfhi(z1) + (bfhi(z0) - bfhi(z1)) * muL[4][1]); } } } }
        __syncthreads();
        {
            f32x4 cw = (f32x4){0.f, 0.f, 0.f, 0.f}, ca = cw, cgt = cw, cv = cw;
            const int arow = 16 * mt + l15;
#pragma unroll
            for (int ks = 0; ks < 2; ++ks) { const bf16x8_t xw = *(const bf16x8_t*)(LW + arow * 72 + 8 * q4 + 32 * ks), xa = *(const bf16x8_t*)(LA + arow * 72 + 8 * q4 + 32 * ks);
                cw = __builtin_amdgcn_mfma_f32_16x16x32_bf16(xw, fw[ks], cw, 0, 0, 0); ca = __builtin_amdgcn_mfma_f32_16x16x32_bf16(xa, fa[ks], ca, 0, 0, 0); }
#pragma unroll
            for (int ks = 0; ks < 4; ++ks) { const bf16x8_t xg = *(const bf16x8_t*)(LG + arow * 136 + 8 * q4 + 32 * ks); cgt = __builtin_amdgcn_mfma_f32_16x16x32_bf16(xg, fg[ks], cgt, 0, 0, 0); }
            if (layer) { bf16x8_t xv = *(const bf16x8_t*)(LV + arow * 40 + 8 * q4); cv = __builtin_amdgcn_mfma_f32_16x16x32_bf16(xv, fv, cv, 0, 0, 0); }
            const int chn = 16 * nt + l15; const bf16_t* IF = (const bf16_t*)(lds + O_IF);
#pragma unroll
            for (int j = 0; j < 4; ++j) { const int tt = 16 * mt + 4 * q4 + j, e = tt * 64 + chn;
                const float lwd = -0.60653065971f * sigmoidf_(w0v + cw[j]);
                const float av = sigmoidf_(a0v + ca[j]);
                const float rv = R[e], kr = Kp[e], vr = Vv[e];
                float v = vr;
                if (layer) { const float vf = bf2f(IF[tt * 64 + chn]); v = vr + (vf - vr) * sigmoidf_(v0v + cv[j]); }
                const float kp = kr * (1.0f + (av - 1.0f) * kav);
                const float bd = sum_row16(rv * kp * rkv);
                Wd[e] = lwd; Kp[e] = kp; Vv[e] = v; BB[e] = KK[e] * av; G[e] = cgt[j];
                if (l15 == 0) BD[nt * 32 + tt] = bd; }
        }
        __syncthreads();
        if (tid < 68) *(u32x4*)(lds + piece_off(tid, 32)) = *(const u32x4*)(lds + piece_off(tid, 31));
        { float rv[4], lwv[4], kpv[4], kkv4[4], bbv[4], vv4[4]; float* WS = LDSF(O_WS);
#pragma unroll
          for (int q = 0; q < 4; ++q) { const int e = (4 * wv + q) * 64 + lane; rv[q] = R[e]; lwv[q] = Wd[e]; kpv[q] = Kp[e]; kkv4[q] = KK[e]; bbv[q] = BB[e]; vv4[q] = Vv[e]; }
          WS[wv * 64 + lane] = (lwv[0] + lwv[1]) + (lwv[2] + lwv[3]);
          WK_BAR();
          if (ch + 1 < cf::SEQ / TC) dma(s0 + TC, tid);
          float cprev = 0.f;
#pragma unroll
          for (int w2 = 0; w2 < 7; ++w2) { const float x_ = WS[w2 * 64 + lane]; cprev += (w2 < wv) ? x_ : 0.f; }
          bf16_t* PA = (bf16_t*)(lds + O_PA); bf16_t* PB = (bf16_t*)(lds + O_PB); bf16_t* PBT = (bf16_t*)(lds + O_PBT); bf16_t* VTl = (bf16_t*)(lds + O_VT);
          float ep = __expf(cprev), cl = cprev; float bt4[4], kt4[4];
#pragma unroll
          for (int q = 0; q < 4; ++q) { const int t = 4 * wv + q; cl += lwv[q]; const float e = __expf(cl), ei = __expf(-cl);
              PA[t * 72 + lane] = (bf16_t)f2bf(kkv4[q] * ep); PA[(32 + t) * 72 + lane] = (bf16_t)f2bf(rv[q] * e);
              bt4[q] = bbv[q] * ei; kt4[q] = kpv[q] * ei;
              PB[t * 72 + lane] = (bf16_t)f2bf(bt4[q]); PB[(32 + t) * 72 + lane] = (bf16_t)f2bf(kt4[q]);
              ep = e; }
          u32x2 w; w.x = pk2(bt4[0], bt4[1]); w.y = pk2(bt4[2], bt4[3]); *(u32x2*)(PBT + lane * 72 + 4 * wv) = w;
          w.x = pk2(kt4[0], kt4[1]); w.y = pk2(kt4[2], kt4[3]); *(u32x2*)(PBT + lane * 72 + 32 + 4 * wv) = w;
          w.x = pk2(vv4[0], vv4[1]); w.y = pk2(vv4[2], vv4[3]); *(u32x2*)(VTl + lane * 40 + 4 * wv) = w;
          if (wv == 7) LDSF(O_GAM)[lane] = ep; }
        WK_BAR();
        WREP(12) { const bf16_t* PA = (const bf16_t*)(lds + O_PA); const bf16_t* PB = (const bf16_t*)(lds + O_PB); bf16_t* AM = (bf16_t*)(lds + O_AM); float* AF = LDSF(O_AF);
          const int mtile = wv >> 1;
          const bf16x8_t a0 = *(const bf16x8_t*)(PA + (16 * mtile + l15) * 72 + 8 * q4), a1 = *(const bf16x8_t*)(PA + (16 * mtile + l15) * 72 + 8 * q4 + 32);
#pragma unroll
          for (int nn = 0; nn < 2; ++nn) { const int ntile = 2 * (wv & 1) + nn;
              const bf16x8_t b0 = *(const bf16x8_t*)(PB + (16 * ntile + l15) * 72 + 8 * q4), b1 = *(const bf16x8_t*)(PB + (16 * ntile + l15) * 72 + 8 * q4 + 32);
              f32x4 c = (f32x4){0.f, 0.f, 0.f, 0.f};
              c = __builtin_amdgcn_mfma_f32_16x16x32_bf16(a0, b0, c, 0, 0, 0); c = __builtin_amdgcn_mfma_f32_16x16x32_bf16(a1, b1, c, 0, 0, 0);
              const int sg = 16 * ntile + l15, s_ = sg & 31;
#pragma unroll
              for (int j = 0; j < 4; ++j) { const int rho = 16 * mtile + 4 * q4 + j, t_ = rho & 31; const bool keep = (rho < 32) ? (t_ > s_) : (t_ >= s_); const float val = keep ? c[j] : 0.f;
                  AM[rho * 72 + sg] = (bf16_t)f2bf(val); if (rho < 32 && sg < 32) AF[rho * 33 + sg] = val; } } }
        WK_BAR();
        WREP(13) { bf16_t* TT = (bf16_t*)(lds + O_TT); bf16_t* TDT = (bf16_t*)(lds + O_TDT);
          if (wv < 2 && lane < 16) { const float* AF = LDSF(O_AF) + (16 * wv) * 33 + 16 * wv; float x[16];
#pragma unroll
              for (int t = 0; t < 16; ++t) { float acc = (t == lane) ? 1.f : 0.f;
#pragma unroll
                  for (int s = 0; s < 16; ++s) if (s < t) acc -= AF[t * 33 + s] * x[s];
                  x[t] = acc; }
#pragma unroll
              for (int t = 0; t < 16; ++t) TT[(16 * wv + t) * 40 + 16 * wv + lane] = (bf16_t)f2bf(x[t]);
              u32x4 w0_, w1_; w0_.x = pk2(x[0], x[1]); w0_.y = pk2(x[2], x[3]); w0_.z = pk2(x[4], x[5]); w0_.w = pk2(x[6], x[7]); w1_.x = pk2(x[8], x[9]); w1_.y = pk2(x[10], x[11]); w1_.z = pk2(x[12], x[13]); w1_.w = pk2(x[14], x[15]);
              *(u32x4*)(TDT + (wv * 16 + lane) * 24) = w0_; *(u32x4*)(TDT + (wv * 16 + lane) * 24 + 8) = w1_; }
          if (wv == 2 && lane < 32) { const int rw = lane >> 1; *(u32x4*)(TT + rw * 40 + 16 + 8 * (lane & 1)) = (u32x4){0u, 0u, 0u, 0u}; }
        }
        WK_BAR();
        WREP(14) if (wv == 0) { const bf16_t* AM = (const bf16_t*)(lds + O_AM); bf16_t* TT = (bf16_t*)(lds + O_TT); const bf16_t* TDT = (const bf16_t*)(lds + O_TDT); bf16_t* M1T = (bf16_t*)(lds + O_M1T);
            const bf16x8_t zf = (bf16x8_t){0, 0, 0, 0, 0, 0, 0, 0};
            bf16x8_t af = zf, bf = zf;
            if (q4 < 2) { af = *(const bf16x8_t*)(AM + (16 + l15) * 72 + 8 * q4); bf = *(const bf16x8_t*)(TDT + l15 * 24 + 8 * q4); }
            f32x4 c = (f32x4){0.f, 0.f, 0.f, 0.f};
            c = __builtin_amdgcn_mfma_f32_16x16x32_bf16(af, bf, c, 0, 0, 0);
            u32x2 w; w.x = pk2(c[0], c[1]); w.y = pk2(c[2], c[3]); *(u32x2*)(M1T + l15 * 24 + 4 * q4) = w;
            __builtin_amdgcn_wave_barrier(); asm volatile("s_waitcnt lgkmcnt(0)" ::: "memory");
            af = zf; bf = zf;
            if (q4 < 2) { af = *(const bf16x8_t*)(TT + (16 + l15) * 40 + 16 + 8 * q4); bf = *(const bf16x8_t*)(M1T + l15 * 24 + 8 * q4); }
            c = (f32x4){0.f, 0.f, 0.f, 0.f};
            c = __builtin_amdgcn_mfma_f32_16x16x32_bf16(af, bf, c, 0, 0, 0);
#pragma unroll
            for (int j = 0; j < 4; ++j) TT[(16 + 4 * q4 + j) * 40 + l15] = (bf16_t)f2bf(-c[j]); }
        WK_BAR();
        if (wv < 4) {
            const unsigned char* pPA = lds + O_PA + l15 * 144 + 8 * q4;   const unsigned char* nAM = lds + O_AM + l15 * 144 + 16 * q4 + 64;
            const unsigned char* pAM = lds + O_AM + l15 * 144 + 8 * q4;   const unsigned char* pTT = lds + O_TT + l15 * 80 + 8 * q4;
            const unsigned char* pPBT = lds + O_PBT + l15 * 144 + 8 * q4; const unsigned char* nPBT = lds + O_PBT + l15 * 144 + 16 * q4 + 64;
            const bf16x8_t vfrag = *(const bf16x8_t*)(lds + O_VT + (16 * wv + l15) * 80 + 16 * q4);
            f32x4 x1[2];
#pragma unroll
            for (int m2 = 0; m2 < 2; ++m2) { f32x4 c = (f32x4){0.f, 0.f, 0.f, 0.f};
                c = __builtin_amdgcn_mfma_f32_16x16x32_bf16(*(const bf16x8_t*)(nAM + m2 * 2304), vfrag, c, 0, 0, 0);
                c = __builtin_amdgcn_mfma_f32_16x16x32_bf16(wk_perm(pPA + m2 * 2304), hb0, c, 0, 0, 0);
                c = __builtin_amdgcn_mfma_f32_16x16x32_bf16(wk_perm(pPA + m2 * 2304 + 64), hb1, c, 0, 0, 0);
                x1[m2] = -c; }
            const bf16x8_t xb = wk_pack(x1[0], x1[1]);
            f32x4 uu[2];
#pragma unroll
            for (int m2 = 0; m2 < 2; ++m2) { f32x4 c = (f32x4){0.f, 0.f, 0.f, 0.f}; uu[m2] = __builtin_amdgcn_mfma_f32_16x16x32_bf16(wk_perm(pTT + m2 * 1280), xb, c, 0, 0, 0); }
            const bf16x8_t ub = wk_pack(uu[0], uu[1]);
#pragma unroll
            for (int m2 = 0; m2 < 2; ++m2) { f32x4 c = (f32x4){0.f, 0.f, 0.f, 0.f};
                c = __builtin_amdgcn_mfma_f32_16x16x32_bf16(*(const bf16x8_t*)(nAM + (2 + m2) * 2304), vfrag, c, 0, 0, 0);
                c = __builtin_amdgcn_mfma_f32_16x16x32_bf16(wk_perm(pPA + (2 + m2) * 2304), hb0, c, 0, 0, 0);
                c = __builtin_amdgcn_mfma_f32_16x16x32_bf16(wk_perm(pPA + (2 + m2) * 2304 + 64), hb1, c, 0, 0, 0);
                c = __builtin_amdgcn_mfma_f32_16x16x32_bf16(wk_perm(pAM + (2 + m2) * 2304), ub, c, 0, 0, 0);
#pragma unroll
                for (int j = 0; j < 4; ++j) Y[(16 * m2 + 4 * q4 + j) * 64 + 16 * wv + l15] = c[j]; }
#pragma unroll
            for (int jm = 0; jm < 4; ++jm) {
                Hs[jm] = __builtin_amdgcn_mfma_f32_16x16x32_bf16(*(const bf16x8_t*)(nPBT + jm * 2304), vfrag, Hs[jm], 0, 0, 0);
                Hs[jm] = __builtin_amdgcn_mfma_f32_16x16x32_bf16(wk_perm(pPBT + jm * 2304), ub, Hs[jm], 0, 0, 0);
                const f32x4 gm = *(const f32x4*)(LDSF(O_GAM) + 16 * jm + 4 * q4); Hs[jm] = Hs[jm] * gm; }
            hb0 = wk_pack(Hs[0], Hs[1]); hb1 = wk_pack(Hs[2], Hs[3]);
        }
        WK_BAR();
        WREP(15)
#pragma unroll
        for (int q = 0; q < 4; ++q) { const int tt = 4 * wv + q;
            const float y = Y[tt * 64 + lane]; const float mu = wave_sum(y) * (1.f / 64.f); const float d = y - mu; const float var = wave_sum(d * d) * (1.f / 64.f);
            const float bd = (BD[tt] + BD[32 + tt]) + (BD[64 + tt] + BD[96 + tt]);
            const float o = (d * rsqrtf(var + cf::GN_EPS) * lnwv + lnbv + bd * Vv[tt * 64 + lane]) * G[tt * 64 + lane];
            a.YC[(m0 + tt) * (size_t)a.ldy + hj] = (bf16_t)f2bf(o); }
        asm volatile("s_waitcnt vmcnt(0)" ::: "memory");
        WK_BAR();
    }
#undef WK_BAR
}
namespace wp {
constexpr int TC = 32;
constexpr int O_IR = 0, O_IK = 4224, O_IV = 8448, O_IL = 12672, O_IZ = O_IL + 16896, O_IF = O_IZ + 2112;
constexpr int O_R = 35904, O_W = O_R + 8192, O_KP = O_W + 8192, O_KK = O_KP + 8192, O_BB = O_KK + 8192, O_V = O_BB + 8192, O_G = O_V + 8192;
constexpr int O_LW = O_G + 8192, O_LA = O_LW + 32 * 72 * 2, O_LG = O_LA + 32 * 72 * 2, O_LV = O_LG + 32 * 136 * 2, O_BD = O_LW + 20480, O_END = O_BD + 512;
static_assert(O_LV + 32 * 40 * 2 <= O_BD && O_END <= 131072, "wkv prep LDS map");
constexpr int S_PA = 0, S_PBT = 9216, S_VT = 18432, S_GAM = 23552, S_GB = 23808, S_BDS = 27904, S_AM3 = 28032, S_TT = 34688, S_END = 37248, SLOT_BYTES = 37888;
static_assert(S_END <= 40960, "slot image inside the dead arrays");
constexpr int O_SL = O_R;
constexpr int O_PB = O_LW, O_AF = O_PB + 9216, O_TDT = O_AF + 4224, O_M1T = O_TDT + 1536, O_WS = O_M1T + 768;
static_assert(O_WS + 2048 <= O_BD, "wkv prep LDS map 2");
}
#define WKF_READY(p) (8192 + 64 * (p))
#define WKF_ACK(p)   (8192 + 64 * 128 + 64 * (p))
__device__ __forceinline__ void wk_wait_ge(unsigned* flag, unsigned want) {
    if (threadIdx.x == 0) { unsigned sp = 0;
        while (__hip_atomic_load(flag, __ATOMIC_RELAXED, __HIP_MEMORY_SCOPE_AGENT) < want) { __builtin_amdgcn_s_sleep(2); if (++sp > (1u << 18)) break; }
        __builtin_amdgcn_fence(__ATOMIC_ACQUIRE, "agent"); asm volatile("s_waitcnt vmcnt(0)" ::: "memory"); }
    __syncthreads();
}
__device__ __forceinline__ void ph_wkv_prep(unsigned char* lds, const WkvArgs& a, int item, int par, unsigned char* slot, unsigned* ctl) {
    using namespace wp;
    float* R = LDSF(O_R); float* Wd = LDSF(O_W); float* Kp = LDSF(O_KP); float* Vv = LDSF(O_V); float* KK = LDSF(O_KK); float* BB = LDSF(O_BB); float* G = LDSF(O_G);
    bf16_t* LW = (bf16_t*)(lds + O_LW); bf16_t* LA = (bf16_t*)(lds + O_LA); bf16_t* LG = (bf16_t*)(lds + O_LG); bf16_t* LV = (bf16_t*)(lds + O_LV); float* BD = LDSF(O_BD);
    const int b = item >> 4, h = item & 15, tid0 = opaque_tid(), pidx = item * 2 + par;
    const int layer = a.layer;
    float mu1[3][2], kkc[2], muL[5][2];
    float w0v, a0v, kav, rkv, v0v;
    bf16x8_t fw[2], fa[2], fg[4], fv;
    { const int tid = tid0, lane = tid & 63, wv = tid >> 6, l15 = lane & 15, q4 = lane >> 4, nt = wv & 3, cp = lane & 31, hc = h * 64 + 16 * nt + l15;
#pragma unroll
      for (int x = 0; x < 2; ++x) { const int c = h * 64 + 2 * cp + x; mu1[0][x] = a.mu[c]; mu1[1][x] = a.mu[1024 + c]; mu1[2][x] = a.mu[2048 + c]; kkc[x] = a.k_k[c];
#pragma unroll
          for (int e = 0; e < 4; ++e) muL[e][x] = a.mu[3072 + 64 * e + 2 * cp + x];
          muL[4][x] = (layer && cp < 16) ? a.mu_v[2 * cp + x] : 0.f; }
      w0v = a.w0[hc]; a0v = a.a0[hc]; kav = a.k_a[hc]; rkv = a.r_k[hc]; v0v = layer ? a.v0[hc] : 0.f;
      bf16_t* T = (bf16_t*)(lds + O_R);
      for (int e = tid; e < 64 * 64; e += 512) { const int i = e >> 6, c = e & 63; T[c * 72 + i] = (bf16_t)f2bf(a.w2[(size_t)i * 1024 + h * 64 + c]); T[64 * 72 + c * 72 + i] = (bf16_t)f2bf(a.a2[(size_t)i * 1024 + h * 64 + c]); }
      for (int e = tid; e < 128 * 64; e += 512) { const int i = e >> 6, c = e & 63; T[2 * 64 * 72 + c * 136 + i] = (bf16_t)f2bf(a.g2[(size_t)i * 1024 + h * 64 + c]); }
      if (layer) for (int e = tid; e < 32 * 64; e += 512) { const int i = e >> 6, c = e & 63; T[2 * 64 * 72 + 64 * 136 + c * 40 + i] = (bf16_t)f2bf(a.v2[(size_t)i * 1024 + h * 64 + c]); }
      __syncthreads();
      const int cl = 16 * nt + l15;
#pragma unroll
      for (int ks = 0; ks < 2; ++ks) { fw[ks] = *(const bf16x8_t*)(T + cl * 72 + 8 * q4 + 32 * ks); fa[ks] = *(const bf16x8_t*)(T + 64 * 72 + cl * 72 + 8 * q4 + 32 * ks); }
#pragma unroll
      for (int ks = 0; ks < 4; ++ks) fg[ks] = *(const bf16x8_t*)(T + 2 * 64 * 72 + cl * 136 + 8 * q4 + 32 * ks);
      fv = layer ? *(const bf16x8_t*)(T + 2 * 64 * 72 + 64 * 136 + cl * 40 + 8 * q4) : fw[0];
      __syncthreads(); }
    auto dma = [&](int s0, int tid) {
        const int ln = tid & 63, wvu = __builtin_amdgcn_readfirstlane(tid >> 6); const size_t mb = (size_t)b * cf::SEQ + s0;
#pragma unroll
        for (int q = 0; q < 5; ++q) { const int j = wvu + 8 * q; if (j >= 34) continue;
            const bf16_t* src; int dst; bool on = true;
            if (j < 16) { src = a.ZC + (mb + 2 * j + (ln >> 5)) * 3328 + 3072 + (ln & 31) * 8; dst = O_IL + j * 1024; }
            else if (j < 28) { const int kd = (j - 16) >> 2, jj = (j - 16) & 3; src = a.ZC + (mb + 8 * jj + (ln >> 3)) * 3328 + kd * 1024 + h * 64 + (ln & 7) * 8; dst = O_IR + kd * 4224 + jj * 1024; }
            else if (j < 32) { const int jj = j - 28; src = a.VF + (mb + 8 * jj + (ln >> 3)) * 1024 + h * 64 + (ln & 7) * 8; dst = O_IF + jj * 1024; on = layer != 0; }
            else { const int jj = j - 32; src = a.ZV1 + (mb + 16 * jj + (ln >> 2)) * 32 + (ln & 3) * 8; dst = O_IZ + jj * 1024; on = layer != 0; }
            if (on) __builtin_amdgcn_global_load_lds((const unsigned*)src, (LAS unsigned*)((LAS unsigned char*)lds + dst), 16, 0, 0); }
    };
    auto load_prev = [&](int s0, int tid) {
        if (tid < 68) { const int pc = tid; u32x4 v = (u32x4){0u, 0u, 0u, 0u};
            if (s0 > 0) { const size_t m = (size_t)b * cf::SEQ + s0 - 1;
                if (pc < 24) v = *(const u32x4*)(a.ZC + m * 3328 + (pc >> 3) * 1024 + h * 64 + (pc & 7) * 8);
                else if (pc < 56) v = *(const u32x4*)(a.ZC + m * 3328 + 3072 + (pc - 24) * 8);
                else if (pc < 60) { if (layer) v = *(const u32x4*)(a.ZV1 + m * 32 + (pc - 56) * 8); }
                else { if (layer) v = *(const u32x4*)(a.VF + m * 1024 + h * 64 + (pc - 60) * 8); } }
            const int off = pc < 24 ? O_IR + (pc >> 3) * 4224 + 32 * 128 + (pc & 7) * 16 : (pc < 56 ? O_IL + 32 * 512 + (pc - 24) * 16 : (pc < 60 ? O_IZ + 32 * 64 + (pc - 56) * 16 : O_IF + 32 * 128 + (pc - 60) * 16));
            *(u32x4*)(lds + off) = v; }
    };
#define WK_BAR() do { asm volatile("s_waitcnt lgkmcnt(0)" ::: "memory"); __builtin_amdgcn_s_barrier(); asm volatile("" ::: "memory"); } while (0)
    dma(par * TC, tid0); load_prev(par * TC, tid0);
    asm volatile("s_waitcnt vmcnt(0)" ::: "memory"); __syncthreads();
#pragma unroll 1
    for (int ch = par; ch < cf::SEQ / TC; ch += 2) {
        const int s0 = ch * TC; const size_t m0 = (size_t)b * cf::SEQ + s0;
        int tid = tid0; asm volatile("" : "+v"(tid));
        const int lane = tid & 63, wv = tid >> 6, l15 = lane & 15, q4 = lane >> 4, mt = wv >> 2, nt = wv & 3;
        { const int cp = lane & 31, th = lane >> 5;
          const unsigned* IRw = (const unsigned*)(lds + O_IR); const unsigned* IKw = (const unsigned*)(lds + O_IK); const unsigned* IVw = (const unsigned*)(lds + O_IV); const unsigned* ILw = (const unsigned*)(lds + O_IL); const unsigned* IZw = (const unsigned*)(lds + O_IZ);
#pragma unroll
          for (int it = 0; it < 2; ++it) { const int tt = 4 * wv + 2 * it + th, pr = tt ? tt - 1 : 32;
              const unsigned r1 = IRw[tt * 32 + cp], r0 = IRw[pr * 32 + cp], k1 = IKw[tt * 32 + cp], k0 = IKw[pr * 32 + cp], v1 = IVw[tt * 32 + cp], v0_ = IVw[pr * 32 + cp];
              const float rs0 = bflo(r1) + (bflo(r0) - bflo(r1)) * mu1[0][0], rs1 = bfhi(r1) + (bfhi(r0) - bfhi(r1)) * mu1[0][1];
              const float ks0 = bflo(k1) + (bflo(k0) - bflo(k1)) * mu1[1][0], ks1 = bfhi(k1) + (bfhi(k0) - bfhi(k1)) * mu1[1][1];
              const float vs0 = bflo(v1) + (bflo(v0_) - bflo(v1)) * mu1[2][0], vs1 = bfhi(v1) + (bfhi(v0_) - bfhi(v1)) * mu1[2][1];
              const float kq0 = ks0 * kkc[0], kq1 = ks1 * kkc[1];
              const float sr = sum_row16(kq0 * kq0 + kq1 * kq1);
              const float slo = readlane_f(sr, 0) + readlane_f(sr, 16), shi = readlane_f(sr, 32) + readlane_f(sr, 48);
              const float rn = rsqrtf((th ? shi : slo) + 1e-12f);
              typedef float f32x2_ __attribute__((ext_vector_type(2)));
              *(f32x2_*)(R + tt * 64 + 2 * cp) = (f32x2_){rs0, rs1}; *(f32x2_*)(Kp + tt * 64 + 2 * cp) = (f32x2_){ks0, ks1}; *(f32x2_*)(Vv + tt * 64 + 2 * cp) = (f32x2_){vs0, vs1}; *(f32x2_*)(KK + tt * 64 + 2 * cp) = (f32x2_){kq0 * rn, kq1 * rn};
              if (layer == 0) *(unsigned*)(a.VF + (m0 + tt) * 1024 + h * 64 + 2 * cp) = pk2(vs0, vs1);
              { unsigned z1 = ILw[tt * 128 + cp], z0 = ILw[pr * 128 + cp];
                ((unsigned*)LW)[tt * 36 + cp] = pk2(tanhf_(bflo(z1) + (bflo(z0) - bflo(z1)) * muL[0][0]), tanhf_(bfhi(z1) + (bfhi(z0) - bfhi(z1)) * muL[0][1]));
                z1 = ILw[tt * 128 + 32 + cp]; z0 = ILw[pr * 128 + 32 + cp];
                ((unsigned*)LA)[tt * 36 + cp] = pk2(bflo(z1) + (bflo(z0) - bflo(z1)) * muL[1][0], bfhi(z1) + (bfhi(z0) - bfhi(z1)) * muL[1][1]);
                z1 = ILw[tt * 128 + 64 + cp]; z0 = ILw[pr * 128 + 64 + cp];
                ((unsigned*)LG)[tt * 68 + cp] = pk2(sigmoidf_(bflo(z1) + (bflo(z0) - bflo(z1)) * muL[2][0]), sigmoidf_(bfhi(z1) + (bfhi(z0) - bfhi(z1)) * muL[2][1]));
                z1 = ILw[tt * 128 + 96 + cp]; z0 = ILw[pr * 128 + 96 + cp];
                ((unsigned*)LG)[tt * 68 + 32 + cp] = pk2(sigmoidf_(bflo(z1) + (bflo(z0) - bflo(z1)) * muL[3][0]), sigmoidf_(bfhi(z1) + (bfhi(z0) - bfhi(z1)) * muL[3][1]));
                if (layer && cp < 16) { z1 = IZw[tt * 16 + cp]; z0 = IZw[pr * 16 + cp];
                    ((unsigned*)LV)[tt * 20 + cp] = pk2(bflo(z1) + (bflo(z0) - bflo(z1)) * muL[4][0], bfhi(z1) + (bfhi(z0) - bfhi(z1)) * muL[4][1]); } } } }
        __syncthreads();
        {
            f32x4 cw = (f32x4){0.f, 0.f, 0.f, 0.f}, ca = cw, cgt = cw, cv = cw;
            const int arow = 16 * mt + l15;
#pragma unroll
            for (int ks = 0; ks < 2; ++ks) { const bf16x8_t xw = *(const bf16x8_t*)(LW + arow * 72 + 8 * q4 + 32 * ks), xa = *(const bf16x8_t*)(LA + arow * 72 + 8 * q4 + 32 * ks);
                cw = __builtin_amdgcn_mfma_f32_16x16x32_bf16(xw, fw[ks], cw, 0, 0, 0); ca = __builtin_amdgcn_mfma_f32_16x16x32_bf16(xa, fa[ks], ca, 0, 0, 0); }
#pragma unroll
            for (int ks = 0; ks < 4; ++ks) { const bf16x8_t xg = *(const bf16x8_t*)(LG + arow * 136 + 8 * q4 + 32 * ks); cgt = __builtin_amdgcn_mfma_f32_16x16x32_bf16(xg, fg[ks], cgt, 0, 0, 0); }
            if (layer) { bf16x8_t xv = *(const bf16x8_t*)(LV + arow * 40 + 8 * q4); cv = __builtin_amdgcn_mfma_f32_16x16x32_bf16(xv, fv, cv, 0, 0, 0); }
            const int chn = 16 * nt + l15; const bf16_t* IF = (const bf16_t*)(lds + O_IF);
#pragma unroll
            for (int j = 0; j < 4; ++j) { const int tt = 16 * mt + 4 * q4 + j, e = tt * 64 + chn;
                const float lwd = -0.60653065971f * sigmoidf_(w0v + cw[j]);
                const float av = sigmoidf_(a0v + ca[j]);
                const float rv = R[e], kr = Kp[e], vr = Vv[e];
                float v = vr;
                if (layer) { const float vf = bf2f(IF[tt * 64 + chn]); v = vr + (vf - vr) * sigmoidf_(v0v + cv[j]); }
                const float kp = kr * (1.0f + (av - 1.0f) * kav);
                const float bd = sum_row16(rv * kp * rkv);
                Wd[e] = lwd; Kp[e] = kp; Vv[e] = v; BB[e] = KK[e] * av; G[e] = cgt[j];
                if (l15 == 0) BD[nt * 32 + tt] = bd; }
        }
        __syncthreads();
        { float rv[4], lwv[4], kpv[4], kkv4[4], bbv[4], vv4[4], gv4[4]; float* WS = LDSF(O_WS);
#pragma unroll
          for (int q = 0; q < 4; ++q) { const int e = (4 * wv + q) * 64 + lane; rv[q] = R[e]; lwv[q] = Wd[e]; kpv[q] = Kp[e]; kkv4[q] = KK[e]; bbv[q] = BB[e]; vv4[q] = Vv[e]; gv4[q] = G[e]; }
          float bds = 0.f; if (tid < 32) bds = (BD[tid] + BD[32 + tid]) + (BD[64 + tid] + BD[96 + tid]);
          WS[wv * 64 + lane] = (lwv[0] + lwv[1]) + (lwv[2] + lwv[3]);
          WK_BAR();
          if (ch + 2 < cf::SEQ / TC) { dma(s0 + 2 * TC, tid); }
          float cprev = 0.f;
#pragma unroll
          for (int w2 = 0; w2 < 7; ++w2) { const float x_ = WS[w2 * 64 + lane]; cprev += (w2 < wv) ? x_ : 0.f; }
          bf16_t* PA = (bf16_t*)(lds + O_SL + S_PA); bf16_t* PB = (bf16_t*)(lds + O_PB); bf16_t* PBT = (bf16_t*)(lds + O_SL + S_PBT); bf16_t* VTl = (bf16_t*)(lds + O_SL + S_VT); bf16_t* GB = (bf16_t*)(lds + O_SL + S_GB);
          float ep = __expf(cprev), cl = cprev; float bt4[4], kt4[4];
#pragma unroll
          for (int q = 0; q < 4; ++q) { const int t = 4 * wv + q; cl += lwv[q]; const float e = __expf(cl), ei = __expf(-cl);
              PA[t * 72 + lane] = (bf16_t)f2bf(kkv4[q] * ep); PA[(32 + t) * 72 + lane] = (bf16_t)f2bf(rv[q] * e);
              bt4[q] = bbv[q] * ei; kt4[q] = kpv[q] * ei;
              PB[t * 72 + lane] = (bf16_t)f2bf(bt4[q]); PB[(32 + t) * 72 + lane] = (bf16_t)f2bf(kt4[q]);
              GB[t * 64 + lane] = (bf16_t)f2bf(gv4[q]);
              ep = e; }
          u32x2 w; w.x = pk2(bt4[0], bt4[1]); w.y = pk2(bt4[2], bt4[3]); *(u32x2*)(PBT + lane * 72 + 4 * wv) = w;
          w.x = pk2(kt4[0], kt4[1]); w.y = pk2(kt4[2], kt4[3]); *(u32x2*)(PBT + lane * 72 + 32 + 4 * wv) = w;
          w.x = pk2(vv4[0], vv4[1]); w.y = pk2(vv4[2], vv4[3]); *(u32x2*)(VTl + lane * 40 + 4 * wv) = w;
          if (wv == 7) LDSF(O_SL + S_GAM)[lane] = ep;
          if (tid < 32) LDSF(O_SL + S_BDS)[tid] = bds; }
        WK_BAR();
        { const bf16_t* PA = (const bf16_t*)(lds + O_SL + S_PA); const bf16_t* PB = (const bf16_t*)(lds + O_PB); bf16_t* AM3 = (bf16_t*)(lds + O_SL + S_AM3); float* AF = LDSF(O_AF);
          const int mtile = wv >> 1;
          const bf16x8_t a0 = *(const bf16x8_t*)(PA + (16 * mtile + l15) * 72 + 8 * q4), a1 = *(const bf16x8_t*)(PA + (16 * mtile + l15) * 72 + 8 * q4 + 32);
#pragma unroll
          for (int nn = 0; nn < 2; ++nn) { const int ntile = 2 * (wv & 1) + nn;
              const bf16x8_t b0 = *(const bf16x8_t*)(PB + (16 * ntile + l15) * 72 + 8 * q4), b1 = *(const bf16x8_t*)(PB + (16 * ntile + l15) * 72 + 8 * q4 + 32);
              f32x4 c = (f32x4){0.f, 0.f, 0.f, 0.f};
              c = __builtin_amdgcn_mfma_f32_16x16x32_bf16(a0, b0, c, 0, 0, 0); c = __builtin_amdgcn_mfma_f32_16x16x32_bf16(a1, b1, c, 0, 0, 0);
              const int sg = 16 * ntile + l15, s_ = sg & 31;
#pragma unroll
              for (int j = 0; j < 4; ++j) { const int rho = 16 * mtile + 4 * q4 + j, t_ = rho & 31; const bool keep = (rho < 32) ? (t_ > s_) : (t_ >= s_); const float val = keep ? c[j] : 0.f;
                  if (rho < 32) { if (sg < 32) AF[t_ * 33 + s_] = val; else AM3[t_ * 104 + s_] = (bf16_t)f2bf(val); }
                  else AM3[t_ * 104 + (sg < 32 ? 32 : 64) + s_] = (bf16_t)f2bf(val); } } }
        WK_BAR();
        { bf16_t* TT = (bf16_t*)(lds + O_SL + S_TT); bf16_t* TDT = (bf16_t*)(lds + O_TDT);
          if (wv < 2 && lane < 16) { const float* AF = LDSF(O_AF) + (16 * wv) * 33 + 16 * wv; float x[16];
#pragma unroll
              for (int t = 0; t < 16; ++t) { float acc = (t == lane) ? 1.f : 0.f;
#pragma unroll
                  for (int s = 0; s < 16; ++s) if (s < t) acc -= AF[t * 33 + s] * x[s];
                  x[t] = acc; }
#pragma unroll
              for (int t = 0; t < 16; ++t) TT[(16 * wv + t) * 40 + 16 * wv + lane] = (bf16_t)f2bf(x[t]);
              u32x4 w0_, w1_; w0_.x = pk2(x[0], x[1]); w0_.y = pk2(x[2], x[3]); w0_.z = pk2(x[4], x[5]); w0_.w = pk2(x[6], x[7]); w1_.x = pk2(x[8], x[9]); w1_.y = pk2(x[10], x[11]); w1_.z = pk2(x[12], x[13]); w1_.w = pk2(x[14], x[15]);
              *(u32x4*)(TDT + (wv * 16 + lane) * 24) = w0_; *(u32x4*)(TDT + (wv * 16 + lane) * 24 + 8) = w1_; }
          if (wv == 2 && lane < 32) { const int rw = lane >> 1; *(u32x4*)(TT + rw * 40 + 16 + 8 * (lane & 1)) = (u32x4){0u, 0u, 0u, 0u}; }
        }
        WK_BAR();
        if (wv == 0) { const float* AF = LDSF(O_AF); bf16_t* TT = (bf16_t*)(lds + O_SL + S_TT); const bf16_t* TDT = (const bf16_t*)(lds + O_TDT); bf16_t* M1T = (bf16_t*)(lds + O_M1T);
            const bf16x8_t zf = (bf16x8_t){0, 0, 0, 0, 0, 0, 0, 0};
            bf16x8_t af = zf, bf = zf;
            if (q4 < 2) { const float* ar = AF + (16 + l15) * 33 + 8 * q4; u32x4 w; w.x = pk2(ar[0], ar[1]); w.y = pk2(ar[2], ar[3]); w.z = pk2(ar[4], ar[5]); w.w = pk2(ar[6], ar[7]); af = __builtin_bit_cast(bf16x8_t, w);
                          bf = *(const bf16x8_t*)(TDT + l15 * 24 + 8 * q4); }
            f32x4 c = (f32x4){0.f, 0.f, 0.f, 0.f};
            c = __builtin_amdgcn_mfma_f32_16x16x32_bf16(af, bf, c, 0, 0, 0);
            u32x2 w; w.x = pk2(c[0], c[1]); w.y = pk2(c[2], c[3]); *(u32x2*)(M1T + l15 * 24 + 4 * q4) = w;
            __builtin_amdgcn_wave_barrier(); asm volatile("s_waitcnt lgkmcnt(0)" ::: "memory");
            af = zf; bf = zf;
            if (q4 < 2) { af = *(const bf16x8_t*)(TT + (16 + l15) * 40 + 16 + 8 * q4); bf = *(const bf16x8_t*)(M1T + l15 * 24 + 8 * q4); }
            c = (f32x4){0.f, 0.f, 0.f, 0.f};
            c = __builtin_amdgcn_mfma_f32_16x16x32_bf16(af, bf, c, 0, 0, 0);
#pragma unroll
            for (int j = 0; j < 4; ++j) TT[(16 + 4 * q4 + j) * 40 + l15] = (bf16_t)f2bf(-c[j]); }
        asm volatile("s_waitcnt vmcnt(0)" ::: "memory");
        if (ch >= 2) wk_wait_ge(ctl + WKF_ACK(pidx), (unsigned)(ch - 1)); else __syncthreads();
        { const unsigned long long* src = (const unsigned long long*)(lds + O_SL); unsigned long long* dst = (unsigned long long*)slot;
          for (int i = tid; i < S_END / 8; i += 512) __hip_atomic_store(dst + i, src[i], __ATOMIC_RELAXED, __HIP_MEMORY_SCOPE_AGENT); }
        if (ch + 2 < cf::SEQ / TC) load_prev(s0 + 2 * TC, tid);
        asm volatile("s_waitcnt vmcnt(0)" ::: "memory");
        __syncthreads();
        if (tid == 0) __hip_atomic_store(ctl + WKF_READY(pidx), (unsigned)(ch + 1), __ATOMIC_RELAXED, __HIP_MEMORY_SCOPE_AGENT);
    }
#undef WK_BAR
}
namespace wc {
constexpr int O_B0 = 0, O_B1 = wp::SLOT_BYTES, O_Y = 2 * wp::SLOT_BYTES, O_END = O_Y + 8192;
}
__device__ __forceinline__ void ph_wkv_chain(unsigned char* lds, const WkvArgs& a, int item, unsigned char* slot0, unsigned char* slot1, unsigned* ctl) {
    using namespace wp;
    const int b = item >> 4, h = item & 15, tid0 = opaque_tid();
    float* Y = LDSF(wc::O_Y);
    float lnwv, lnbv;
    { const int hj = h * 64 + (tid0 & 63); lnwv = a.lnw[hj]; lnbv = a.lnb[hj]; }
    f32x4 Hs[4];
#pragma unroll
    for (int c = 0; c < 4; ++c) Hs[c] = (f32x4){0.f, 0.f, 0.f, 0.f};
    bf16x8_t hb0 = (bf16x8_t){0, 0, 0, 0, 0, 0, 0, 0}, hb1 = hb0;
    auto dma_in = [&](int c, int tid) {
        const int ln = tid & 63, wvu = __builtin_amdgcn_readfirstlane(tid >> 6); const unsigned char* src = (c & 1) ? slot1 : slot0; const int dst = (c & 1) ? wc::O_B1 : wc::O_B0;
#pragma unroll
        for (int q = 0; q < 5; ++q) { const int j = wvu + 8 * q; if (j >= SLOT_BYTES / 1024) continue;
            __builtin_amdgcn_global_load_lds((const unsigned*)(src + j * 1024 + ln * 16), (LAS unsigned*)((LAS unsigned char*)lds + dst + j * 1024), 16, 0, 0); }
    };
#define WK_BAR() do { asm volatile("s_waitcnt lgkmcnt(0)" ::: "memory"); __builtin_amdgcn_s_barrier(); asm volatile("" ::: "memory"); } while (0)
    auto stage4 = [&](int c, int tid) {
        const int lane = tid & 63, wv = tid >> 6; const unsigned char* B = lds + ((c & 1) ? wc::O_B1 : wc::O_B0);
        const bf16_t* VTl = (const bf16_t*)(B + S_VT); const bf16_t* GB = (const bf16_t*)(B + S_GB); const float* BDS = (const float*)(B + S_BDS);
        const size_t m0 = (size_t)b * cf::SEQ + c * TC;
#pragma unroll
        for (int q = 0; q < 4; ++q) { const int tt = 4 * wv + q;
            const float y = Y[tt * 64 + lane]; const float mu = wave_sum(y) * (1.f / 64.f); const float d = y - mu; const float var = wave_sum(d * d) * (1.f / 64.f);
            const float o = (d * rsqrtf(var + cf::GN_EPS) * lnwv + lnbv + BDS[tt] * bf2f(VTl[lane * 40 + tt])) * bf2f(GB[tt * 64 + lane]);
            a.YC[(m0 + tt) * (size_t)a.ldy + h * 64 + lane] = (bf16_t)f2bf(o); }
    };
    wk_wait_ge(ctl + WKF_READY(item * 2 + 0), 1u);
    dma_in(0, tid0);
    asm volatile("s_waitcnt vmcnt(0)" ::: "memory"); __syncthreads();
    if (tid0 == 0) __hip_atomic_store(ctl + WKF_ACK(item * 2 + 0), 1u, __ATOMIC_RELAXED, __HIP_MEMORY_SCOPE_AGENT);
#pragma unroll 1
    for (int ch = 0; ch < cf::SEQ / TC; ++ch) {
        int tid = tid0; asm volatile("" : "+v"(tid));
        const int lane = tid & 63, wv = tid >> 6, l15 = lane & 15, q4 = lane >> 4;
        if (ch > 0) stage4(ch - 1, tid);
        __syncthreads();
        if (ch + 1 < cf::SEQ / TC) { wk_wait_ge(ctl + WKF_READY(item * 2 + ((ch + 1) & 1)), (unsigned)(ch + 2)); dma_in(ch + 1, tid); }
        if (wv < 4) { const unsigned char* B = lds + ((ch & 1) ? wc::O_B1 : wc::O_B0);
            const unsigned char* pPA = B + S_PA + l15 * 144 + 8 * q4;
            const unsigned char* nAK = B + S_AM3 + l15 * 208 + 16 * q4;
            const unsigned char* pRB = B + S_AM3 + l15 * 208 + 64 + 8 * q4;
            const unsigned char* nRK = B + S_AM3 + l15 * 208 + 128 + 16 * q4;
            const unsigned char* pTT = B + S_TT + l15 * 80 + 8 * q4;
            const unsigned char* pPBT = B + S_PBT + l15 * 144 + 8 * q4; const unsigned char* nPBT = B + S_PBT + l15 * 144 + 16 * q4 + 64;
            const bf16x8_t vfrag = *(const bf16x8_t*)(B + S_VT + (16 * wv + l15) * 80 + 16 * q4);
            f32x4 x1[2];
#pragma unroll
            for (int m2 = 0; m2 < 2; ++m2) { f32x4 c = (f32x4){0.f, 0.f, 0.f, 0.f};
                c = __builtin_amdgcn_mfma_f32_16x16x32_bf16(*(const bf16x8_t*)(nAK + m2 * 3328), vfrag, c, 0, 0, 0);
                c = __builtin_amdgcn_mfma_f32_16x16x32_bf16(wk_perm(pPA + m2 * 2304), hb0, c, 0, 0, 0);
                c = __builtin_amdgcn_mfma_f32_16x16x32_bf16(wk_perm(pPA + m2 * 2304 + 64), hb1, c, 0, 0, 0);
                x1[m2] = -c; }
            const bf16x8_t xb = wk_pack(x1[0], x1[1]);
            f32x4 uu[2];
#pragma unroll
            for (int m2 = 0; m2 < 2; ++m2) { f32x4 c = (f32x4){0.f, 0.f, 0.f, 0.f}; uu[m2] = __builtin_amdgcn_mfma_f32_16x16x32_bf16(wk_perm(pTT + m2 * 1280), xb, c, 0, 0, 0); }
            const bf16x8_t ub = wk_pack(uu[0], uu[1]);
#pragma unroll
            for (int m2 = 0; m2 < 2; ++m2) { f32x4 c = (f32x4){0.f, 0.f, 0.f, 0.f};
                c = __builtin_amdgcn_mfma_f32_16x16x32_bf16(*(const bf16x8_t*)(nRK + m2 * 3328), vfrag, c, 0, 0, 0);
                c = __builtin_amdgcn_mfma_f32_16x16x32_bf16(wk_perm(pPA + (2 + m2) * 2304), hb0, c, 0, 0, 0);
                c = __builtin_amdgcn_mfma_f32_16x16x32_bf16(wk_perm(pPA + (2 + m2) * 2304 + 64), hb1, c, 0, 0, 0);
                c = __builtin_amdgcn_mfma_f32_16x16x32_bf16(wk_perm(pRB + m2 * 3328), ub, c, 0, 0, 0);
#pragma unroll
                for (int j = 0; j < 4; ++j) Y[(16 * m2 + 4 * q4 + j) * 64 + 16 * wv + l15] = c[j]; }
#pragma unroll
            for (int jm = 0; jm < 4; ++jm) {
                Hs[jm] = __builtin_amdgcn_mfma_f32_16x16x32_bf16(*(const bf16x8_t*)(nPBT + jm * 2304), vfrag, Hs[jm], 0, 0, 0);
                Hs[jm] = __builtin_amdgcn_mfma_f32_16x16x32_bf16(wk_perm(pPBT + jm * 2304), ub, Hs[jm], 0, 0, 0);
                const f32x4 gm = *(const f32x4*)((const float*)(B + S_GAM) + 16 * jm + 4 * q4); Hs[jm] = Hs[jm] * gm; }
            hb0 = wk_pack(Hs[0], Hs[1]); hb1 = wk_pack(Hs[2], Hs[3]);
        }
        asm volatile("s_waitcnt vmcnt(0)" ::: "memory");
        WK_BAR();
        if (ch + 1 < cf::SEQ / TC && tid == 0) __hip_atomic_store(ctl + WKF_ACK(item * 2 + ((ch + 1) & 1)), (unsigned)(ch + 2), __ATOMIC_RELAXED, __HIP_MEMORY_SCOPE_AGENT);
    }
    { int tid = tid0; asm volatile("" : "+v"(tid)); stage4(cf::SEQ / TC - 1, tid); }
#undef WK_BAR
}
#include <hip/hip_cooperative_groups.h>
namespace cg = cooperative_groups;
namespace wsmap {
using cf::MiB;
constexpr size_t CTL = 0, MOD = 1 * MiB, CS = MiB + MiB / 2, H = 3 * MiB, VF = 35 * MiB, W = 67 * MiB, AR = 84 * MiB;
constexpr size_t XA = AR, GA = AR + 32 * MiB, Q = AR + 64 * MiB, K = AR + 88 * MiB, V = AR + 112 * MiB, ZC = AR + 136 * MiB, ZV1 = AR + 240 * MiB, YB = AR + 241 * MiB;
constexpr size_t GT = Q, MG = AR + 96 * MiB, YO = AR + 128 * MiB;
constexpr size_t U = AR, SS = AR + 88 * MiB, YF = AR + 176 * MiB;
constexpr size_t W_G = W, W_PA = W + 6 * MiB, W_PB = W + 8 * MiB, W_PC = W + 8 * MiB + MiB / 2, W_O = W + 10 * MiB + MiB / 2;
constexpr size_t W_UP = W, W_DN = W + 11 * MiB;
}
#ifndef PROBE_ID
#define PROBE_ID 0
#endif
#define REP(id) _Pragma("unroll 1") for (int rep_ = 0; rep_ < ((PROBE_ID == (id)) ? 3 : 1); ++rep_)
constexpr int MEGA_LDS = 147456;
struct MegaArgs { const float* in[40]; float* out; unsigned char* ws; };

template <class Epi> __device__ __forceinline__ void run_gemm(unsigned char* lds, const bf16_t* A, int lda, const bf16_t* Bt, int M, int N, int K, const Epi& E) {
    pg8::Gemm g; g.A = A; g.Bt = Bt; g.M = M; g.N = N; g.K = K; g.lda = lda;
    pg8::StaticOrder S; S.init(M, N, (int)gridDim.x, (int)blockIdx.x);
    pg8::gemm_phase<Epi, pg8::StaticOrder, true, true>((PG8_LAS unsigned char*)lds, g, S, E);
}

__global__ __launch_bounds__(512, 2) void mega(MegaArgs A) {
    using namespace wsmap;
    cg::grid_group grid = cg::this_grid();
    extern __shared__ __attribute__((aligned(16))) unsigned char lds[];
#define KARG(i) (((const float* const volatile __attribute__((address_space(4)))*)__builtin_amdgcn_kernarg_segment_ptr())[i])
#define F(i) ((const float*)KARG(i))
#define P_WS ((unsigned char*)KARG(41))
    { volatile LAS unsigned* misc = (volatile LAS unsigned*)((LAS unsigned char*)lds + 131072 + 320); { const int t_ = opaque_tid(); if (t_ < 32) misc[t_] = 0u; } }
    __syncthreads();
    (void)xcd_barrier_post((unsigned*)(P_WS) + 4096, (volatile LAS unsigned*)((LAS unsigned char*)lds + 131072 + 320) + 8);
#define GSYNC() do { XcdBarrier xb_; xb_.bar = (unsigned*)(P_WS) + 4096; xb_.x = xb_xcc_id(); xb_.st = (volatile LAS unsigned*)((LAS unsigned char*)lds + 131072 + 320) + 8; xcd_barrier(xb_); } while (0)
#define P_X ((float*)KARG(40))
#define P_MOD ((float*)(P_WS + MOD))
#define P_CS ((float*)(P_WS + CS))
#define P_H ((bf16_t*)(P_WS + H))
#define P_VF ((bf16_t*)(P_WS + VF))
#define P_WINT ((bf16_t*)(P_WS + W))
    REP(8) ph_mod(lds, F(1), F(3), F(4), P_MOD);
    ph_rope((const int*)F(2), P_CS);
    __syncthreads();
    REP(7) ph_transpose(lds, F(5), 1024, 10752, 0, 7680, P_WINT, 0);
    __syncthreads(); grid.sync();
    ph_modulate(F(0), P_MOD, 0, 1024, P_H);
    GSYNC();
#pragma unroll 1
    for (int l = 0; l < 2; ++l) {
#define P_MODL (P_MOD + (size_t)l * 4 * 6144)
        { pg8::EpiIn E; E.XA = (bf16_t*)(P_WS + XA); E.GA = (bf16_t*)(P_WS + GA); E.Q = (bf16_t*)(P_WS + Q); E.K = (bf16_t*)(P_WS + K); E.V = (bf16_t*)(P_WS + V); E.ZC = (bf16_t*)(P_WS + ZC); E.ZV1 = (bf16_t*)(P_WS + ZV1); E.cs = P_CS;
          REP(1) run_gemm(lds, P_H, 1024, P_WINT, cf::M, (30 + l) * 256, 1024, E); }
        GSYNC();
        REP(7) ph_transpose(lds, F(5) + (size_t)l * 1024 * 10752, 1024, 10752, 7680, 3072, (bf16_t*)(P_WS + W_G), 0);
        REP(7) ph_transpose(lds, F(28) + (size_t)l * 1024 * 1024, 1024, 1024, 0, 1024, (bf16_t*)(P_WS + W_PA), 0);
        REP(7) ph_transpose(lds, F(29) + (size_t)l * 256 * 1024, 256, 1024, 0, 1024, (bf16_t*)(P_WS + W_PB), 0);
        REP(7) ph_transpose(lds, F(30) + (size_t)l * 1024 * 1024, 1024, 1024, 0, 1024, (bf16_t*)(P_WS + W_PC), 0);
        REP(7) ph_transpose(lds, F(31) + (size_t)l * 1024 * 1024, 1024, 1024, 0, 1024, (bf16_t*)(P_WS + W_O), 0);
        __syncthreads();
        {
            const int bx = (int)blockIdx.x;
            if (bx < 192) {
                WkvArgs a; a.ZC = (const bf16_t*)(P_WS + ZC); a.ZV1 = (const bf16_t*)(P_WS + ZV1); a.VF = P_VF; a.YC = (bf16_t*)(P_WS + ZC) + 2048; a.ldy = 3328;
                a.mu = F(14) + l * 3328; a.mu_v = F(15); a.w0 = F(16) + l * 1024; a.w2 = F(17) + l * 65536; a.a0 = F(18) + l * 1024; a.a2 = F(19) + l * 65536; a.g2 = F(20) + l * 131072; a.v0 = F(21); a.v2 = F(22);
                a.k_k = F(23) + l * 1024; a.k_a = F(24) + l * 1024; a.r_k = F(25) + l * 1024; a.lnw = F(26) + l * 1024; a.lnb = F(27) + l * 1024; a.layer = l;
                unsigned* ctl = (unsigned*)(P_WS) + l * 32768;
                if (bx < 64) ph_wkv_chain(lds, a, bx, P_WS + W + 13 * MiB + (size_t)bx * wp::SLOT_BYTES, P_WS + AR + 249 * MiB + (size_t)bx * wp::SLOT_BYTES, ctl);
                else { const int p = bx - 64, item = p >> 1, par = p & 1;
                    ph_wkv_prep(lds, a, item, par, par ? P_WS + AR + 249 * MiB + (size_t)item * wp::SLOT_BYTES : P_WS + W + 13 * MiB + (size_t)item * wp::SLOT_BYTES, ctl); }
            } else {
                LruArgs a; a.XA = (const bf16_t*)(P_WS + XA); a.GA = (bf16_t*)(P_WS + GA); a.cw = F(7) + l * 4096; a.cb = F(8) + l * 1024; a.wa = F(9) + l * 65536; a.ba = F(10) + l * 1024; a.wx = F(11) + l * 65536; a.bx = F(12) + l * 1024; a.lam = F(13) + l * 1024;
                ph_lru_item(lds, a, bx - 192);
                __syncthreads();
                ph_attn((const bf16_t*)(P_WS + Q), (const bf16_t*)(P_WS + K), (const bf16_t*)(P_WS + V), (bf16_t*)(P_WS + YB), (bx - 192) * 8 + (opaque_tid() >> 6), 64 * 8);
            }
        }
        GSYNC();
        REP(2)
#pragma unroll 1
        for (int br = 0; br < 3; ++br) {
            { pg8::EpiBf16<1> Eg; Eg.O = (bf16_t*)(P_WS + GT); Eg.ldc = 1024; Eg.pad_ = 0;
              run_gemm(lds, P_H, 1024, (const bf16_t*)(P_WS + W_G) + (size_t)br * 1024 * 1024, cf::M, 1024, 1024, Eg); }
            const bf16_t* Y = (br == 0) ? (const bf16_t*)(P_WS + GA) : ((br == 1) ? (const bf16_t*)(P_WS + YB) : (const bf16_t*)(P_WS + ZC) + 2048); const bf16_t* P = (const bf16_t*)(P_WS + (br == 0 ? W_PA : (br == 1 ? W_PB : W_PC))); const int Kb = (br == 1) ? 256 : 1024, ldY = (br == 2) ? 3328 : Kb;
            if (br == 0) { pg8::EpiMerge<0> Em; Em.MG = (bf16_t*)(P_WS + MG); Em.GT = (const bf16_t*)(P_WS + GT); Em.ldc = 1024; Em.pad_ = 0; run_gemm(lds, Y, ldY, P, cf::M, 1024, Kb, Em); }
            else { pg8::EpiMerge<1> Em; Em.MG = (bf16_t*)(P_WS + MG); Em.GT = (const bf16_t*)(P_WS + GT); Em.ldc = 1024; Em.pad_ = 0; run_gemm(lds, Y, ldY, P, cf::M, 1024, Kb, Em); }
        }
        GSYNC();
        { pg8::EpiF32 E; E.C = (float*)(P_WS + YO); E.ldc = 1024; E.pad_ = 0; REP(3) run_gemm(lds, (const bf16_t*)(P_WS + MG), 1024, (const bf16_t*)(P_WS + W_O), cf::M, 1024, 1024, E); }
        GSYNC();
        ph_ln(l == 0 ? F(0) : (const float*)P_X, (const float*)(P_WS + YO), 0, cf::M, P_MODL, 2048, F(32) + l * 1024, F(33) + l * 1024, P_X, P_MODL, 3072, 4096, P_H);
        REP(7) ph_transpose(lds, F(34) + (size_t)l * 1024 * 5632, 1024, 5632, 0, 5632, (bf16_t*)(P_WS + W_UP), 0);
        REP(7) ph_transpose(lds, F(37) + (size_t)l * 2816 * 1024, 2816, 1024, 0, 1024, (bf16_t*)(P_WS + W_DN), 0);
        GSYNC();
#pragma unroll 1
        for (int hf = 0; hf < 2; ++hf) {
            const int m0 = hf * 8192;
            { pg8::EpiBf16<0> E; E.O = (bf16_t*)(P_WS + U); E.ldc = 5632; E.pad_ = 0; REP(4) run_gemm(lds, P_H + (size_t)m0 * 1024, 1024, (const bf16_t*)(P_WS + W_UP), 8192, 5632, 1024, E); }
            GSYNC();
            REP(5) ph_convglu((const bf16_t*)(P_WS + U), 8192, F(35) + l * 3 * 5632, F(36) + l * 5632, (bf16_t*)(P_WS + SS) + (size_t)m0 * 2816);
            GSYNC();
        }
        { pg8::EpiF32 E; E.C = (float*)(P_WS + YF); E.ldc = 1024; E.pad_ = 0; REP(6) run_gemm(lds, (const bf16_t*)(P_WS + SS), 2816, (const bf16_t*)(P_WS + W_DN), cf::M, 1024, 2816, E); }
        GSYNC();
        ph_ln((const float*)P_X, (const float*)(P_WS + YF), 0, cf::M, P_MODL, 5120, F(38) + l * 1024, F(39) + l * 1024, P_X, P_MOD + 4 * 6144, 0, 1024, l == 0 ? P_H : (bf16_t*)nullptr);
        if (l == 0) {
            REP(7) ph_transpose(lds, F(5) + (size_t)1024 * 10752, 1024, 10752, 0, 7680, P_WINT, 0);
            REP(7) ph_transpose(lds, F(6), 1024, 32, 0, 32, P_WINT, 7680);
            ph_zero16((u32x4*)(P_WINT + (size_t)7712 * 1024), (size_t)224 * 1024 * 2 / 16);
            GSYNC();
        }
    }
#undef F
#undef GSYNC
#undef P_WS
#undef P_X
#undef P_MOD
#undef P_CS
#undef P_H
#undef P_VF
#undef P_WINT
#undef P_MODL
}

extern "C" void kernel_launch(void* const* d_in, const int* in_sizes, int n_in, void* d_out, int out_size, void* d_ws, size_t ws_size, hipStream_t stream) {
    static int grid = 0;
    if (grid == 0) {
        int dev = 0, cus = 0, per_cu = 0;
        (void)hipGetDevice(&dev); (void)hipDeviceGetAttribute(&cus, hipDeviceAttributeMultiprocessorCount, dev);
        (void)hipFuncSetAttribute((const void*)mega, hipFuncAttributeMaxDynamicSharedMemorySize, MEGA_LDS);
        (void)hipOccupancyMaxActiveBlocksPerMultiprocessor(&per_cu, (const void*)mega, 512, MEGA_LDS);
        if (per_cu < 1) { fprintf(stderr, "kernel_launch: occupancy query says %d workgroups per CU\n", per_cu); per_cu = 1; }
        grid = cus;
        if (grid != 256) fprintf(stderr, "kernel_launch: %d CUs (built for 256)\n", grid);
    }
    (void)hipMemsetAsync((char*)d_ws + wsmap::CTL, 0, cf::MiB, stream);
    MegaArgs a{};
    for (int i = 0; i < 40; ++i) a.in[i] = (const float*)d_in[i];
    a.out = (float*)d_out; a.ws = (unsigned char*)d_ws;
    void* args[] = {&a};
    hipError_t e = hipLaunchCooperativeKernel((const void*)mega, dim3(grid), dim3(512), args, MEGA_LDS, stream);
    if (e != hipSuccess) fprintf(stderr, "cooperative launch failed: %s (grid %d)\n", hipGetErrorString(e), grid);
}
```
